# Optimizing an MI355X kernel written in HIP

```python
import math
import jax, jax.numpy as jnp
from jax import lax
import numpy as np

D_MODEL = 1024
BATCH = 4
SEQ = 4096
DEPTH = 2

N_A = DEPTH // 2
N_B = DEPTH - N_A
D_FF = 2816
LRU_WIDTH = D_MODEL
LRU_BLOCKS = 4
LRU_BW = LRU_WIDTH // LRU_BLOCKS
CONV_W = 4
LRU_C = 8.0
N_HEADS = 16
HEAD_DIM = 64
D_ATTN = N_HEADS * HEAD_DIM
Q_BLOCK = 128
EPS = 1e-6

kernel_name = "yoco_rglru_stickbreaking_macaron"


def rms_norm(x, gain):
    xf = x.astype(jnp.float32)
    y = xf * lax.rsqrt(jnp.mean(xf * xf, axis=-1, keepdims=True) + EPS)
    return (y * gain.astype(jnp.float32)).astype(x.dtype)


def swiglu(h, w13, w2):
    gate, up = jnp.split(h @ w13, 2, axis=-1)
    return (jax.nn.silu(gate) * up) @ w2


def causal_depthwise_conv(x, w, b):
    S = x.shape[1]
    xp = jnp.pad(x, ((0, 0), (CONV_W - 1, 0), (0, 0)))
    y = b
    for k in range(CONV_W):
        y = y + w[k] * xp[:, k:k + S]
    return y


def block_diag_linear(x, w, b):
    Bt, S, _ = x.shape
    xb = x.reshape(Bt, S, LRU_BLOCKS, LRU_BW)
    y = jnp.einsum('bsnc,ncd->bsnd', xb, w).reshape(Bt, S, LRU_WIDTH)
    return y + b


def linear_recurrence(a, u):
    def step(h, au):
        a_t, u_t = au
        h = a_t * h + u_t
        return h, h
    h0 = jnp.zeros((a.shape[0], a.shape[2]), jnp.float32)
    _, hs = lax.scan(step, h0, (jnp.swapaxes(a, 0, 1), jnp.swapaxes(u, 0, 1)))
    return jnp.swapaxes(hs, 0, 1)


def rglru_block(h, w_in, conv_w, conv_b, w_r, b_r, w_i, b_i, lam, w_out):
    gate_br, rec = jnp.split(h @ w_in, 2, axis=-1)
    gate_br = jax.nn.gelu(gate_br)
    xc = causal_depthwise_conv(rec, conv_w, conv_b)
    r = jax.nn.sigmoid(block_diag_linear(xc, w_r, b_r))
    i = jax.nn.sigmoid(block_diag_linear(xc, w_i, b_i))
    log_a = -LRU_C * r.astype(jnp.float32) * jax.nn.softplus(-lam.astype(jnp.float32))
    a = jnp.exp(log_a)
    mult = jnp.sqrt(-jnp.expm1(2.0 * log_a))
    u = mult * (i * xc).astype(jnp.float32)
    hs = linear_recurrence(a, u)
    y = hs.astype(h.dtype) * gate_br
    return y @ w_out


def heads(t):
    Bt, S, _ = t.shape
    return t.reshape(Bt, S, N_HEADS, HEAD_DIM).transpose(0, 2, 1, 3)


def shared_kv(x, kv_gain, w_kv, k_gain):
    hkv = rms_norm(x, kv_gain)
    k, v = jnp.split(hkv @ w_kv, 2, axis=-1)
    k = rms_norm(heads(k), k_gain)
    return k, heads(v)


def stick_breaking_attention(q, k, v):
    S = q.shape[2]
    scale = HEAD_DIM ** -0.5
    outs = []
    for blk in range(S // Q_BLOCK):
        q0 = blk * Q_BLOCK
        end = q0 + Q_BLOCK
        z = jnp.einsum('bhqd,bhkd->bhqk', q[:, :, q0:end], k[:, :, :end]).astype(jnp.float32) * scale
        t_pos = q0 + jnp.arange(Q_BLOCK)[:, None]
        s_pos = jnp.arange(end)[None, :]
        mask = s_pos < t_pos
        log_stay = jnp.where(mask, -jax.nn.softplus(z), 0.0)
        stay_after = lax.cumsum(log_stay, axis=3, reverse=True) - log_stay
        log_w = jax.nn.log_sigmoid(z) + stay_after
        w = jnp.where(mask, jnp.exp(log_w), 0.0)
        o = jnp.einsum('bhqk,bhkd->bhqd', w, v[:, :, :end].astype(jnp.float32))
        outs.append(o.astype(v.dtype))
    return jnp.concatenate(outs, axis=2)


def stick_breaking_block(h, k, v, w_q, q_gain, w_o):
    q = rms_norm(heads(h @ w_q), q_gain)
    o = stick_breaking_attention(q, k, v)
    Bt, _, S, _ = o.shape
    o = o.transpose(0, 2, 1, 3).reshape(Bt, S, D_ATTN)
    return o @ w_o


def setup_inputs(seed: int = 0) -> dict:
    key = jax.random.key(seed)
    keys = jax.random.split(key, 32)
    counter = [0]
    f32 = jnp.float32

    def nk():
        k = keys[counter[0]]
        counter[0] += 1
        return k

    def w(shape, fan_in, scale=1.0):
        return jax.random.normal(nk(), shape, f32) * (scale * fan_in ** -0.5)

    def gain(shape):
        return 1.0 + 0.02 * jax.random.normal(nk(), shape, f32)

    def bias(shape):
        return 0.02 * jax.random.normal(nk(), shape, f32)

    a0 = jax.random.uniform(nk(), (N_A, LRU_WIDTH), f32, 0.9, 0.999)
    return {
        "x": jax.random.normal(nk(), (BATCH, SEQ, D_MODEL), f32),
        "ffn1_norm": gain((DEPTH, D_MODEL)),
        "ffn1_w13": w((DEPTH, D_MODEL, 2 * D_FF), D_MODEL),
        "ffn1_w2": w((DEPTH, D_FF, D_MODEL), D_FF, 0.5),
        "mix_norm": gain((DEPTH, D_MODEL)),
        "a_w_in": w((N_A, D_MODEL, 2 * LRU_WIDTH), D_MODEL),
        "a_conv_w": w((N_A, CONV_W, LRU_WIDTH), CONV_W),
        "a_conv_b": bias((N_A, LRU_WIDTH)),
        "a_w_r": w((N_A, LRU_BLOCKS, LRU_BW, LRU_BW), LRU_BW),
        "a_b_r": bias((N_A, LRU_WIDTH)),
        "a_w_i": w((N_A, LRU_BLOCKS, LRU_BW, LRU_BW), LRU_BW),
        "a_b_i": bias((N_A, LRU_WIDTH)),
        "a_lambda": jnp.log(a0) - jnp.log1p(-a0),
        "a_w_out": w((N_A, LRU_WIDTH, D_MODEL), LRU_WIDTH),
        "kv_norm": gain((D_MODEL,)),
        "w_kv": w((D_MODEL, 2 * D_ATTN), D_MODEL),
        "k_norm": gain((HEAD_DIM,)),
        "b_w_q": w((N_B, D_MODEL, D_ATTN), D_MODEL),
        "q_norm": gain((N_B, HEAD_DIM)),
        "b_w_o": w((N_B, D_ATTN, D_MODEL), D_ATTN),
        "ffn2_norm": gain((DEPTH, D_MODEL)),
        "ffn2_w13": w((DEPTH, D_MODEL, 2 * D_FF), D_MODEL),
        "ffn2_w2": w((DEPTH, D_FF, D_MODEL), D_FF, 0.5),
    }


def reference(x, ffn1_norm, ffn1_w13, ffn1_w2, mix_norm, a_w_in, a_conv_w, a_conv_b,
              a_w_r, a_b_r, a_w_i, a_b_i, a_lambda, a_w_out, kv_norm, w_kv, k_norm,
              b_w_q, q_norm, b_w_o, ffn2_norm, ffn2_w13, ffn2_w2):
    k_shared = None
    v_shared = None
    for l in range(DEPTH):
        if l == N_A:
            k_shared, v_shared = shared_kv(x, kv_norm, w_kv, k_norm)
        x = x + 0.5 * swiglu(rms_norm(x, ffn1_norm[l]), ffn1_w13[l], ffn1_w2[l])
        h = rms_norm(x, mix_norm[l])
        if l < N_A:
            x = x + rglru_block(h, a_w_in[l], a_conv_w[l], a_conv_b[l], a_w_r[l], a_b_r[l],
                                a_w_i[l], a_b_i[l], a_lambda[l], a_w_out[l])
        else:
            j = l - N_A
            x = x + stick_breaking_block(h, k_shared, v_shared, b_w_q[j], q_norm[j], b_w_o[j])
        x = x + 0.5 * swiglu(rms_norm(x, ffn2_norm[l]), ffn2_w13[l], ffn2_w2[l])
    return x
```

```cpp
#include <hip/hip_runtime.h>
#include <hip/hip_cooperative_groups.h>
#include <cstdio>
#include <cstdint>
#include <cmath>
namespace cg = cooperative_groups;

#ifndef MK_COOP
#define MK_COOP 1
#endif

#define LAS __attribute__((address_space(3)))
typedef unsigned short bf16_t;
typedef short bf16x8 __attribute__((ext_vector_type(8)));
typedef float f32x4 __attribute__((ext_vector_type(4)));
typedef float f32x2 __attribute__((ext_vector_type(2)));
typedef float f32x16 __attribute__((ext_vector_type(16)));
typedef unsigned u32x4 __attribute__((ext_vector_type(4)));
typedef unsigned u32x2 __attribute__((ext_vector_type(2)));

constexpr int BATCH = 4, SEQ = 4096, D = 1024, FF = 2816, NH = 16, HD = 64;
constexpr int M = BATCH * SEQ;
constexpr float EPS = 1e-6f;
constexpr float LOG2E = 1.4426950408889634f, LN2 = 0.6931471805599453f;

constexpr size_t MiB = 1u << 20, KiB = 1u << 10;
constexpr size_t WS_SS = 64 * KiB;
constexpr size_t WS_SP8 = 32 * KiB;
constexpr size_t WS_HL = 1 * MiB, WS_PC = 2 * MiB;
constexpr size_t SZ_W13 = (size_t)2 * FF * D * 2, SZ_W2 = (size_t)D * FF * 2;
constexpr size_t WS_WA13 = 4 * MiB, WS_WA2 = WS_WA13 + SZ_W13;
constexpr size_t WS_WB13 = WS_WA2 + SZ_W2, WS_WB2 = WS_WB13 + SZ_W13;
constexpr size_t WS_WKV = WS_WB2 + SZ_W2, WS_WC13 = WS_WKV + 4 * MiB, WS_WC2 = WS_WC13 + SZ_W13;
constexpr size_t WS_WIN = WS_WC2 + SZ_W2, WS_WRI = WS_WIN + 4 * MiB, WS_WOUT = WS_WRI + 1 * MiB, WS_WQ = WS_WOUT + 2 * MiB, WS_WO = WS_WQ + 2 * MiB;
constexpr size_t WS_XB = 69 * MiB;
constexpr size_t WS_ACT = 101 * MiB;
constexpr size_t WS_K = 189 * MiB, WS_VT = 221 * MiB, WS_END = 253 * MiB;
constexpr size_t WS_GB = WS_ACT, WS_U = WS_ACT + 32 * MiB, WS_REC = WS_ACT + 64 * MiB;
constexpr size_t WS_Y = WS_ACT + 96 * MiB;
constexpr size_t WS_Q = WS_ACT, WS_O = WS_ACT + 32 * MiB;
static_assert(WS_WO + 2 * MiB <= WS_XB && WS_REC + 64 * MiB <= WS_END, "ws map");

__device__ __forceinline__ unsigned cvt_pk_bf16(float lo, float hi) {
    typedef __bf16 bf16x2_t __attribute__((ext_vector_type(2)));
    f32x2 v = {lo, hi}; bf16x2_t b = __builtin_convertvector(v, bf16x2_t); return __builtin_bit_cast(unsigned, b);
}
__device__ __forceinline__ float bf_lo(unsigned w) { return __uint_as_float(w << 16); }
__device__ __forceinline__ float bf_hi(unsigned w) { return __uint_as_float(w & 0xffff0000u); }
__device__ __forceinline__ float sigm(float x) { return __builtin_amdgcn_rcpf(1.0f + __builtin_amdgcn_exp2f(-x * LOG2E)); }
__device__ __forceinline__ float gelu_tanh(float x) { return x * sigm(1.5957691216057308f * (x + 0.044715f * x * x * x)); }
__device__ __forceinline__ float wave_sum(float v) {
#pragma unroll
    for (int o = 1; o < 64; o <<= 1) v += __shfl_xor(v, o);
    return v;
}
#define LDS_WAIT() asm volatile("s_waitcnt lgkmcnt(0)" ::: "memory")

namespace pg8 {
constexpr int BM = 256, BK = 64, HALF = 128, HTB = HALF * BK * 2, STAGE_BYTES = 8 * HTB, NXCD = 8, WGM = 4;
__host__ __device__ __forceinline__ int lds_byte(int r, int c) { const int st = (r >> 4) * 2 + (c >> 5), rr = r & 15, cc = c & 31, ob = rr * 64 + cc * 2; return st * 1024 + (ob ^ (((ob >> 9) & 1) << 5)); }
__host__ __device__ __forceinline__ void stage_rc(int b, int& R, int& C) { const int st = b / 1024, sb = b % 1024, swz = sb ^ (((sb >> 9) & 1) << 5); R = (st >> 1) * 16 + swz / 64; C = (st & 1) * 32 + (swz % 64) / 2; }
__host__ __device__ __forceinline__ int perm32(int rho) { const int n = rho >> 4, i = rho & 15; return 8 * (i >> 2) + 4 * n + (i & 3); }

struct Unit { int pm, pn; };
struct Gemm { const bf16_t* A; const bf16_t* Bt; int M, N, K, lda, adiv; };

struct StaticOrder {
    int nM, nN, nwg, G, c;
    __device__ void init(int M_, int N_, int G_, int c_) { nM = M_ / BM; nN = N_ / BM; nwg = nM * nN; G = G_; c = c_; }
    __device__ bool next(int i, Unit& u) const {
        const long L = (long)i * G + c; if (L >= nwg) return false;
        int wgid = (int)L; { const int q = nwg / NXCD, r = nwg % NXCD, xcd = wgid % NXCD, off = wgid / NXCD; wgid = (xcd < r ? xcd * (q + 1) : r * (q + 1) + (xcd - r) * q) + off; }
        const int nig = WGM * nN, gid = wgid / nig, fm = gid * WGM, gsz = (nM - fm) < WGM ? (nM - fm) : WGM;
        u.pm = fm + ((wgid % nig) % gsz); u.pn = (wgid % nig) / gsz; return true;
    }
};

template <class Epi, bool ALIGN_EPI>
__device__ __forceinline__ void gemm_phase(LAS unsigned char* lds, const Gemm g, const StaticOrder& S, const Epi& E) {
    const int tid = threadIdx.x, wid = __builtin_amdgcn_readfirstlane(tid >> 6), lane = tid & 63, wr = wid >> 2, wc = wid & 3, fr = lane & 15, fq = lane >> 4;
    const int K = g.K, nt = K / BK, lda = g.lda;
    unsigned voffA[2], voffB[2];
#pragma unroll
    for (int i = 0; i < 2; ++i) { int R, C; stage_rc(tid * 16 + i * 8192, R, C); const int Rb = (R & ~31) + perm32(R & 31);
        voffA[i] = (unsigned)(R * lda + C) * 2u; voffB[i] = (unsigned)(Rb * K + C) * 2u; }
    const size_t kstep = (size_t)(BK * 2);
    const size_t hA = (size_t)HALF * lda * 2, hB = (size_t)HALF * K * 2;
    const size_t tA = 2 * hA, tB = 2 * hB;
    const unsigned ldsw = (unsigned)wid * 1024u;
    const int aoff = lds_byte(wr * 64 + fr, fq * 8), boff = lds_byte(wc * 32 + fr, fq * 8);
#define PG8_SA(b, h) (((b) * 2 + (h)) * HTB)
#define PG8_SB(b, h) ((4 + (b) * 2 + (h)) * HTB)
#define PG8_STAGE(bufoff, gbase, voff) do { _Pragma("unroll") for (int _i = 0; _i < 2; ++_i) \
        __builtin_amdgcn_global_load_lds((const unsigned*)((const char*)(gbase) + (voff)[_i]), (LAS unsigned*)(lds + (bufoff) + ldsw + _i * 8192), 16, 0, 0); } while (0)
#define PG8_LDA(dst, b, h) do { _Pragma("unroll") for (int m = 0; m < 4; ++m) _Pragma("unroll") for (int k = 0; k < 2; ++k) dst[m][k] = *(const LAS bf16x8*)(lds + PG8_SA(b, h) + aoff + m * 2048 + k * 1024); } while (0)
#define PG8_LDB(dst, b, h) do { _Pragma("unroll") for (int n = 0; n < 2; ++n) _Pragma("unroll") for (int k = 0; k < 2; ++k) dst[n][k] = *(const LAS bf16x8*)(lds + PG8_SB(b, h) + boff + n * 2048 + k * 1024); } while (0)
#define PG8_MMA(ai, bj, At, Bt) do { __builtin_amdgcn_s_setprio(1); _Pragma("unroll") for (int m = 0; m < 4; ++m) _Pragma("unroll") for (int n = 0; n < 2; ++n) _Pragma("unroll") for (int k = 0; k < 2; ++k) \
        acc[ai][bj][m][n] = __builtin_amdgcn_mfma_f32_16x16x32_bf16(Bt[n][k], At[m][k], acc[ai][bj][m][n], 0, 0, 0); __builtin_amdgcn_s_setprio(0); } while (0)
#define PG8_WAIT_V(n) asm volatile("s_waitcnt vmcnt(" #n ")" ::: "memory")
#define PG8_WAIT_L(n) asm volatile("s_waitcnt lgkmcnt(" #n ")" ::: "memory")
#define PG8_BAR __builtin_amdgcn_s_barrier()
#define PG8_SCHED __builtin_amdgcn_sched_barrier(0)
#define PG8_ABASE(u) ((const char*)g.A + (size_t)(u).pm * tA + (g.adiv ? (size_t)((u).pn / g.adiv) * K * 2 : (size_t)0))
#define PG8_BBASE(u) ((const char*)g.Bt + (size_t)(u).pn * tB)
    Unit cur, nxt; int ui = 0;
    if (!S.next(0, cur)) return;
    f32x4 acc[2][2][4][2];
#pragma unroll
    for (int a = 0; a < 2; ++a)
#pragma unroll
        for (int b = 0; b < 2; ++b)
#pragma unroll
            for (int m = 0; m < 4; ++m)
#pragma unroll
                for (int n = 0; n < 2; ++n) acc[a][b][m][n] = (f32x4){0.f, 0.f, 0.f, 0.f};
    bf16x8 At[4][2], B0[2][2], B1[2][2];
    const char* cA = PG8_ABASE(cur); const char* cB = PG8_BBASE(cur);
    PG8_STAGE(PG8_SB(0, 0), cB, voffB); PG8_STAGE(PG8_SB(0, 1), cB + hB, voffB); PG8_STAGE(PG8_SA(0, 0), cA, voffA); PG8_STAGE(PG8_SA(0, 1), cA + hA, voffA);
    if (wr == 1) PG8_BAR;
    PG8_WAIT_V(2); PG8_BAR;
    PG8_STAGE(PG8_SB(1, 0), cB + kstep, voffB); PG8_STAGE(PG8_SA(1, 0), cA + kstep, voffA); PG8_STAGE(PG8_SB(1, 1), cB + hB + kstep, voffB);
    PG8_WAIT_V(6); PG8_BAR;
    for (;;) {
        const bool has_next = S.next(ui + 1, nxt);
        const char* nA = has_next ? PG8_ABASE(nxt) : cA; const char* nB = has_next ? PG8_BBASE(nxt) : cB;
#pragma unroll 1
        for (int t = 0; t < nt; t += 2) {
            const bool last = (t == nt - 2);
            const char* a1 = cA + (size_t)(t + 1) * kstep;
            const char* a2 = last ? nA : cA + (size_t)(t + 2) * kstep; const char* b2 = last ? nB : cB + (size_t)(t + 2) * kstep;
            const char* a3 = a2 + kstep; const char* b3 = b2 + kstep;
            PG8_LDB(B0, 0, 0); PG8_LDB(B1, 0, 1); PG8_SCHED; PG8_LDA(At, 0, 0); PG8_STAGE(PG8_SA(1, 1), a1 + hA, voffA);
            PG8_WAIT_V(8); PG8_WAIT_L(0); PG8_BAR; PG8_MMA(0, 0, At, B0); PG8_MMA(0, 1, At, B1); PG8_BAR; PG8_SCHED;
            PG8_LDA(At, 0, 1); PG8_STAGE(PG8_SB(0, 0), b2, voffB); PG8_STAGE(PG8_SB(0, 1), b2 + hB, voffB); PG8_STAGE(PG8_SA(0, 0), a2, voffA);
            PG8_WAIT_V(8); PG8_WAIT_L(0); PG8_BAR; PG8_MMA(1, 0, At, B0); PG8_MMA(1, 1, At, B1); PG8_BAR; PG8_SCHED;
            PG8_LDB(B0, 1, 0); PG8_LDB(B1, 1, 1); PG8_SCHED; PG8_LDA(At, 1, 0); PG8_STAGE(PG8_SA(0, 1), a2 + hA, voffA);
            PG8_WAIT_V(8); PG8_WAIT_L(0); PG8_BAR; PG8_MMA(0, 0, At, B0); PG8_MMA(0, 1, At, B1); PG8_BAR; PG8_SCHED;
            PG8_LDA(At, 1, 1); PG8_STAGE(PG8_SB(1, 0), b3, voffB); PG8_STAGE(PG8_SB(1, 1), b3 + hB, voffB); PG8_STAGE(PG8_SA(1, 0), a3, voffA);
            PG8_WAIT_V(8); PG8_WAIT_L(0); PG8_BAR; PG8_MMA(1, 0, At, B0); PG8_MMA(1, 1, At, B1); PG8_BAR; PG8_SCHED;
        }
        if constexpr (ALIGN_EPI) { if (wr == 0) PG8_BAR; }
        E(acc, cur, wr, wc, fr, fq);
        if (!has_next) break;
#pragma unroll
        for (int a = 0; a < 2; ++a)
#pragma unroll
            for (int b = 0; b < 2; ++b)
#pragma unroll
                for (int m = 0; m < 4; ++m)
#pragma unroll
                    for (int n = 0; n < 2; ++n) acc[a][b][m][n] = (f32x4){0.f, 0.f, 0.f, 0.f};
        cur = nxt; cA = nA; cB = nB; ++ui;
        if constexpr (ALIGN_EPI) { if (wr == 1) PG8_BAR; }
    }
    PG8_WAIT_V(0);
    if constexpr (!ALIGN_EPI) { if (wr == 0) PG8_BAR; }
    PG8_BAR;
#undef PG8_SA
#undef PG8_SB
#undef PG8_STAGE
#undef PG8_LDA
#undef PG8_LDB
#undef PG8_MMA
#undef PG8_WAIT_V
#undef PG8_WAIT_L
#undef PG8_BAR
#undef PG8_SCHED
#undef PG8_ABASE
#undef PG8_BBASE
}

typedef f32x4 Acc[2][2][4][2];
__device__ __forceinline__ float rstd_of(const float* ss, int row) { return 1.0f / sqrtf(ss[row] * (1.0f / D) + EPS); }

__device__ __forceinline__ void rstd8(const float* ss, int rbase, float (&rs)[2][4]) {
    float t[2][4];
#pragma unroll
    for (int ai = 0; ai < 2; ++ai)
#pragma unroll
        for (int m = 0; m < 4; ++m) t[ai][m] = ss[rbase + ai * HALF + m * 16];
#pragma unroll
    for (int ai = 0; ai < 2; ++ai)
#pragma unroll
        for (int m = 0; m < 4; ++m) rs[ai][m] = 1.0f / sqrtf(t[ai][m] * (1.0f / D) + EPS);
}
__device__ __forceinline__ void epi_swiglu(const Acc& acc, int pm, int pnf, int wr, int wc, int fr, int fq, const float* ss, bf16_t* act) {
    const int col = pnf * 128 + wc * 32 + 8 * fq;
    float rs8[2][4]; rstd8(ss, pm * BM + wr * 64 + fr, rs8);
#pragma unroll
    for (int ai = 0; ai < 2; ++ai)
#pragma unroll
        for (int m = 0; m < 4; ++m) {
            const int row = pm * BM + ai * HALF + wr * 64 + m * 16 + fr; const float rs = rs8[ai][m];
            float o[8];
#pragma unroll
            for (int n = 0; n < 2; ++n)
#pragma unroll
                for (int j = 0; j < 4; ++j) { const float gt = acc[ai][0][m][n][j] * rs, up = acc[ai][1][m][n][j] * rs; o[n * 4 + j] = gt * sigm(gt) * up; }
            u32x4 w; w.x = cvt_pk_bf16(o[0], o[1]); w.y = cvt_pk_bf16(o[2], o[3]); w.z = cvt_pk_bf16(o[4], o[5]); w.w = cvt_pk_bf16(o[6], o[7]);
            __builtin_nontemporal_store(w, (u32x4*)(act + (size_t)row * FF + col));
        }
}
struct EpiSwiglu { const float* ss; bf16_t* act;
    __device__ __forceinline__ void operator()(const Acc& acc, const Unit& u, int wr, int wc, int fr, int fq) const { epi_swiglu(acc, u.pm, u.pn, wr, wc, fr, fq, ss, act); } };

template <bool IN_F32, bool FINAL> struct EpiResid { const float* xin; float* xout; bf16_t* xb; float* ssn; float alpha;
    __device__ __forceinline__ void operator()(const Acc& acc, const Unit& u, int wr, int wc, int fr, int fq) const {
        const size_t cbase = (size_t)u.pn * BM + wc * 32 + 8 * fq;
#pragma unroll
        for (int ai = 0; ai < 2; ++ai) {
            f32x4 xr[4][2][2];
#pragma unroll
            for (int m = 0; m < 4; ++m)
#pragma unroll
                for (int bj = 0; bj < 2; ++bj) {
                    const size_t off = (size_t)(u.pm * BM + ai * HALF + wr * 64 + m * 16 + fr) * D + cbase + bj * HALF;
                    if (IN_F32) { xr[m][bj][0] = *(const f32x4*)(xin + off); xr[m][bj][1] = *(const f32x4*)(xin + off + 4); }
                    else { const u32x4 xw = *(const u32x4*)(xb + off); xr[m][bj][0] = __builtin_bit_cast(f32x4, xw); }
                }
#pragma unroll
            for (int m = 0; m < 4; ++m) {
                const int row = u.pm * BM + ai * HALF + wr * 64 + m * 16 + fr; float sq = 0.f;
#pragma unroll
                for (int bj = 0; bj < 2; ++bj) {
                    const size_t off = (size_t)row * D + cbase + bj * HALF;
                    f32x4 x0, x1;
                    if (IN_F32) { x0 = xr[m][bj][0]; x1 = xr[m][bj][1]; }
                    else { const u32x4 xw = __builtin_bit_cast(u32x4, xr[m][bj][0]); x0 = (f32x4){bf_lo(xw.x), bf_hi(xw.x), bf_lo(xw.y), bf_hi(xw.y)}; x1 = (f32x4){bf_lo(xw.z), bf_hi(xw.z), bf_lo(xw.w), bf_hi(xw.w)}; }
                    const f32x4 y0 = x0 + acc[ai][bj][m][0] * alpha, y1 = x1 + acc[ai][bj][m][1] * alpha;
                    if (FINAL) { *(f32x4*)(xout + off) = y0; *(f32x4*)(xout + off + 4) = y1; }
                    else {
                        sq += (y0[0] * y0[0] + y0[1] * y0[1]) + (y0[2] * y0[2] + y0[3] * y0[3]) + (y1[0] * y1[0] + y1[1] * y1[1]) + (y1[2] * y1[2] + y1[3] * y1[3]);
                        u32x4 w; w.x = cvt_pk_bf16(y0[0], y0[1]); w.y = cvt_pk_bf16(y0[2], y0[3]); w.z = cvt_pk_bf16(y1[0], y1[1]); w.w = cvt_pk_bf16(y1[2], y1[3]);
                        *(u32x4*)(xb + off) = w;
                    }
                }
                if (!FINAL) { sq += __shfl_xor(sq, 16); sq += __shfl_xor(sq, 32); if (fq == 0) atomicAdd(ssn + row, sq); }
            }
        }
    } };
typedef EpiResid<true, false> EpiResidIn; typedef EpiResid<false, false> EpiResidMid; typedef EpiResid<false, true> EpiResidOut;

struct EpiWin { const float* ss; bf16_t* gb; bf16_t* rec;
    __device__ __forceinline__ void operator()(const Acc& acc, const Unit& u, int wr, int wc, int fr, int fq) const {
        const bool isg = u.pn < 4; const int ct = (u.pn & 3) * BM;
        float rs8[2][4]; rstd8(ss, u.pm * BM + wr * 64 + fr, rs8);
#pragma unroll
        for (int ai = 0; ai < 2; ++ai)
#pragma unroll
            for (int m = 0; m < 4; ++m) {
                const int row = u.pm * BM + ai * HALF + wr * 64 + m * 16 + fr; const float rs = rs8[ai][m];
#pragma unroll
                for (int bj = 0; bj < 2; ++bj) {
                    const size_t off = (size_t)row * D + ct + bj * HALF + wc * 32 + 8 * fq;
                    const f32x4 v0 = acc[ai][bj][m][0] * rs, v1 = acc[ai][bj][m][1] * rs;
                    if (isg) { u32x4 w; w.x = cvt_pk_bf16(gelu_tanh(v0[0]), gelu_tanh(v0[1])); w.y = cvt_pk_bf16(gelu_tanh(v0[2]), gelu_tanh(v0[3]));
                        w.z = cvt_pk_bf16(gelu_tanh(v1[0]), gelu_tanh(v1[1])); w.w = cvt_pk_bf16(gelu_tanh(v1[2]), gelu_tanh(v1[3])); *(u32x4*)(gb + off) = w; }
                    else { u32x4 w; w.x = cvt_pk_bf16(v0[0], v0[1]); w.y = cvt_pk_bf16(v0[2], v0[3]); w.z = cvt_pk_bf16(v1[0], v1[1]); w.w = cvt_pk_bf16(v1[2], v1[3]); *(u32x4*)(rec + off) = w; }
                }
            }
    } };

struct EpiGate { const bf16_t* xc; const float* b_r; const float* b_i; const float* sp8; bf16_t* aout; bf16_t* uout;
    __device__ __forceinline__ void operator()(const Acc& acc, const Unit& u, int wr, int wc, int fr, int fq) const {
        const int ch = u.pn * 128 + wc * 32 + 8 * fq;
        float br[8], bi[8], sp[8];
#pragma unroll
        for (int n = 0; n < 2; ++n) { const f32x4 a_ = *(const f32x4*)(b_r + ch + 4 * n), b_ = *(const f32x4*)(b_i + ch + 4 * n), c_ = *(const f32x4*)(sp8 + ch + 4 * n);
#pragma unroll
            for (int j = 0; j < 4; ++j) { br[4 * n + j] = a_[j]; bi[4 * n + j] = b_[j]; sp[4 * n + j] = c_[j]; } }
        u32x4 xcw[2][4];
#pragma unroll
        for (int ai = 0; ai < 2; ++ai)
#pragma unroll
            for (int m = 0; m < 4; ++m) xcw[ai][m] = *(const u32x4*)(xc + (size_t)(u.pm * BM + ai * HALF + wr * 64 + m * 16 + fr) * D + ch);
#pragma unroll
        for (int ai = 0; ai < 2; ++ai)
#pragma unroll
            for (int m = 0; m < 4; ++m) {
                const int row = u.pm * BM + ai * HALF + wr * 64 + m * 16 + fr; const size_t off = (size_t)row * D + ch;
                const u32x4 xw = xcw[ai][m];
                const float xv[8] = {bf_lo(xw.x), bf_hi(xw.x), bf_lo(xw.y), bf_hi(xw.y), bf_lo(xw.z), bf_hi(xw.z), bf_lo(xw.w), bf_hi(xw.w)};
                float av[8], uv[8];
#pragma unroll
                for (int j = 0; j < 8; ++j) {
                    const float r = sigm(acc[ai][0][m][j >> 2][j & 3] + br[j]), ig = sigm(acc[ai][1][m][j >> 2][j & 3] + bi[j]);
                    const float la2 = r * sp[j];
                    const float a = __builtin_amdgcn_exp2f(la2);
                    av[j] = la2; uv[j] = __builtin_amdgcn_sqrtf(fmaxf(1.0f - a * a, 0.f)) * ig * xv[j];
                }
                u32x4 wa; wa.x = cvt_pk_bf16(av[0], av[1]); wa.y = cvt_pk_bf16(av[2], av[3]); wa.z = cvt_pk_bf16(av[4], av[5]); wa.w = cvt_pk_bf16(av[6], av[7]);
                *(u32x4*)(aout + off) = wa;
                u32x4 w; w.x = cvt_pk_bf16(uv[0], uv[1]); w.y = cvt_pk_bf16(uv[2], uv[3]); w.z = cvt_pk_bf16(uv[4], uv[5]); w.w = cvt_pk_bf16(uv[6], uv[7]);
                *(u32x4*)(uout + off) = w;
            }
    } };

__device__ __forceinline__ void epi_headnorm(const Acc& acc, int pm, int pnh, int wr, int wc, int fr, int fq, const float* ss, const float* gain, float oscale, bf16_t* out) {
    const int head = 4 * pnh + wc;
    float sc[2][4]; rstd8(ss, pm * BM + wr * 64 + fr, sc);
#pragma unroll
    for (int ai = 0; ai < 2; ++ai)
#pragma unroll
        for (int m = 0; m < 4; ++m) {
            const float rs = sc[ai][m];
            float sq = 0.f;
#pragma unroll
            for (int bj = 0; bj < 2; ++bj)
#pragma unroll
                for (int n = 0; n < 2; ++n) { const f32x4 v = acc[ai][bj][m][n]; sq += (v[0] * v[0] + v[1] * v[1]) + (v[2] * v[2] + v[3] * v[3]); }
            sq += __shfl_xor(sq, 16); sq += __shfl_xor(sq, 32);
            sc[ai][m] = rs * oscale / sqrtf(sq * rs * rs * (1.0f / HD) + EPS);
        }
#pragma unroll
    for (int bj = 0; bj < 2; ++bj) {
        const f32x4 g0 = *(const f32x4*)(gain + 32 * bj + 8 * fq), g1 = *(const f32x4*)(gain + 32 * bj + 8 * fq + 4);
#pragma unroll
        for (int ai = 0; ai < 2; ++ai)
#pragma unroll
            for (int m = 0; m < 4; ++m) {
                const int row = pm * BM + ai * HALF + wr * 64 + m * 16 + fr;
                const f32x4 v0 = acc[ai][bj][m][0] * g0 * sc[ai][m], v1 = acc[ai][bj][m][1] * g1 * sc[ai][m];
                u32x4 w; w.x = cvt_pk_bf16(v0[0], v0[1]); w.y = cvt_pk_bf16(v0[2], v0[3]); w.z = cvt_pk_bf16(v1[0], v1[1]); w.w = cvt_pk_bf16(v1[2], v1[3]);
                *(u32x4*)(out + (size_t)row * D + head * HD + 32 * bj + 8 * fq) = w;
                asm volatile("" ::: "memory");
            }
    }
}
struct EpiQ { const float* ss; const float* gain; bf16_t* q;
    __device__ __forceinline__ void operator()(const Acc& acc, const Unit& u, int wr, int wc, int fr, int fq) const { epi_headnorm(acc, u.pm, u.pn, wr, wc, fr, fq, ss, gain, 0.125f * LOG2E, q); } };
struct EpiKvSwiglu { const float* ss; const float* kgain; bf16_t* kout; bf16_t* vt; bf16_t* act;
    __device__ __forceinline__ void operator()(const Acc& acc, const Unit& u, int wr, int wc, int fr, int fq) const {
        if (u.pn >= 8) { epi_swiglu(acc, u.pm, u.pn - 8, wr, wc, fr, fq, ss, act); return; }
        if (u.pn < 4) { epi_headnorm(acc, u.pm, u.pn, wr, wc, fr, fq, ss, kgain, 1.0f, kout); return; }
        const int head = 4 * (u.pn - 4) + wc;
        float rs8[2][4]; rstd8(ss, u.pm * BM + wr * 64 + fr, rs8);
        const int row0 = u.pm * BM + wr * 64 + fr, b = row0 / SEQ, s0 = row0 % SEQ;
        bf16_t* base = vt + ((size_t)(b * NH + head) * HD + 8 * fq) * SEQ + s0;
#pragma unroll
        for (int bj = 0; bj < 2; ++bj)
#pragma unroll
            for (int j = 0; j < 8; ++j) {
                bf16_t* p = base + (size_t)(32 * bj + j) * SEQ;
#pragma unroll
                for (int ai = 0; ai < 2; ++ai)
#pragma unroll
                    for (int m = 0; m < 4; ++m) p[ai * HALF + m * 16] = (bf16_t)(cvt_pk_bf16(acc[ai][bj][m][j >> 2][j & 3] * rs8[ai][m], 0.f) & 0xffffu);
                asm volatile("" ::: "memory");
            }
    } };
}


#define XB_TMO      128
#define XB_XCNT(j)  (256  + 64 * (j))
#define XB_XSUB(j)  (1280 + 64 * (j))
#define XB_XGEN(j)  (2304 + 64 * (j))
#define XB_TOP      3328
#define XB_TOPGEN   3392
#define XCD_BAR_WORDS 3456
#define XB_SPIN_CAP (1u << 18)
__device__ __forceinline__ unsigned xb_ld(unsigned* p)              { return __hip_atomic_load(p, __ATOMIC_RELAXED, __HIP_MEMORY_SCOPE_AGENT); }
__device__ __forceinline__ unsigned xb_add(unsigned* p, unsigned v) { return __hip_atomic_fetch_add(p, v, __ATOMIC_RELAXED, __HIP_MEMORY_SCOPE_AGENT); }
__device__ __forceinline__ unsigned xb_xcc_id() { return (unsigned)__builtin_amdgcn_s_getreg((3 << 11) | 20) & 0xFu; }
#define XB_SPIN(cond, bar) do { unsigned _sp = 0; while (cond) { __builtin_amdgcn_s_sleep(1); \
    if ((++_sp & 255u) == 0u) { if (xb_ld(&(bar)[XB_TMO])) break; if (_sp > XB_SPIN_CAP) { atomicAdd(&(bar)[XB_TMO], 1u); break; } } } } while (0)
struct XcdBarrier { unsigned* bar; unsigned x; volatile LAS unsigned* st; };
__device__ __forceinline__ XcdBarrier xcd_barrier_post(unsigned* bar, volatile LAS unsigned* st) {
    XcdBarrier b; b.bar = bar; b.x = xb_xcc_id(); b.st = st;
    if (threadIdx.x == 0) (void)xb_add(&bar[XB_XCNT(b.x)], 1u);
    return b;
}
__device__ __forceinline__ void xcd_barrier_complete(unsigned* bar, unsigned x, unsigned& nloc, unsigned& nx) {
    const unsigned G = gridDim.x * gridDim.y * gridDim.z;
    unsigned sum, cnt, mine, sp = 0u;
    for (;;) {
        sum = 0u; cnt = 0u; mine = 0u;
#pragma unroll
        for (unsigned j = 0; j < 16; ++j) { const unsigned c = xb_ld(&bar[XB_XCNT(j)]); sum += c; cnt += (c > 0u) ? 1u : 0u; mine = (j == x) ? c : mine; }
        if (sum == G) break;
        __builtin_amdgcn_s_sleep(1);
        if ((++sp & 255u) == 0u) { if (xb_ld(&bar[XB_TMO])) break; if (sp > XB_SPIN_CAP) { atomicAdd(&bar[XB_TMO], 1u); break; } }
    }
    nloc = mine > 0u ? mine : 1u; nx = cnt > 0u ? cnt : 1u;
}
__device__ __forceinline__ void xcd_barrier(const XcdBarrier& b) {
    asm volatile("s_waitcnt vmcnt(0)" ::: "memory");
    __syncthreads();
    if (threadIdx.x == 0) {
        unsigned* bar = b.bar;
        __builtin_amdgcn_s_waitcnt(0);
        unsigned nloc = b.st[0], nx = b.st[1];
        if (nloc == 0u) { xcd_barrier_complete(bar, b.x, nloc, nx); b.st[0] = nloc; b.st[1] = nx; }
        const unsigned old = xb_add(&bar[XB_XSUB(b.x)], 1u);
        const unsigned gen = old / nloc;
        if (old + 1u == (gen + 1u) * nloc) {
            __builtin_amdgcn_fence(__ATOMIC_RELEASE, "agent");
            asm volatile("s_waitcnt vmcnt(0)" ::: "memory");
            const unsigned og = xb_add(&bar[XB_TOP], 1u);
            const unsigned tg = og / nx;
            if (og + 1u == (tg + 1u) * nx) xb_add(&bar[XB_TOPGEN], 1u);
            else XB_SPIN(xb_ld(&bar[XB_TOPGEN]) == tg, bar);
            __builtin_amdgcn_fence(__ATOMIC_ACQUIRE, "agent");
            xb_add(&bar[XB_XGEN(b.x)], 1u);
            asm volatile("s_waitcnt vmcnt(0)" ::: "memory");
        } else {
            XB_SPIN(xb_ld(&bar[XB_XGEN(b.x)]) == gen, bar);
            __builtin_amdgcn_fence(__ATOMIC_ACQUIRE, "agent");
            asm volatile("s_waitcnt vmcnt(0)" ::: "memory");
        }
    }
    __syncthreads();
}

constexpr int N_PHASES = 18;
constexpr int NWAVES = 8, NTHR = NWAVES * 64;
constexpr int MISC_OFF = 8 * 16896, LDS_BYTES = MISC_OFF + 256;

struct Args { const float* in[23]; float* out; unsigned char* ws; int ph_lo, ph_hi; };

struct Frame { LAS unsigned char* lds; int tid, lane, wave, G, gw, NGW; };

struct CvtDesc { const float* W; const float* W2; bf16_t* dst; const float* gain; int ldw, K, nb, mode; };
constexpr int SCR_STRIDE = 64 * 65 * 4;
__device__ __forceinline__ void cvt_item(const CvtDesc& d, int local, LAS float* scr, int lane) {
    const int kb = local / d.nb, gI = local % d.nb, k0 = 64 * kb, n0 = 64 * gI;
    const int l16 = lane & 15, l4 = lane >> 4, n = n0 + 4 * l16;
    const float* W = d.W; int c0;
    if (d.mode == 0) c0 = n;
    else if (d.mode == 1) { const int tile = n >> 8, bj = (n >> 7) & 1, j0 = n & 127; c0 = bj * FF + tile * 128 + j0; }
    else if (d.mode == 2) { const int pn = n >> 8, bj = (n >> 7) & 1, wc = (n >> 5) & 3, j0 = n & 31; c0 = 256 * pn + 64 * wc + 32 * bj + j0; }
    else { const int t = n >> 8, blk = t >> 1, half = t & 1, which = (n >> 7) & 1, j0 = n & 127; W = (which ? d.W2 : d.W) + (size_t)blk * 65536; c0 = half * 128 + j0; }
    const float* wp = W + (size_t)(k0 + l4) * d.ldw + c0;
    f32x4 v[16];
#pragma unroll
    for (int i = 0; i < 16; ++i) v[i] = *(const f32x4*)(wp + (size_t)(4 * i) * d.ldw);
    if (d.gain) {
#pragma unroll
        for (int i = 0; i < 16; ++i) v[i] *= d.gain[k0 + 4 * i + l4];
    }
#pragma unroll
    for (int i = 0; i < 16; ++i) { LAS float* s = scr + (4 * i + l4) * 65 + 4 * l16; s[0] = v[i][0]; s[1] = v[i][1]; s[2] = v[i][2]; s[3] = v[i][3]; }
    LDS_WAIT(); asm volatile("" ::: "memory");
    const int c = lane & 7;
#pragma unroll
    for (int j = 0; j < 8; ++j) { const int nn = (lane >> 3) + 8 * j; const LAS float* s = scr + (8 * c) * 65 + nn;
        u32x4 o; o.x = cvt_pk_bf16(s[0 * 65], s[1 * 65]); o.y = cvt_pk_bf16(s[2 * 65], s[3 * 65]); o.z = cvt_pk_bf16(s[4 * 65], s[5 * 65]); o.w = cvt_pk_bf16(s[6 * 65], s[7 * 65]);
        *(u32x4*)(d.dst + (size_t)(n0 + nn) * d.K + k0 + 8 * c) = o; }
    LDS_WAIT(); asm volatile("" ::: "memory");
}
enum { I_X = 0, I_F1N, I_F1W13, I_F1W2, I_MIXN, I_AWIN, I_ACW, I_ACB, I_AWR, I_ABR, I_AWI, I_ABI, I_ALAM, I_AWOUT, I_KVN, I_WKV, I_KN, I_BWQ, I_QN, I_BWO, I_F2N, I_F2W13, I_F2W2 };
constexpr int IT_W13 = (D / 64) * (2 * FF / 64), IT_W2 = (FF / 64) * (D / 64), IT_2048 = (D / 64) * (2048 / 64), IT_1024 = (D / 64) * (D / 64), IT_RI = (256 / 64) * (2048 / 64);
__device__ __forceinline__ CvtDesc cvt_desc(const Args& a, int id) {
    unsigned char* ws = a.ws; CvtDesc d; d.W2 = nullptr; d.gain = nullptr;
    switch (id) {
    case 0: d = {a.in[I_F1W13], nullptr, (bf16_t*)(ws + WS_WA13), a.in[I_F1N], 2 * FF, D, 2 * FF / 64, 1}; break;
    case 1: d = {a.in[I_F1W2], nullptr, (bf16_t*)(ws + WS_WA2), nullptr, D, FF, D / 64, 0}; break;
    case 2: d = {a.in[I_F2W13], nullptr, (bf16_t*)(ws + WS_WB13), a.in[I_F2N], 2 * FF, D, 2 * FF / 64, 1}; break;
    case 3: d = {a.in[I_F2W2], nullptr, (bf16_t*)(ws + WS_WB2), nullptr, D, FF, D / 64, 0}; break;
    case 4: d = {a.in[I_WKV], nullptr, (bf16_t*)(ws + WS_WKV), a.in[I_KVN], 2048, D, 2048 / 64, 2}; break;
    case 5: d = {a.in[I_F1W13] + (size_t)D * 2 * FF, nullptr, (bf16_t*)(ws + WS_WC13), a.in[I_F1N] + D, 2 * FF, D, 2 * FF / 64, 1}; break;
    case 6: d = {a.in[I_F1W2] + (size_t)FF * D, nullptr, (bf16_t*)(ws + WS_WC2), nullptr, D, FF, D / 64, 0}; break;
    case 7: d = {a.in[I_AWIN], nullptr, (bf16_t*)(ws + WS_WIN), a.in[I_MIXN], 2048, D, 2048 / 64, 0}; break;
    case 8: d = {a.in[I_AWR], a.in[I_AWI], (bf16_t*)(ws + WS_WRI), nullptr, 256, 256, 2048 / 64, 3}; break;
    case 9: d = {a.in[I_AWOUT], nullptr, (bf16_t*)(ws + WS_WOUT), nullptr, D, D, D / 64, 0}; break;
    case 10: d = {a.in[I_BWQ], nullptr, (bf16_t*)(ws + WS_WQ), a.in[I_MIXN] + D, D, D, D / 64, 2}; break;
    case 11: d = {a.in[I_BWO], nullptr, (bf16_t*)(ws + WS_WO), nullptr, D, D, D / 64, 0}; break;
    case 12: d = {a.in[I_F2W13] + (size_t)D * 2 * FF, nullptr, (bf16_t*)(ws + WS_WA13), a.in[I_F2N] + D, 2 * FF, D, 2 * FF / 64, 1}; break;
    default: d = {a.in[I_F2W2] + (size_t)FF * D, nullptr, (bf16_t*)(ws + WS_WA2), nullptr, D, FF, D / 64, 0}; break;
    }
    return d;
}
__device__ __forceinline__ int cvt_items(int id) {
    switch (id) { case 0: case 2: case 5: case 12: return IT_W13; case 1: case 3: case 6: case 13: return IT_W2; case 4: case 7: return IT_2048; case 8: return IT_RI; default: return IT_1024; }
}
__device__ __forceinline__ void cvt_range(const Args& a, const Frame& F, int id_lo, int id_hi, int wg_lo, int wg_n) {
    LAS float* scr = (LAS float*)(F.lds + F.wave * 16896);
    int total = 0; for (int id = id_lo; id < id_hi; ++id) total += cvt_items(id);
    const int rank = (int)blockIdx.x - wg_lo; if (rank < 0 || rank >= wg_n) return;
    for (int it = rank * NWAVES + F.wave; it < total; it += wg_n * NWAVES) {
        int r = it, id = id_lo; while (r >= cvt_items(id)) { r -= cvt_items(id); ++id; }
        const CvtDesc d = cvt_desc(a, id); cvt_item(d, r, scr, F.lane);
    }
}

__device__ __forceinline__ void p0_rows(const Args& a, const Frame& F) {
    const float* x = a.in[I_X]; bf16_t* xb = (bf16_t*)(a.ws + WS_XB); float* ss = (float*)(a.ws + WS_SS);
    for (int m = F.gw; m < M; m += 2 * F.NGW) {
        const int m2 = m + F.NGW;
        const bool has2 = m2 < M;
        const f32x4* xr = (const f32x4*)(x + (size_t)m * D) + F.lane; const f32x4* xr2 = (const f32x4*)(x + (size_t)(has2 ? m2 : m) * D) + F.lane;
        f32x4 v[4], v2[4]; float s = 0.f, s2 = 0.f;
#pragma unroll
        for (int j = 0; j < 4; ++j) { v[j] = xr[64 * j]; v2[j] = xr2[64 * j]; }
#pragma unroll
        for (int j = 0; j < 4; ++j) { s += (v[j][0] * v[j][0] + v[j][1] * v[j][1]) + (v[j][2] * v[j][2] + v[j][3] * v[j][3]); s2 += (v2[j][0] * v2[j][0] + v2[j][1] * v2[j][1]) + (v2[j][2] * v2[j][2] + v2[j][3] * v2[j][3]); }
        s = wave_sum(s); s2 = wave_sum(s2);
        u32x2* o = (u32x2*)(xb + (size_t)m * D) + F.lane; u32x2* o2 = (u32x2*)(xb + (size_t)m2 * D) + F.lane;
#pragma unroll
        for (int j = 0; j < 4; ++j) { u32x2 w; w.x = cvt_pk_bf16(v[j][0], v[j][1]); w.y = cvt_pk_bf16(v[j][2], v[j][3]); o[64 * j] = w;
            if (has2) { u32x2 w2; w2.x = cvt_pk_bf16(v2[j][0], v2[j][1]); w2.y = cvt_pk_bf16(v2[j][2], v2[j][3]); o2[64 * j] = w2; } }
        if (F.lane == 0) { ss[m] = s; if (has2) ss[m2] = s2; }
    }
    for (int i = blockIdx.x * NTHR + F.tid; i < 5 * M; i += F.G * NTHR) ss[M + i] = 0.f;
    if (blockIdx.x == 0) for (int c = F.tid; c < D; c += NTHR) { const float l = a.in[I_ALAM][c]; ((float*)(a.ws + WS_SP8))[c] = -8.0f * LOG2E * (fmaxf(-l, 0.f) + log1pf(expf(-fabsf(l)))); }
}

__device__ __forceinline__ void conv_phase(const Args& a, const Frame& F) {
    const bf16_t* rec = (const bf16_t*)(a.ws + WS_REC); bf16_t* xc = (bf16_t*)(a.ws + WS_Y);
    constexpr int CR = 16, NITEM = (M / CR) * 4;
    for (int it = F.gw; it < NITEM; it += F.NGW) {
        const int cq = it & 3, m0 = (it >> 2) * CR, t0 = m0 & (SEQ - 1), ch = cq * 256 + 4 * F.lane;
        f32x4 w[4];
#pragma unroll
        for (int k = 0; k < 4; ++k) w[k] = *(const f32x4*)(a.in[I_ACW] + k * D + ch);
        const f32x4 bv = *(const f32x4*)(a.in[I_ACB] + ch);
        u32x2 rw[CR + 3];
#pragma unroll
        for (int i = 0; i < CR + 3; ++i) { const int r = m0 - 3 + i; rw[i] = (i >= 3 || t0 > 0) ? *(const u32x2*)(rec + (size_t)r * D + ch) : (u32x2){0u, 0u}; }
#pragma unroll
        for (int i = 0; i < CR; ++i) {
            f32x4 y = bv;
#pragma unroll
            for (int k = 0; k < 4; ++k) { const u32x2 q = rw[i + k]; y += w[k] * (f32x4){bf_lo(q.x), bf_hi(q.x), bf_lo(q.y), bf_hi(q.y)}; }
            u32x2 o; o.x = cvt_pk_bf16(y[0], y[1]); o.y = cvt_pk_bf16(y[2], y[3]); *(u32x2*)(xc + (size_t)(m0 + i) * D + ch) = o;
        }
    }
}

constexpr int SC_L = 64, SC_C = SEQ / SC_L;
__device__ __forceinline__ void scan_a(const Args& a, const Frame& F) {
    const bf16_t* av = (const bf16_t*)(a.ws + WS_REC); const bf16_t* uv = (const bf16_t*)(a.ws + WS_U);
    f32x4* hl = (f32x4*)(a.ws + WS_HL); f32x4* pc = (f32x4*)(a.ws + WS_PC);
    if (F.tid >= 256) return;
    for (int item = blockIdx.x * 256 + F.tid; item < BATCH * SC_C * 256; item += F.G * 256) {
        const int cgp = item & 255, bc = item >> 8; const size_t row0 = (size_t)bc * SC_L;
        f32x4 h = {0.f, 0.f, 0.f, 0.f}, p = {1.f, 1.f, 1.f, 1.f};
#pragma unroll 8
        for (int t = 0; t < SC_L; ++t) { const u32x2 aw = *(const u32x2*)(av + (row0 + t) * D + 4 * cgp); const f32x4 aa = {__builtin_amdgcn_exp2f(bf_lo(aw.x)), __builtin_amdgcn_exp2f(bf_hi(aw.x)), __builtin_amdgcn_exp2f(bf_lo(aw.y)), __builtin_amdgcn_exp2f(bf_hi(aw.y))}; const u32x2 uw = *(const u32x2*)(uv + (row0 + t) * D + 4 * cgp);
            const f32x4 uu = {bf_lo(uw.x), bf_hi(uw.x), bf_lo(uw.y), bf_hi(uw.y)}; h = aa * h + uu; p = p * aa; }
        hl[item] = h; pc[item] = p;
    }
}
__device__ __forceinline__ void scan_b(const Args& a, const Frame& F) {
    const bf16_t* av = (const bf16_t*)(a.ws + WS_REC); const bf16_t* uv = (const bf16_t*)(a.ws + WS_U); const bf16_t* gb = (const bf16_t*)(a.ws + WS_GB); bf16_t* yb = (bf16_t*)(a.ws + WS_Y);
    const f32x4* hl = (const f32x4*)(a.ws + WS_HL); const f32x4* pc = (const f32x4*)(a.ws + WS_PC);
    if (F.tid >= 256) return;
    for (int item = blockIdx.x * 256 + F.tid; item < BATCH * SC_C * 256; item += F.G * 256) {
        const int cgp = item & 255, bc = item >> 8, ck = bc & (SC_C - 1), b0 = bc - ck; const size_t row0 = (size_t)bc * SC_L;
        f32x4 h = {0.f, 0.f, 0.f, 0.f};
        int j = 0;
        for (; j + 8 <= ck; j += 8) {
            f32x4 pp[8], hh[8];
#pragma unroll
            for (int e = 0; e < 8; ++e) { pp[e] = pc[(b0 + j + e) * 256 + cgp]; hh[e] = hl[(b0 + j + e) * 256 + cgp]; }
#pragma unroll
            for (int e = 0; e < 8; ++e) h = pp[e] * h + hh[e];
        }
        for (; j < ck; ++j) h = pc[(b0 + j) * 256 + cgp] * h + hl[(b0 + j) * 256 + cgp];
#pragma unroll 8
        for (int t = 0; t < SC_L; ++t) { const size_t off = (row0 + t) * D + 4 * cgp; const u32x2 aw = *(const u32x2*)(av + off); const f32x4 aa = {__builtin_amdgcn_exp2f(bf_lo(aw.x)), __builtin_amdgcn_exp2f(bf_hi(aw.x)), __builtin_amdgcn_exp2f(bf_lo(aw.y)), __builtin_amdgcn_exp2f(bf_hi(aw.y))}; const u32x2 uw = *(const u32x2*)(uv + off);
            const f32x4 uu = {bf_lo(uw.x), bf_hi(uw.x), bf_lo(uw.y), bf_hi(uw.y)}; h = aa * h + uu;
            const u32x2 gw = *(const u32x2*)(gb + off); u32x2 o; o.x = cvt_pk_bf16(h[0] * bf_lo(gw.x), h[1] * bf_hi(gw.x)); o.y = cvt_pk_bf16(h[2] * bf_lo(gw.y), h[3] * bf_hi(gw.y));
            *(u32x2*)(yb + off) = o; }
    }
}

constexpr float SB_TINY = 5.42e-20f;
struct SbFrag { bf16x8 kf[4]; bf16x8 vf[2][2]; };
constexpr int ATT_KSTR = 1088, ATT_VOFF = 4 * ATT_KSTR, ATT_SLOT = ATT_VOFF + 4096, WAVE_LDS = 2 * ATT_SLOT;
__device__ __forceinline__ void sb_dma(LAS unsigned char* slot, const bf16_t* kg, const bf16_t* vg, int k0) {
    const bf16_t* k = kg + (size_t)k0 * D; const bf16_t* v = vg + k0;
#define SB_GLDS(g, o) __builtin_amdgcn_global_load_lds((const unsigned*)(g), (LAS unsigned*)(slot + (o)), 16, 0, 0)
    SB_GLDS(k, 0); SB_GLDS(k + 8 * D, ATT_KSTR); SB_GLDS(k + 16 * D, 2 * ATT_KSTR); SB_GLDS(k + 24 * D, 3 * ATT_KSTR);
    SB_GLDS(v, ATT_VOFF); SB_GLDS(v + (size_t)16 * SEQ, ATT_VOFF + 1024); SB_GLDS(v + (size_t)32 * SEQ, ATT_VOFF + 2048); SB_GLDS(v + (size_t)48 * SEQ, ATT_VOFF + 3072);
#undef SB_GLDS
}
template <int N> __device__ __forceinline__ void sb_wait() { asm volatile("s_waitcnt vmcnt(%0)" :: "n"(N) : "memory"); }
struct SbAddr { int k[4]; int v[4]; };
__device__ __forceinline__ void sb_read(SbFrag& f, const LAS unsigned char* slot, const SbAddr& ad) {
#pragma unroll
    for (int d0 = 0; d0 < 4; ++d0) f.kf[d0] = *(const LAS bf16x8*)(slot + ad.k[d0]);
#pragma unroll
    for (int dh = 0; dh < 2; ++dh)
#pragma unroll
        for (int mm = 0; mm < 2; ++mm) f.vf[dh][mm] = *(const LAS bf16x8*)(slot + ad.v[dh * 2 + mm]);
}
template <bool DIAG> __device__ __forceinline__ void sb_tile(const SbFrag& f, const bf16x8 (&qf)[4], f32x16& o0, f32x16& o1, float& carry, int lim, int hi) {
    f32x16 s;
#pragma unroll
    for (int r = 0; r < 16; ++r) s[r] = 0.f;
#pragma unroll
    for (int d0 = 0; d0 < 4; ++d0) s = __builtin_amdgcn_mfma_f32_32x32x16_bf16(f.kf[d0], qf[d0], s, 0, 0, 0);
    float wv[16]; float run = 1.f;
#pragma unroll
    for (int r = 15; r >= 0; --r) {
        float stay = __builtin_amdgcn_rcpf(1.0f + __builtin_amdgcn_exp2f(s[r]));
        float beta = 1.0f - stay;
        if (DIAG) { const bool ok = r < lim; stay = ok ? stay : 1.0f; beta = ok ? beta : 0.f; }
        wv[r] = beta * run; run *= stay;
    }
    const float other = __shfl_xor(run, 32);
    const float base = carry * (hi == 0 ? other : 1.0f);
    carry *= run * other;
    u32x4 p0, p1;
    p0.x = cvt_pk_bf16(wv[0] * base, wv[1] * base); p0.y = cvt_pk_bf16(wv[2] * base, wv[3] * base); p0.z = cvt_pk_bf16(wv[4] * base, wv[5] * base); p0.w = cvt_pk_bf16(wv[6] * base, wv[7] * base);
    p1.x = cvt_pk_bf16(wv[8] * base, wv[9] * base); p1.y = cvt_pk_bf16(wv[10] * base, wv[11] * base); p1.z = cvt_pk_bf16(wv[12] * base, wv[13] * base); p1.w = cvt_pk_bf16(wv[14] * base, wv[15] * base);
    const bf16x8 pa0 = __builtin_bit_cast(bf16x8, p0), pa1 = __builtin_bit_cast(bf16x8, p1);
    o0 = __builtin_amdgcn_mfma_f32_32x32x16_bf16(f.vf[0][0], pa0, o0, 0, 0, 0); o0 = __builtin_amdgcn_mfma_f32_32x32x16_bf16(f.vf[0][1], pa1, o0, 0, 0, 0);
    o1 = __builtin_amdgcn_mfma_f32_32x32x16_bf16(f.vf[1][0], pa0, o1, 0, 0, 0); o1 = __builtin_amdgcn_mfma_f32_32x32x16_bf16(f.vf[1][1], pa1, o1, 0, 0, 0);
}
__device__ __forceinline__ void sb_unit(const bf16_t* Q, const bf16_t* K, const bf16_t* VT, bf16_t* O, int b, int h, int qb, int lane, LAS unsigned char* slotA, LAS unsigned char* slotB, const SbAddr& ad) {
    const int j = lane & 31, hi = lane >> 5, q0 = qb * 32; const size_t rowbase = (size_t)b * SEQ;
    const bf16_t* qp = Q + (rowbase + q0 + j) * D + h * HD + 8 * hi;
    bf16x8 qf[4];
#pragma unroll
    for (int d0 = 0; d0 < 4; ++d0) qf[d0] = *(const bf16x8*)(qp + 16 * d0);
    const int k8w = lane >> 3, cw = (lane & 7) ^ k8w, aw = lane >> 4, d16w = 4 * ((lane >> 2) & 3) + aw, pw = (lane & 3) ^ aw;
    const bf16_t* kg = K + (rowbase + k8w) * D + h * HD + 8 * cw;
    const bf16_t* vg = VT + ((size_t)(b * NH + h) * HD + d16w) * SEQ + 8 * pw;
    f32x16 o0, o1;
#pragma unroll
    for (int r = 0; r < 16; ++r) { o0[r] = 0.f; o1[r] = 0.f; }
    float carry = 1.f;
    SbFrag f;
    sb_dma(slotA, kg, vg, q0);
    sb_dma(slotB, kg, vg, qb > 0 ? q0 - 32 : 0);
    sb_wait<8>(); sb_read(f, slotA, ad);
    sb_tile<true>(f, qf, o0, o1, carry, j - 16 * hi, hi);
    for (int kt = qb - 1; kt >= 0; kt -= 2) {
        sb_dma(slotA, kg, vg, (kt > 0 ? kt - 1 : 0) * 32);
        sb_wait<8>(); sb_read(f, slotB, ad);
        sb_tile<false>(f, qf, o0, o1, carry, 64, hi);
        if (kt == 0 || __all(carry < SB_TINY)) break;
        sb_dma(slotB, kg, vg, (kt > 1 ? kt - 2 : 0) * 32);
        sb_wait<8>(); sb_read(f, slotA, ad);
        sb_tile<false>(f, qf, o0, o1, carry, 64, hi);
        if (__all(carry < SB_TINY)) break;
    }
    sb_wait<0>();
    unsigned char* orow = (unsigned char*)(O + (rowbase + q0 + j) * D + h * HD) + (hi ? 16 : 0);
#pragma unroll
    for (int k = 0; k < 8; k += 2) {
        const int g = k & 3;
        u32x2 a, bq;
        if (k < 4) { a.x = cvt_pk_bf16(o0[4 * g], o0[4 * g + 1]); a.y = cvt_pk_bf16(o0[4 * g + 2], o0[4 * g + 3]); bq.x = cvt_pk_bf16(o0[4 * g + 4], o0[4 * g + 5]); bq.y = cvt_pk_bf16(o0[4 * g + 6], o0[4 * g + 7]); }
        else       { a.x = cvt_pk_bf16(o1[4 * g], o1[4 * g + 1]); a.y = cvt_pk_bf16(o1[4 * g + 2], o1[4 * g + 3]); bq.x = cvt_pk_bf16(o1[4 * g + 4], o1[4 * g + 5]); bq.y = cvt_pk_bf16(o1[4 * g + 6], o1[4 * g + 7]); }
        auto rx = __builtin_amdgcn_permlane32_swap(a.x, bq.x, false, false); auto ry = __builtin_amdgcn_permlane32_swap(a.y, bq.y, false, false);
        u32x4 w; w.x = rx[0]; w.y = ry[0]; w.z = rx[1]; w.w = ry[1];
        *(u32x4*)(orow + 16 * k) = w;
    }
}
__device__ __forceinline__ void attn_phase(const Args& a, const Frame& F) {
    const bf16_t* Q = (const bf16_t*)(a.ws + WS_Q); const bf16_t* K = (const bf16_t*)(a.ws + WS_K); const bf16_t* VT = (const bf16_t*)(a.ws + WS_VT); bf16_t* O = (bf16_t*)(a.ws + WS_O);
    constexpr int NQB = SEQ / 32, NU = BATCH * NH * NQB;
    LAS unsigned char* slotA = F.lds + F.wave * WAVE_LDS;
    SbAddr ad;
    { const int j = F.lane & 31, hi = F.lane >> 5, key = 16 * ((j >> 2) & 1) + (j & 3) + 4 * (j >> 3), ki = key >> 3, k8 = key & 7;
#pragma unroll
      for (int d0 = 0; d0 < 4; ++d0) ad.k[d0] = ki * ATT_KSTR + (8 * k8 + ((2 * d0 + hi) ^ k8)) * 16;
#pragma unroll
      for (int dh = 0; dh < 2; ++dh)
#pragma unroll
          for (int mm = 0; mm < 2; ++mm) { const int dd = 32 * dh + j, vi = dd >> 4, d16 = dd & 15, a_ = d16 & 3, b_ = d16 >> 2, p = 2 * hi + mm; ad.v[dh * 2 + mm] = ATT_VOFF + vi * 1024 + (16 * a_ + 4 * b_ + (p ^ a_)) * 16; } }
    for (int u = F.gw; u < NU; u += F.NGW) { const int bh = u / NQB, qb = u % NQB; sb_unit(Q, K, VT, O, bh / NH, bh % NH, qb, F.lane, slotA, slotA + ATT_SLOT, ad); }
}

__global__ void __launch_bounds__(NTHR) fwd_kernel(Args args) {
    extern __shared__ __attribute__((aligned(16))) unsigned char lds_raw[];
    Frame F; F.lds = (LAS unsigned char*)lds_raw; F.tid = threadIdx.x; F.lane = F.tid & 63; F.wave = __builtin_amdgcn_readfirstlane(F.tid >> 6);
    F.G = gridDim.x; F.gw = blockIdx.x * NWAVES + F.wave; F.NGW = F.G * NWAVES;
    unsigned char* ws = args.ws;
    float* ss = (float*)(ws + WS_SS);
    const int lo = args.ph_lo, hi = args.ph_hi;
#if MK_COOP
    cg::grid_group grid = cg::this_grid();
    volatile LAS unsigned* MISC = (volatile LAS unsigned*)(F.lds + MISC_OFF);
    if (F.tid < 16) MISC[F.tid] = 0u;
    __syncthreads();
    const XcdBarrier xbar = xcd_barrier_post((unsigned*)ws, MISC + 8);
    if (hi > N_PHASES) grid.sync();
#define SEAM(k) do { if (lo <= (k) && (k) + 1 < hi) xcd_barrier(xbar); } while (0)
#else
#define SEAM(k) do { } while (0)
#endif
#ifndef PH_MASK
#define PH_MASK 0x3ffff
#endif
#define IN(k) (((PH_MASK >> (k)) & 1) && lo <= (k) && (k) < hi)
    using namespace pg8;
    bf16_t* XB = (bf16_t*)(ws + WS_XB); bf16_t* ACT = (bf16_t*)(ws + WS_ACT);
    const int bx = blockIdx.x;
#define RUN_GEMM(EPI, ALIGN, Aptr, Bptr, N_, K_, lda_, adiv_, ...) do { Gemm g{(const bf16_t*)(Aptr), (const bf16_t*)(Bptr), M, (N_), (K_), (lda_), (adiv_)}; StaticOrder S; S.init(M, (N_), F.G, bx); \
        EPI E{__VA_ARGS__}; gemm_phase<EPI, ALIGN>(F.lds, g, S, E); } while (0)

#ifndef DUP_MASK
#define DUP_MASK 0
#endif
#if MK_COOP
#define REDO_BAR() xcd_barrier(xbar)
#else
#define REDO_BAR() do { } while (0)
#endif
#define PHASE(k, ...) do { if (IN(k)) { __VA_ARGS__; if ((DUP_MASK >> (k)) & 1) { REDO_BAR(); __VA_ARGS__; } } SEAM(k); } while (0)
    PHASE(0, cvt_range(args, F, 0, 1, 0, F.G); p0_rows(args, F));
    const int T22 = (64 * 22) % F.G, T30 = (64 * 30) % F.G;
    PHASE(1, RUN_GEMM(EpiSwiglu, true, XB, ws + WS_WA13, 2 * FF, D, D, 0, ss, ACT); cvt_range(args, F, 1, 4, T22, F.G - T22); cvt_range(args, F, 7, 10, T22, F.G - T22));
    PHASE(2, RUN_GEMM(EpiResidIn, true, ACT, ws + WS_WA2, D, FF, FF, 0, args.in[I_X], nullptr, XB, ss + M, 0.5f));
    PHASE(3, RUN_GEMM(EpiWin, true, XB, ws + WS_WIN, 2048, D, D, 0, ss + M, (bf16_t*)(ws + WS_GB), (bf16_t*)(ws + WS_REC)));
    PHASE(4, conv_phase(args, F));
    PHASE(5, RUN_GEMM(EpiGate, true, ws + WS_Y, ws + WS_WRI, 2048, 256, D, 2, (const bf16_t*)(ws + WS_Y), args.in[I_ABR], args.in[I_ABI], (const float*)(ws + WS_SP8), (bf16_t*)(ws + WS_REC), (bf16_t*)(ws + WS_U)));
    PHASE(6, scan_a(args, F));
    PHASE(7, scan_b(args, F));
    PHASE(8, RUN_GEMM(EpiResidMid, true, ws + WS_Y, ws + WS_WOUT, D, D, D, 0, nullptr, nullptr, XB, ss + 2 * M, 1.0f));
    PHASE(9, RUN_GEMM(EpiSwiglu, true, XB, ws + WS_WB13, 2 * FF, D, D, 0, ss + 2 * M, ACT); cvt_range(args, F, 4, 7, T22, F.G - T22));
    PHASE(10, RUN_GEMM(EpiResidMid, true, ACT, ws + WS_WB2, D, FF, FF, 0, nullptr, nullptr, XB, ss + 3 * M, 0.5f));
    PHASE(11, RUN_GEMM(EpiKvSwiglu, true, XB, ws + WS_WKV, 2048 + 2 * FF, D, D, 0, ss + 3 * M, args.in[I_KN], (bf16_t*)(ws + WS_K), (bf16_t*)(ws + WS_VT), ACT); cvt_range(args, F, 10, 14, T30, F.G - T30));
    PHASE(12, RUN_GEMM(EpiResidMid, true, ACT, ws + WS_WC2, D, FF, FF, 0, nullptr, nullptr, XB, ss + 4 * M, 0.5f));
    PHASE(13, RUN_GEMM(EpiQ, true, XB, ws + WS_WQ, D, D, D, 0, ss + 4 * M, args.in[I_QN], (bf16_t*)(ws + WS_Q)));
    PHASE(14, attn_phase(args, F));
    PHASE(15, RUN_GEMM(EpiResidMid, true, ws + WS_O, ws + WS_WO, D, D, D, 0, nullptr, nullptr, XB, ss + 5 * M, 1.0f));
    PHASE(16, RUN_GEMM(EpiSwiglu, true, XB, ws + WS_WA13, 2 * FF, D, D, 0, ss + 5 * M, ACT));
    PHASE(17, RUN_GEMM(EpiResidOut, true, ACT, ws + WS_WA2, D, FF, FF, 0, nullptr, args.out, XB, nullptr, 0.5f));
}

extern "C" void kernel_launch(void* const* d_in, const int* in_sizes, int n_in, void* d_out, int out_size, void* d_ws, size_t ws_size, hipStream_t stream) {
    static int grid = 0;
    if (grid == 0) {
        if (n_in != 23 || out_size != M * D || ws_size < WS_END) { fprintf(stderr, "kernel_launch: unexpected problem (n_in %d out %d ws %zu)\n", n_in, out_size, ws_size); grid = -1; return; }
        int dev = 0, cus = 0, per_cu = 0;
        (void)hipGetDevice(&dev); (void)hipDeviceGetAttribute(&cus, hipDeviceAttributeMultiprocessorCount, dev);
        if (hipFuncSetAttribute((const void*)fwd_kernel, hipFuncAttributeMaxDynamicSharedMemorySize, LDS_BYTES) != hipSuccess) { fprintf(stderr, "kernel_launch: hipFuncSetAttribute failed\n"); grid = -1; return; }
        if (hipOccupancyMaxActiveBlocksPerMultiprocessor(&per_cu, (const void*)fwd_kernel, NTHR, LDS_BYTES) != hipSuccess || per_cu < 1) { fprintf(stderr, "kernel_launch: occupancy query says %d\n", per_cu); per_cu = 1; }
        (void)hipGetLastError();
        grid = cus * 1;
        if (grid <= 0) grid = 256;
    }
    if (grid < 0) return;
    Args a{};
    for (int i = 0; i < 23; ++i) a.in[i] = (const float*)d_in[i];
    a.out = (float*)d_out; a.ws = (unsigned char*)d_ws;
#if MK_COOP
    a.ph_lo = 0; a.ph_hi = N_PHASES;
    if (hipMemsetAsync(d_ws, 0, 16 * KiB, stream) != hipSuccess) { fprintf(stderr, "kernel_launch: memset of the barrier words failed\n"); return; }
    void* kargs[] = {&a};
    hipError_t e = hipLaunchCooperativeKernel((const void*)fwd_kernel, dim3(grid), dim3(NTHR), kargs, LDS_BYTES, stream);
    if (e != hipSuccess) fprintf(stderr, "kernel_launch: cooperative launch failed: %s (grid %d)\n", hipGetErrorString(e), grid);
#else
    for (int p = 0; p < N_PHASES; ++p) { a.ph_lo = p; a.ph_hi = p + 1; hipLaunchKernelGGL(fwd_kernel, dim3(grid), dim3(NTHR), LDS_BYTES, stream, a); }
#endif
}
```

```cpp
#include <hip/hip_runtime.h>
#include <hip/hip_cooperative_groups.h>
#include <cstdio>
#include <cstdint>
#include <cmath>
namespace cg = cooperative_groups;

#ifndef MK_COOP
#define MK_COOP 1
#endif

#define LAS __attribute__((address_space(3)))
typedef unsigned short bf16_t;
typedef short bf16x8 __attribute__((ext_vector_type(8)));
typedef float f32x4 __attribute__((ext_vector_type(4)));
typedef float f32x2 __attribute__((ext_vector_type(2)));
typedef float f32x16 __attribute__((ext_vector_type(16)));
typedef unsigned u32x4 __attribute__((ext_vector_type(4)));
typedef unsigned u32x2 __attribute__((ext_vector_type(2)));

constexpr int BATCH = 4, SEQ = 4096, D = 1024, FF = 2816, NH = 16, HD = 64;
constexpr int M = BATCH * SEQ;
constexpr float EPS = 1e-6f;
constexpr float LOG2E = 1.4426950408889634f, LN2 = 0.6931471805599453f;

constexpr size_t MiB = 1u << 20, KiB = 1u << 10;
constexpr size_t WS_SS = 64 * KiB;
constexpr size_t WS_SP8 = 32 * KiB;
constexpr size_t WS_HL = 1 * MiB, WS_PC = 2 * MiB;
constexpr size_t SZ_W13 = (size_t)2 * FF * D * 2, SZ_W2 = (size_t)D * FF * 2;
constexpr size_t WS_WA13 = 4 * MiB, WS_WA2 = WS_WA13 + SZ_W13;
constexpr size_t WS_WB13 = WS_WA2 + SZ_W2, WS_WB2 = WS_WB13 + SZ_W13;
constexpr size_t WS_WKV = WS_WB2 + SZ_W2, WS_WC13 = WS_WKV + 4 * MiB, WS_WC2 = WS_WC13 + SZ_W13;
constexpr size_t WS_WIN = WS_WC2 + SZ_W2, WS_WRI = WS_WIN + 4 * MiB, WS_WOUT = WS_WRI + 1 * MiB, WS_WQ = WS_WOUT + 2 * MiB, WS_WO = WS_WQ + 2 * MiB;
constexpr size_t WS_XB = 69 * MiB;
constexpr size_t WS_ACT = 101 * MiB;
constexpr size_t WS_K = 189 * MiB, WS_VT = 221 * MiB, WS_END = 253 * MiB;
constexpr size_t WS_GB = WS_ACT, WS_U = WS_ACT + 32 * MiB, WS_REC = WS_ACT + 64 * MiB;
constexpr size_t WS_Y = WS_ACT + 96 * MiB;
constexpr size_t WS_Q = WS_ACT, WS_O = WS_ACT + 32 * MiB;
static_assert(WS_WO + 2 * MiB <= WS_XB && WS_REC + 64 * MiB <= WS_END, "ws map");

__device__ __forceinline__ unsigned cvt_pk_bf16(float lo, float hi) {
    typedef __bf16 bf16x2_t __attribute__((ext_vector_type(2)));
    f32x2 v = {lo, hi}; bf16x2_t b = __builtin_convertvector(v, bf16x2_t); return __builtin_bit_cast(unsigned, b);
}
__device__ __forceinline__ float bf_lo(unsigned w) { return __uint_as_float(w << 16); }
__device__ __forceinline__ float bf_hi(unsigned w) { return __uint_as_float(w & 0xffff0000u); }
__device__ __forceinline__ float sigm(float x) { return __builtin_amdgcn_rcpf(1.0f + __builtin_amdgcn_exp2f(-x * LOG2E)); }
__device__ __forceinline__ float gelu_tanh(float x) { return x * sigm(1.5957691216057308f * (x + 0.044715f * x * x * x)); }
__device__ __forceinline__ float wave_sum(float v) {
#pragma unroll
    for (int o = 1; o < 64; o <<= 1) v += __shfl_xor(v, o);
    return v;
}
#define LDS_WAIT() asm volatile("s_waitcnt lgkmcnt(0)" ::: "memory")

namespace pg8 {
constexpr int BM = 256, BK = 64, HALF = 128, HTB = HALF * BK * 2, STAGE_BYTES = 8 * HTB, NXCD = 8, WGM = 4;
__host__ __device__ __forceinline__ int lds_byte(int r, int c) { const int st = (r >> 4) * 2 + (c >> 5), rr = r & 15, cc = c & 31, ob = rr * 64 + cc * 2; return st * 1024 + (ob ^ (((ob >> 9) & 1) << 5)); }
__host__ __device__ __forceinline__ void stage_rc(int b, int& R, int& C) { const int st = b / 1024, sb = b % 1024, swz = sb ^ (((sb >> 9) & 1) << 5); R = (st >> 1) * 16 + swz / 64; C = (st & 1) * 32 + (swz % 64) / 2; }
__host__ __device__ __forceinline__ int perm32(int rho) { const int n = rho >> 4, i = rho & 15; return 8 * (i >> 2) + 4 * n + (i & 3); }

struct Unit { int pm, pn; };
struct Gemm { const bf16_t* A; const bf16_t* Bt; int M, N, K, lda, adiv; };

struct StaticOrder {
    int nM, nN, nwg, G, c;
    __device__ void init(int M_, int N_, int G_, int c_) { nM = M_ / BM; nN = N_ / BM; nwg = nM * nN; G = G_; c = c_; }
    __device__ bool next(int i, Unit& u) const {
        const long L = (long)i * G + c; if (L >= nwg) return false;
        int wgid = (int)L; { const int q = nwg / NXCD, r = nwg % NXCD, xcd = wgid % NXCD, off = wgid / NXCD; wgid = (xcd < r ? xcd * (q + 1) : r * (q + 1) + (xcd - r) * q) + off; }
        const int nig = WGM * nN, gid = wgid / nig, fm = gid * WGM, gsz = (nM - fm) < WGM ? (nM - fm) : WGM;
        u.pm = fm + ((wgid % nig) % gsz); u.pn = (wgid % nig) / gsz; return true;
    }
};

template <class Epi, bool ALIGN_EPI>
__device__ __forceinline__ void gemm_phase(LAS unsigned char* lds, const Gemm g, const StaticOrder& S, const Epi& E) {
    const int tid = threadIdx.x, wid = __builtin_amdgcn_readfirstlane(tid >> 6), lane = tid & 63, wr = wid >> 2, wc = wid & 3, fr = lane & 15, fq = lane >> 4;
    const int K = g.K, nt = K / BK, lda = g.lda;
    unsigned voffA[2], voffB[2];
#pragma unroll
    for (int i = 0; i < 2; ++i) { int R, C; stage_rc(tid * 16 + i * 8192, R, C); const int Rb = (R & ~31) + perm32(R & 31);
        voffA[i] = (unsigned)(R * lda + C) * 2u; voffB[i] = (unsigned)(Rb * K + C) * 2u; }
    const size_t kstep = (size_t)(BK * 2);
    const size_t hA = (size_t)HALF * lda * 2, hB = (size_t)HALF * K * 2;
    const size_t tA = 2 * hA, tB = 2 * hB;
    const unsigned ldsw = (unsigned)wid * 1024u;
    const int aoff = lds_byte(wr * 64 + fr, fq * 8), boff = lds_byte(wc * 32 + fr, fq * 8);
#define PG8_SA(b, h) (((b) * 2 + (h)) * HTB)
#define PG8_SB(b, h) ((4 + (b) * 2 + (h)) * HTB)
#define PG8_STAGE(bufoff, gbase, voff) do { _Pragma("unroll") for (int _i = 0; _i < 2; ++_i) \
        __builtin_amdgcn_global_load_lds((const unsigned*)((const char*)(gbase) + (voff)[_i]), (LAS unsigned*)(lds + (bufoff) + ldsw + _i * 8192), 16, 0, 0); } while (0)
#define PG8_LDA(dst, b, h) do { _Pragma("unroll") for (int m = 0; m < 4; ++m) _Pragma("unroll") for (int k = 0; k < 2; ++k) dst[m][k] = *(const LAS bf16x8*)(lds + PG8_SA(b, h) + aoff + m * 2048 + k * 1024); } while (0)
#define PG8_LDB(dst, b, h) do { _Pragma("unroll") for (int n = 0; n < 2; ++n) _Pragma("unroll") for (int k = 0; k < 2; ++k) dst[n][k] = *(const LAS bf16x8*)(lds + PG8_SB(b, h) + boff + n * 2048 + k * 1024); } while (0)
#define PG8_MMA(ai, bj, At, Bt) do { __builtin_amdgcn_s_setprio(1); _Pragma("unroll") for (int m = 0; m < 4; ++m) _Pragma("unroll") for (int n = 0; n < 2; ++n) _Pragma("unroll") for (int k = 0; k < 2; ++k) \
        acc[ai][bj][m][n] = __builtin_amdgcn_mfma_f32_16x16x32_bf16(Bt[n][k], At[m][k], acc[ai][bj][m][n], 0, 0, 0); __builtin_amdgcn_s_setprio(0); } while (0)
#define PG8_WAIT_V(n) asm volatile("s_waitcnt vmcnt(" #n ")" ::: "memory")
#define PG8_WAIT_L(n) asm volatile("s_waitcnt lgkmcnt(" #n ")" ::: "memory")
#define PG8_BAR __builtin_amdgcn_s_barrier()
#define PG8_SCHED __builtin_amdgcn_sched_barrier(0)
#define PG8_ABASE(u) ((const char*)g.A + (size_t)(u).pm * tA + (g.adiv ? (size_t)((u).pn / g.adiv) * K * 2 : (size_t)0))
#define PG8_BBASE(u) ((const char*)g.Bt + (size_t)(u).pn * tB)
    Unit cur, nxt; int ui = 0;
    if (!S.next(0, cur)) return;
    f32x4 acc[2][2][4][2];
#pragma unroll
    for (int a = 0; a < 2; ++a)
#pragma unroll
        for (int b = 0; b < 2; ++b)
#pragma unroll
            for (int m = 0; m < 4; ++m)
#pragma unroll
                for (int n = 0; n < 2; ++n) acc[a][b][m][n] = (f32x4){0.f, 0.f, 0.f, 0.f};
    bf16x8 At[4][2], B0[2][2], B1[2][2];
    float pre[2][4];
#define PG8_PREFETCH(u) do { if constexpr (Epi::NEEDS_SS) { const float* _p = E.ss + (u).pm * BM + wr * 64 + fr; \
        _Pragma("unroll") for (int _m = 0; _m < 4; ++_m) pre[0][_m] = _p[_m * 16]; } \
        else { _Pragma("unroll") for (int _m = 0; _m < 4; ++_m) pre[0][_m] = 0.f; } } while (0)
#define PG8_PREFETCH2(u) do { if constexpr (Epi::NEEDS_SS) { const float* _p = E.ss + (u).pm * BM + wr * 64 + fr + HALF; \
        _Pragma("unroll") for (int _m = 0; _m < 4; ++_m) pre[1][_m] = _p[_m * 16]; } \
        else { _Pragma("unroll") for (int _m = 0; _m < 4; ++_m) pre[1][_m] = 0.f; } } while (0)
    PG8_PREFETCH(cur);
    const char* cA = PG8_ABASE(cur); const char* cB = PG8_BBASE(cur);
    PG8_STAGE(PG8_SB(0, 0), cB, voffB); PG8_STAGE(PG8_SB(0, 1), cB + hB, voffB); PG8_STAGE(PG8_SA(0, 0), cA, voffA); PG8_STAGE(PG8_SA(0, 1), cA + hA, voffA);
    if (wr == 1) PG8_BAR;
    PG8_WAIT_V(2); PG8_BAR;
    PG8_STAGE(PG8_SB(1, 0), cB + kstep, voffB); PG8_STAGE(PG8_SA(1, 0), cA + kstep, voffA); PG8_STAGE(PG8_SB(1, 1), cB + hB + kstep, voffB);
    PG8_WAIT_V(6); PG8_BAR;
    for (;;) {
        const bool has_next = S.next(ui + 1, nxt);
        const char* nA = has_next ? PG8_ABASE(nxt) : cA; const char* nB = has_next ? PG8_BBASE(nxt) : cB;
#pragma unroll 1
        for (int t = 0; t < nt; t += 2) {
            const bool last = (t == nt - 2);
            const char* a1 = cA + (size_t)(t + 1) * kstep;
            const char* a2 = last ? nA : cA + (size_t)(t + 2) * kstep; const char* b2 = last ? nB : cB + (size_t)(t + 2) * kstep;
            const char* a3 = a2 + kstep; const char* b3 = b2 + kstep;
            PG8_LDB(B0, 0, 0); PG8_LDB(B1, 0, 1); PG8_SCHED; PG8_LDA(At, 0, 0); PG8_STAGE(PG8_SA(1, 1), a1 + hA, voffA);
            PG8_WAIT_V(8); PG8_WAIT_L(0); PG8_BAR; PG8_MMA(0, 0, At, B0); PG8_MMA(0, 1, At, B1); PG8_BAR; PG8_SCHED;
            PG8_LDA(At, 0, 1); PG8_STAGE(PG8_SB(0, 0), b2, voffB); PG8_STAGE(PG8_SB(0, 1), b2 + hB, voffB); PG8_STAGE(PG8_SA(0, 0), a2, voffA);
            PG8_WAIT_V(8); PG8_WAIT_L(0); PG8_BAR; PG8_MMA(1, 0, At, B0); PG8_MMA(1, 1, At, B1); PG8_BAR; PG8_SCHED;
            PG8_LDB(B0, 1, 0); PG8_LDB(B1, 1, 1); PG8_SCHED; PG8_LDA(At, 1, 0); PG8_STAGE(PG8_SA(0, 1), a2 + hA, voffA);
            PG8_WAIT_V(8); PG8_WAIT_L(0); PG8_BAR; PG8_MMA(0, 0, At, B0); PG8_MMA(0, 1, At, B1); PG8_BAR; PG8_SCHED;
            PG8_LDA(At, 1, 1); PG8_STAGE(PG8_SB(1, 0), b3, voffB); PG8_STAGE(PG8_SB(1, 1), b3 + hB, voffB); PG8_STAGE(PG8_SA(1, 0), a3, voffA);
            PG8_WAIT_V(8); PG8_WAIT_L(0); PG8_BAR; PG8_MMA(1, 0, At, B0); PG8_MMA(1, 1, At, B1); PG8_BAR; PG8_SCHED;
        }
        if constexpr (ALIGN_EPI) { if (wr == 0) PG8_BAR; }
        PG8_PREFETCH2(cur);
        E(acc, cur, wr, wc, fr, fq, pre);
        if (!has_next) break;
#pragma unroll
        for (int a = 0; a < 2; ++a)
#pragma unroll
            for (int b = 0; b < 2; ++b)
#pragma unroll
                for (int m = 0; m < 4; ++m)
#pragma unroll
                    for (int n = 0; n < 2; ++n) acc[a][b][m][n] = (f32x4){0.f, 0.f, 0.f, 0.f};
        cur = nxt; cA = nA; cB = nB; ++ui;
        PG8_PREFETCH(cur);
        if constexpr (ALIGN_EPI) { if (wr == 1) PG8_BAR; }
    }
    PG8_WAIT_V(0);
    if constexpr (!ALIGN_EPI) { if (wr == 0) PG8_BAR; }
    PG8_BAR;
#undef PG8_SA
#undef PG8_SB
#undef PG8_STAGE
#undef PG8_LDA
#undef PG8_LDB
#undef PG8_MMA
#undef PG8_WAIT_V
#undef PG8_WAIT_L
#undef PG8_BAR
#undef PG8_SCHED
#undef PG8_ABASE
#undef PG8_PREFETCH
#undef PG8_PREFETCH2
#undef PG8_BBASE
}

typedef f32x4 Acc[2][2][4][2];
__device__ __forceinline__ float rstd_of(const float* ss, int row) { return 1.0f / sqrtf(ss[row] * (1.0f / D) + EPS); }

typedef float Pre8[2][4];
__device__ __forceinline__ void rstd8(const Pre8& t, float (&rs)[2][4]) {
#pragma unroll
    for (int ai = 0; ai < 2; ++ai)
#pragma unroll
        for (int m = 0; m < 4; ++m) rs[ai][m] = 1.0f / sqrtf(t[ai][m] * (1.0f / D) + EPS);
}
__device__ __forceinline__ void epi_swiglu(const Acc& acc, int pm, int pnf, int wr, int wc, int fr, int fq, const Pre8& pre, bf16_t* act) {
    const int col = pnf * 128 + wc * 32 + 8 * fq;
#pragma unroll
    for (int ai = 0; ai < 2; ++ai)
#pragma unroll
        for (int m = 0; m < 4; ++m) {
            const int row = pm * BM + ai * HALF + wr * 64 + m * 16 + fr; const float rs = 1.0f / sqrtf(pre[ai][m] * (1.0f / D) + EPS);
            float o[8];
#pragma unroll
            for (int n = 0; n < 2; ++n)
#pragma unroll
                for (int j = 0; j < 4; ++j) { const float gt = acc[ai][0][m][n][j] * rs, up = acc[ai][1][m][n][j] * rs; o[n * 4 + j] = gt * sigm(gt) * up; }
            u32x4 w; w.x = cvt_pk_bf16(o[0], o[1]); w.y = cvt_pk_bf16(o[2], o[3]); w.z = cvt_pk_bf16(o[4], o[5]); w.w = cvt_pk_bf16(o[6], o[7]);
            __builtin_nontemporal_store(w, (u32x4*)(act + (size_t)row * FF + col));
        }
}
struct EpiSwiglu { static constexpr bool NEEDS_SS = true; const float* ss; bf16_t* act;
    __device__ __forceinline__ void operator()(const Acc& acc, const Unit& u, int wr, int wc, int fr, int fq, const Pre8& pre) const { epi_swiglu(acc, u.pm, u.pn, wr, wc, fr, fq, pre, act); } };

template <bool IN_F32, bool FINAL> struct EpiResid { static constexpr bool NEEDS_SS = false; const float* xin; float* xout; bf16_t* xb; float* ssn; float alpha;
    __device__ __forceinline__ void operator()(const Acc& acc, const Unit& u, int wr, int wc, int fr, int fq, const Pre8&) const {
        const size_t cbase = (size_t)u.pn * BM + wc * 32 + 8 * fq;
#pragma unroll
        for (int ai = 0; ai < 2; ++ai) {
            f32x4 xr[4][2][2];
#pragma unroll
            for (int m = 0; m < 4; ++m)
#pragma unroll
                for (int bj = 0; bj < 2; ++bj) {
                    const size_t off = (size_t)(u.pm * BM + ai * HALF + wr * 64 + m * 16 + fr) * D + cbase + bj * HALF;
                    if (IN_F32) { xr[m][bj][0] = *(const f32x4*)(xin + off); xr[m][bj][1] = *(const f32x4*)(xin + off + 4); }
                    else { const u32x4 xw = *(const u32x4*)(xb + off); xr[m][bj][0] = __builtin_bit_cast(f32x4, xw); }
                }
#pragma unroll
            for (int m = 0; m < 4; ++m) {
                const int row = u.pm * BM + ai * HALF + wr * 64 + m * 16 + fr; float sq = 0.f;
#pragma unroll
                for (int bj = 0; bj < 2; ++bj) {
                    const size_t off = (size_t)row * D + cbase + bj * HALF;
                    f32x4 x0, x1;
                    if (IN_F32) { x0 = xr[m][bj][0]; x1 = xr[m][bj][1]; }
                    else { const u32x4 xw = __builtin_bit_cast(u32x4, xr[m][bj][0]); x0 = (f32x4){bf_lo(xw.x), bf_hi(xw.x), bf_lo(xw.y), bf_hi(xw.y)}; x1 = (f32x4){bf_lo(xw.z), bf_hi(xw.z), bf_lo(xw.w), bf_hi(xw.w)}; }
                    const f32x4 y0 = x0 + acc[ai][bj][m][0] * alpha, y1 = x1 + acc[ai][bj][m][1] * alpha;
                    if (FINAL) { *(f32x4*)(xout + off) = y0; *(f32x4*)(xout + off + 4) = y1; }
                    else {
                        sq += (y0[0] * y0[0] + y0[1] * y0[1]) + (y0[2] * y0[2] + y0[3] * y0[3]) + (y1[0] * y1[0] + y1[1] * y1[1]) + (y1[2] * y1[2] + y1[3] * y1[3]);
                        u32x4 w; w.x = cvt_pk_bf16(y0[0], y0[1]); w.y = cvt_pk_bf16(y0[2], y0[3]); w.z = cvt_pk_bf16(y1[0], y1[1]); w.w = cvt_pk_bf16(y1[2], y1[3]);
                        *(u32x4*)(xb + off) = w;
                    }
                }
                if (!FINAL) { sq += __shfl_xor(sq, 16); sq += __shfl_xor(sq, 32); if (fq == 0) atomicAdd(ssn + row, sq); }
            }
        }
    } };
typedef EpiResid<true, false> EpiResidIn; typedef EpiResid<false, false> EpiResidMid; typedef EpiResid<false, true> EpiResidOut;

struct EpiWin { static constexpr bool NEEDS_SS = true; const float* ss; bf16_t* gb; bf16_t* rec;
    __device__ __forceinline__ void operator()(const Acc& acc, const Unit& u, int wr, int wc, int fr, int fq, const Pre8& pre) const {
        const bool isg = u.pn < 4; const int ct = (u.pn & 3) * BM;
#pragma unroll
        for (int ai = 0; ai < 2; ++ai)
#pragma unroll
            for (int m = 0; m < 4; ++m) {
                const int row = u.pm * BM + ai * HALF + wr * 64 + m * 16 + fr; const float rs = 1.0f / sqrtf(pre[ai][m] * (1.0f / D) + EPS);
#pragma unroll
                for (int bj = 0; bj < 2; ++bj) {
                    const size_t off = (size_t)row * D + ct + bj * HALF + wc * 32 + 8 * fq;
                    const f32x4 v0 = acc[ai][bj][m][0] * rs, v1 = acc[ai][bj][m][1] * rs;
                    if (isg) { u32x4 w; w.x = cvt_pk_bf16(gelu_tanh(v0[0]), gelu_tanh(v0[1])); w.y = cvt_pk_bf16(gelu_tanh(v0[2]), gelu_tanh(v0[3]));
                        w.z = cvt_pk_bf16(gelu_tanh(v1[0]), gelu_tanh(v1[1])); w.w = cvt_pk_bf16(gelu_tanh(v1[2]), gelu_tanh(v1[3])); *(u32x4*)(gb + off) = w; }
                    else { u32x4 w; w.x = cvt_pk_bf16(v0[0], v0[1]); w.y = cvt_pk_bf16(v0[2], v0[3]); w.z = cvt_pk_bf16(v1[0], v1[1]); w.w = cvt_pk_bf16(v1[2], v1[3]); *(u32x4*)(rec + off) = w; }
                }
            }
    } };

struct EpiGate { static constexpr bool NEEDS_SS = false; const bf16_t* xc; const float* b_r; const float* b_i; const float* sp8; bf16_t* aout; bf16_t* uout;
    __device__ __forceinline__ void operator()(const Acc& acc, const Unit& u, int wr, int wc, int fr, int fq, const Pre8&) const {
        const int ch = u.pn * 128 + wc * 32 + 8 * fq;
        float br[8], bi[8], sp[8];
#pragma unroll
        for (int n = 0; n < 2; ++n) { const f32x4 a_ = *(const f32x4*)(b_r + ch + 4 * n), b_ = *(const f32x4*)(b_i + ch + 4 * n), c_ = *(const f32x4*)(sp8 + ch + 4 * n);
#pragma unroll
            for (int j = 0; j < 4; ++j) { br[4 * n + j] = a_[j]; bi[4 * n + j] = b_[j]; sp[4 * n + j] = c_[j]; } }
        u32x4 xcw[2][4];
#pragma unroll
        for (int ai = 0; ai < 2; ++ai)
#pragma unroll
            for (int m = 0; m < 4; ++m) xcw[ai][m] = *(const u32x4*)(xc + (size_t)(u.pm * BM + ai * HALF + wr * 64 + m * 16 + fr) * D + ch);
#pragma unroll
        for (int ai = 0; ai < 2; ++ai)
#pragma unroll
            for (int m = 0; m < 4; ++m) {
                const int row = u.pm * BM + ai * HALF + wr * 64 + m * 16 + fr; const size_t off = (size_t)row * D + ch;
                const u32x4 xw = xcw[ai][m];
                const float xv[8] = {bf_lo(xw.x), bf_hi(xw.x), bf_lo(xw.y), bf_hi(xw.y), bf_lo(xw.z), bf_hi(xw.z), bf_lo(xw.w), bf_hi(xw.w)};
                float av[8], uv[8];
#pragma unroll
                for (int j = 0; j < 8; ++j) {
                    const float r = sigm(acc[ai][0][m][j >> 2][j & 3] + br[j]), ig = sigm(acc[ai][1][m][j >> 2][j & 3] + bi[j]);
                    const float la2 = r * sp[j];
                    const float a = __builtin_amdgcn_exp2f(la2);
                    av[j] = la2; uv[j] = __builtin_amdgcn_sqrtf(fmaxf(1.0f - a * a, 0.f)) * ig * xv[j];
                }
                u32x4 wa; wa.x = cvt_pk_bf16(av[0], av[1]); wa.y = cvt_pk_bf16(av[2], av[3]); wa.z = cvt_pk_bf16(av[4], av[5]); wa.w = cvt_pk_bf16(av[6], av[7]);
                *(u32x4*)(aout + off) = wa;
                u32x4 w; w.x = cvt_pk_bf16(uv[0], uv[1]); w.y = cvt_pk_bf16(uv[2], uv[3]); w.z = cvt_pk_bf16(uv[4], uv[5]); w.w = cvt_pk_bf16(uv[6], uv[7]);
                *(u32x4*)(uout + off) = w;
            }
    } };

__device__ __forceinline__ void epi_headnorm(const Acc& acc, int pm, int pnh, int wr, int wc, int fr, int fq, const Pre8& pre, const float* gain, float oscale, bf16_t* out) {
    const int head = 4 * pnh + wc;
    float sc[2][4]; rstd8(pre, sc);
#pragma unroll
    for (int ai = 0; ai < 2; ++ai)
#pragma unroll
        for (int m = 0; m < 4; ++m) {
            const float rs = sc[ai][m];
            float sq = 0.f;
#pragma unroll
            for (int bj = 0; bj < 2; ++bj)
#pragma unroll
                for (int n = 0; n < 2; ++n) { const f32x4 v = acc[ai][bj][m][n]; sq += (v[0] * v[0] + v[1] * v[1]) + (v[2] * v[2] + v[3] * v[3]); }
            sq += __shfl_xor(sq, 16); sq += __shfl_xor(sq, 32);
            sc[ai][m] = rs * oscale / sqrtf(sq * rs * rs * (1.0f / HD) + EPS);
        }
#pragma unroll
    for (int bj = 0; bj < 2; ++bj) {
        const f32x4 g0 = *(const f32x4*)(gain + 32 * bj + 8 * fq), g1 = *(const f32x4*)(gain + 32 * bj + 8 * fq + 4);
#pragma unroll
        for (int ai = 0; ai < 2; ++ai)
#pragma unroll
            for (int m = 0; m < 4; ++m) {
                const int row = pm * BM + ai * HALF + wr * 64 + m * 16 + fr;
                const f32x4 v0 = acc[ai][bj][m][0] * g0 * sc[ai][m], v1 = acc[ai][bj][m][1] * g1 * sc[ai][m];
                u32x4 w; w.x = cvt_pk_bf16(v0[0], v0[1]); w.y = cvt_pk_bf16(v0[2], v0[3]); w.z = cvt_pk_bf16(v1[0], v1[1]); w.w = cvt_pk_bf16(v1[2], v1[3]);
                *(u32x4*)(out + (size_t)row * D + head * HD + 32 * bj + 8 * fq) = w;
                asm volatile("" ::: "memory");
            }
    }
}
struct EpiQ { static constexpr bool NEEDS_SS = true; const float* ss; const float* gain; bf16_t* q;
    __device__ __forceinline__ void operator()(const Acc& acc, const Unit& u, int wr, int wc, int fr, int fq, const Pre8& pre) const { epi_headnorm(acc, u.pm, u.pn, wr, wc, fr, fq, pre, gain, 0.125f * LOG2E, q); } };
struct EpiKvSwiglu { static constexpr bool NEEDS_SS = true; const float* ss; const float* kgain; bf16_t* kout; bf16_t* vt; bf16_t* act;
    __device__ __forceinline__ void operator()(const Acc& acc, const Unit& u, int wr, int wc, int fr, int fq, const Pre8& pre) const {
        if (u.pn >= 8) { epi_swiglu(acc, u.pm, u.pn - 8, wr, wc, fr, fq, pre, act); return; }
        if (u.pn < 4) { epi_headnorm(acc, u.pm, u.pn, wr, wc, fr, fq, pre, kgain, 1.0f, kout); return; }
        const int head = 4 * (u.pn - 4) + wc;
        float rs8[2][4]; rstd8(pre, rs8);
        const int row0 = u.pm * BM + wr * 64 + fr, b = row0 / SEQ, s0 = row0 % SEQ;
        bf16_t* base = vt + ((size_t)(b * NH + head) * HD + 8 * fq) * SEQ + s0;
#pragma unroll
        for (int bj = 0; bj < 2; ++bj)
#pragma unroll
            for (int j = 0; j < 8; ++j) {
                bf16_t* p = base + (size_t)(32 * bj + j) * SEQ;
#pragma unroll
                for (int ai = 0; ai < 2; ++ai)
#pragma unroll
                    for (int m = 0; m < 4; ++m) p[ai * HALF + m * 16] = (bf16_t)(cvt_pk_bf16(acc[ai][bj][m][j >> 2][j & 3] * rs8[ai][m], 0.f) & 0xffffu);
                asm volatile("" ::: "memory");
            }
    } };
}


#define XB_TMO      128
#define XB_XCNT(j)  (256  + 64 * (j))
#define XB_XSUB(j)  (1280 + 64 * (j))
#define XB_XGEN(j)  (2304 + 64 * (j))
#define XB_TOP      3328
#define XB_TOPGEN   3392
#define XCD_BAR_WORDS 3456
#define XB_SPIN_CAP (1u << 18)
__device__ __forceinline__ unsigned xb_ld(unsigned* p)              { return __hip_atomic_load(p, __ATOMIC_RELAXED, __HIP_MEMORY_SCOPE_AGENT); }
__device__ __forceinline__ unsigned xb_add(unsigned* p, unsigned v) { return __hip_atomic_fetch_add(p, v, __ATOMIC_RELAXED, __HIP_MEMORY_SCOPE_AGENT); }
__device__ __forceinline__ unsigned xb_xcc_id() { return (unsigned)__builtin_amdgcn_s_getreg((3 << 11) | 20) & 0xFu; }
#define XB_SPIN(cond, bar) do { unsigned _sp = 0; while (cond) { __builtin_amdgcn_s_sleep(1); \
    if ((++_sp & 255u) == 0u) { if (xb_ld(&(bar)[XB_TMO])) break; if (_sp > XB_SPIN_CAP) { atomicAdd(&(bar)[XB_TMO], 1u); break; } } } } while (0)
struct XcdBarrier { unsigned* bar; unsigned x; volatile LAS unsigned* st; };
__device__ __forceinline__ XcdBarrier xcd_barrier_post(unsigned* bar, volatile LAS unsigned* st) {
    XcdBarrier b; b.bar = bar; b.x = xb_xcc_id(); b.st = st;
    if (threadIdx.x == 0) (void)xb_add(&bar[XB_XCNT(b.x)], 1u);
    return b;
}
__device__ __forceinline__ void xcd_barrier_complete(unsigned* bar, unsigned x, unsigned& nloc, unsigned& nx) {
    const unsigned G = gridDim.x * gridDim.y * gridDim.z;
    unsigned sum, cnt, mine, sp = 0u;
    for (;;) {
        sum = 0u; cnt = 0u; mine = 0u;
#pragma unroll
        for (unsigned j = 0; j < 16; ++j) { const unsigned c = xb_ld(&bar[XB_XCNT(j)]); sum += c; cnt += (c > 0u) ? 1u : 0u; mine = (j == x) ? c : mine; }
        if (sum == G) break;
        __builtin_amdgcn_s_sleep(1);
        if ((++sp & 255u) == 0u) { if (xb_ld(&bar[XB_TMO])) break; if (sp > XB_SPIN_CAP) { atomicAdd(&bar[XB_TMO], 1u); break; } }
    }
    nloc = mine > 0u ? mine : 1u; nx = cnt > 0u ? cnt : 1u;
}
__device__ __forceinline__ void xcd_barrier(const XcdBarrier& b) {
    asm volatile("s_waitcnt vmcnt(0)" ::: "memory");
    __syncthreads();
    if (threadIdx.x == 0) {
        unsigned* bar = b.bar;
        __builtin_amdgcn_s_waitcnt(0);
        unsigned nloc = b.st[0], nx = b.st[1];
        if (nloc == 0u) { xcd_barrier_complete(bar, b.x, nloc, nx); b.st[0] = nloc; b.st[1] = nx; }
        const unsigned old = xb_add(&bar[XB_XSUB(b.x)], 1u);
        const unsigned gen = old / nloc;
        if (old + 1u == (gen + 1u) * nloc) {
            __builtin_amdgcn_fence(__ATOMIC_RELEASE, "agent");
            asm volatile("s_waitcnt vmcnt(0)" ::: "memory");
            const unsigned og = xb_add(&bar[XB_TOP], 1u);
            const unsigned tg = og / nx;
            if (og + 1u == (tg + 1u) * nx) xb_add(&bar[XB_TOPGEN], 1u);
            else XB_SPIN(xb_ld(&bar[XB_TOPGEN]) == tg, bar);
            __builtin_amdgcn_fence(__ATOMIC_ACQUIRE, "agent");
            xb_add(&bar[XB_XGEN(b.x)], 1u);
            asm volatile("s_waitcnt vmcnt(0)" ::: "memory");
        } else {
            XB_SPIN(xb_ld(&bar[XB_XGEN(b.x)]) == gen, bar);
            __builtin_amdgcn_fence(__ATOMIC_ACQUIRE, "agent");
            asm volatile("s_waitcnt vmcnt(0)" ::: "memory");
        }
    }
    __syncthreads();
}

constexpr int N_PHASES = 18;
constexpr int NWAVES = 8, NTHR = NWAVES * 64;
constexpr int MISC_OFF = 8 * 16896, LDS_BYTES = MISC_OFF + 256;

struct Args { const float* in[23]; float* out; unsigned char* ws; int ph_lo, ph_hi; };

struct Frame { LAS unsigned char* lds; int tid, lane, wave, G, gw, NGW; };

struct CvtDesc { const float* W; const float* W2; bf16_t* dst; const float* gain; int ldw, K, nb, mode; };
constexpr int SCR_STRIDE = 64 * 65 * 4;
__device__ __forceinline__ void cvt_item(const CvtDesc& d, int local, LAS float* scr, int lane) {
    const int kb = local / d.nb, gI = local % d.nb, k0 = 64 * kb, n0 = 64 * gI;
    const int l16 = lane & 15, l4 = lane >> 4, n = n0 + 4 * l16;
    const float* W = d.W; int c0;
    if (d.mode == 0) c0 = n;
    else if (d.mode == 1) { const int tile = n >> 8, bj = (n >> 7) & 1, j0 = n & 127; c0 = bj * FF + tile * 128 + j0; }
    else if (d.mode == 2) { const int pn = n >> 8, bj = (n >> 7) & 1, wc = (n >> 5) & 3, j0 = n & 31; c0 = 256 * pn + 64 * wc + 32 * bj + j0; }
    else { const int t = n >> 8, blk = t >> 1, half = t & 1, which = (n >> 7) & 1, j0 = n & 127; W = (which ? d.W2 : d.W) + (size_t)blk * 65536; c0 = half * 128 + j0; }
    const float* wp = W + (size_t)(k0 + l4) * d.ldw + c0;
    f32x4 v[16];
#pragma unroll
    for (int i = 0; i < 16; ++i) v[i] = *(const f32x4*)(wp + (size_t)(4 * i) * d.ldw);
    if (d.gain) {
#pragma unroll
        for (int i = 0; i < 16; ++i) v[i] *= d.gain[k0 + 4 * i + l4];
    }
#pragma unroll
    for (int i = 0; i < 16; ++i) { LAS float* s = scr + (4 * i + l4) * 65 + 4 * l16; s[0] = v[i][0]; s[1] = v[i][1]; s[2] = v[i][2]; s[3] = v[i][3]; }
    LDS_WAIT(); asm volatile("" ::: "memory");
    const int c = lane & 7;
#pragma unroll
    for (int j = 0; j < 8; ++j) { const int nn = (lane >> 3) + 8 * j; const LAS float* s = scr + (8 * c) * 65 + nn;
        u32x4 o; o.x = cvt_pk_bf16(s[0 * 65], s[1 * 65]); o.y = cvt_pk_bf16(s[2 * 65], s[3 * 65]); o.z = cvt_pk_bf16(s[4 * 65], s[5 * 65]); o.w = cvt_pk_bf16(s[6 * 65], s[7 * 65]);
        *(u32x4*)(d.dst + (size_t)(n0 + nn) * d.K + k0 + 8 * c) = o; }
    LDS_WAIT(); asm volatile("" ::: "memory");
}
enum { I_X = 0, I_F1N, I_F1W13, I_F1W2, I_MIXN, I_AWIN, I_ACW, I_ACB, I_AWR, I_ABR, I_AWI, I_ABI, I_ALAM, I_AWOUT, I_KVN, I_WKV, I_KN, I_BWQ, I_QN, I_BWO, I_F2N, I_F2W13, I_F2W2 };
constexpr int IT_W13 = (D / 64) * (2 * FF / 64), IT_W2 = (FF / 64) * (D / 64), IT_2048 = (D / 64) * (2048 / 64), IT_1024 = (D / 64) * (D / 64), IT_RI = (256 / 64) * (2048 / 64);
__device__ __forceinline__ CvtDesc cvt_desc(const Args& a, int id) {
    unsigned char* ws = a.ws; CvtDesc d; d.W2 = nullptr; d.gain = nullptr;
    switch (id) {
    case 0: d = {a.in[I_F1W13], nullptr, (bf16_t*)(ws + WS_WA13), a.in[I_F1N], 2 * FF, D, 2 * FF / 64, 1}; break;
    case 1: d = {a.in[I_F1W2], nullptr, (bf16_t*)(ws + WS_WA2), nullptr, D, FF, D / 64, 0}; break;
    case 2: d = {a.in[I_F2W13], nullptr, (bf16_t*)(ws + WS_WB13), a.in[I_F2N], 2 * FF, D, 2 * FF / 64, 1}; break;
    case 3: d = {a.in[I_F2W2], nullptr, (bf16_t*)(ws + WS_WB2), nullptr, D, FF, D / 64, 0}; break;
    case 4: d = {a.in[I_WKV], nullptr, (bf16_t*)(ws + WS_WKV), a.in[I_KVN], 2048, D, 2048 / 64, 2}; break;
    case 5: d = {a.in[I_F1W13] + (size_t)D * 2 * FF, nullptr, (bf16_t*)(ws + WS_WC13), a.in[I_F1N] + D, 2 * FF, D, 2 * FF / 64, 1}; break;
    case 6: d = {a.in[I_F1W2] + (size_t)FF * D, nullptr, (bf16_t*)(ws + WS_WC2), nullptr, D, FF, D / 64, 0}; break;
    case 7: d = {a.in[I_AWIN], nullptr, (bf16_t*)(ws + WS_WIN), a.in[I_MIXN], 2048, D, 2048 / 64, 0}; break;
    case 8: d = {a.in[I_AWR], a.in[I_AWI], (bf16_t*)(ws + WS_WRI), nullptr, 256, 256, 2048 / 64, 3}; break;
    case 9: d = {a.in[I_AWOUT], nullptr, (bf16_t*)(ws + WS_WOUT), nullptr, D, D, D / 64, 0}; break;
    case 10: d = {a.in[I_BWQ], nullptr, (bf16_t*)(ws + WS_WQ), a.in[I_MIXN] + D, D, D, D / 64, 2}; break;
    case 11: d = {a.in[I_BWO], nullptr, (bf16_t*)(ws + WS_WO), nullptr, D, D, D / 64, 0}; break;
    case 12: d = {a.in[I_F2W13] + (size_t)D * 2 * FF, nullptr, (bf16_t*)(ws + WS_WA13), a.in[I_F2N] + D, 2 * FF, D, 2 * FF / 64, 1}; break;
    default: d = {a.in[I_F2W2] + (size_t)FF * D, nullptr, (bf16_t*)(ws + WS_WA2), nullptr, D, FF, D / 64, 0}; break;
    }
    return d;
}
__device__ __forceinline__ int cvt_items(int id) {
    switch (id) { case 0: case 2: case 5: case 12: return IT_W13; case 1: case 3: case 6: case 13: return IT_W2; case 4: case 7: return IT_2048; case 8: return IT_RI; default: return IT_1024; }
}
__device__ __forceinline__ void cvt_range(const Args& a, const Frame& F, int id_lo, int id_hi, int wg_lo, int wg_n) {
    LAS float* scr = (LAS float*)(F.lds + F.wave * 16896);
    int total = 0; for (int id = id_lo; id < id_hi; ++id) total += cvt_items(id);
    const int rank = (int)blockIdx.x - wg_lo; if (rank < 0 || rank >= wg_n) return;
    for (int it = rank * NWAVES + F.wave; it < total; it += wg_n * NWAVES) {
        int r = it, id = id_lo; while (r >= cvt_items(id)) { r -= cvt_items(id); ++id; }
        const CvtDesc d = cvt_desc(a, id); cvt_item(d, r, scr, F.lane);
    }
}

__device__ __forceinline__ void p0_rows(const Args& a, const Frame& F) {
    const float* x = a.in[I_X]; bf16_t* xb = (bf16_t*)(a.ws + WS_XB); float* ss = (float*)(a.ws + WS_SS);
    for (int m = F.gw; m < M; m += 2 * F.NGW) {
        const int m2 = m + F.NGW;
        const bool has2 = m2 < M;
        const f32x4* xr = (const f32x4*)(x + (size_t)m * D) + F.lane; const f32x4* xr2 = (const f32x4*)(x + (size_t)(has2 ? m2 : m) * D) + F.lane;
        f32x4 v[4], v2[4]; float s = 0.f, s2 = 0.f;
#pragma unroll
        for (int j = 0; j < 4; ++j) { v[j] = xr[64 * j]; v2[j] = xr2[64 * j]; }
#pragma unroll
        for (int j = 0; j < 4; ++j) { s += (v[j][0] * v[j][0] + v[j][1] * v[j][1]) + (v[j][2] * v[j][2] + v[j][3] * v[j][3]); s2 += (v2[j][0] * v2[j][0] + v2[j][1] * v2[j][1]) + (v2[j][2] * v2[j][2] + v2[j][3] * v2[j][3]); }
        s = wave_sum(s); s2 = wave_sum(s2);
        u32x2* o = (u32x2*)(xb + (size_t)m * D) + F.lane; u32x2* o2 = (u32x2*)(xb + (size_t)m2 * D) + F.lane;
#pragma unroll
        for (int j = 0; j < 4; ++j) { u32x2 w; w.x = cvt_pk_bf16(v[j][0], v[j][1]); w.y = cvt_pk_bf16(v[j][2], v[j][3]); o[64 * j] = w;
            if (has2) { u32x2 w2; w2.x = cvt_pk_bf16(v2[j][0], v2[j][1]); w2.y = cvt_pk_bf16(v2[j][2], v2[j][3]); o2[64 * j] = w2; } }
        if (F.lane == 0) { ss[m] = s; if (has2) ss[m2] = s2; }
    }
    for (int i = blockIdx.x * NTHR + F.tid; i < 5 * M; i += F.G * NTHR) ss[M + i] = 0.f;
    if (blockIdx.x == 0) for (int c = F.tid; c < D; c += NTHR) { const float l = a.in[I_ALAM][c]; ((float*)(a.ws + WS_SP8))[c] = -8.0f * LOG2E * (fmaxf(-l, 0.f) + log1pf(expf(-fabsf(l)))); }
}

__device__ __forceinline__ void conv_phase(const Args& a, const Frame& F) {
    const bf16_t* rec = (const bf16_t*)(a.ws + WS_REC); bf16_t* xc = (bf16_t*)(a.ws + WS_Y);
    constexpr int CR = 16, NITEM = (M / CR) * 4;
    for (int it = F.gw; it < NITEM; it += F.NGW) {
        const int cq = it & 3, m0 = (it >> 2) * CR, t0 = m0 & (SEQ - 1), ch = cq * 256 + 4 * F.lane;
        f32x4 w[4];
#pragma unroll
        for (int k = 0; k < 4; ++k) w[k] = *(const f32x4*)(a.in[I_ACW] + k * D + ch);
        const f32x4 bv = *(const f32x4*)(a.in[I_ACB] + ch);
        u32x2 rw[CR + 3];
#pragma unroll
        for (int i = 0; i < CR + 3; ++i) { const int r = m0 - 3 + i; rw[i] = (i >= 3 || t0 > 0) ? *(const u32x2*)(rec + (size_t)r * D + ch) : (u32x2){0u, 0u}; }
#pragma unroll
        for (int i = 0; i < CR; ++i) {
            f32x4 y = bv;
#pragma unroll
            for (int k = 0; k < 4; ++k) { const u32x2 q = rw[i + k]; y += w[k] * (f32x4){bf_lo(q.x), bf_hi(q.x), bf_lo(q.y), bf_hi(q.y)}; }
            u32x2 o; o.x = cvt_pk_bf16(y[0], y[1]); o.y = cvt_pk_bf16(y[2], y[3]); *(u32x2*)(xc + (size_t)(m0 + i) * D + ch) = o;
        }
    }
}

constexpr int SC_L = 64, SC_C = SEQ / SC_L;
__device__ __forceinline__ void scan_a(const Args& a, const Frame& F) {
    const bf16_t* av = (const bf16_t*)(a.ws + WS_REC); const bf16_t* uv = (const bf16_t*)(a.ws + WS_U);
    f32x4* hl = (f32x4*)(a.ws + WS_HL); f32x4* pc = (f32x4*)(a.ws + WS_PC);
    if (F.tid >= 256) return;
    for (int item = blockIdx.x * 256 + F.tid; item < BATCH * SC_C * 256; item += F.G * 256) {
        const int cgp = item & 255, bc = item >> 8; const size_t row0 = (size_t)bc * SC_L;
        f32x4 h = {0.f, 0.f, 0.f, 0.f}, p = {1.f, 1.f, 1.f, 1.f};
#pragma unroll 8
        for (int t = 0; t < SC_L; ++t) { const u32x2 aw = *(const u32x2*)(av + (row0 + t) * D + 4 * cgp); const f32x4 aa = {__builtin_amdgcn_exp2f(bf_lo(aw.x)), __builtin_amdgcn_exp2f(bf_hi(aw.x)), __builtin_amdgcn_exp2f(bf_lo(aw.y)), __builtin_amdgcn_exp2f(bf_hi(aw.y))}; const u32x2 uw = *(const u32x2*)(uv + (row0 + t) * D + 4 * cgp);
            const f32x4 uu = {bf_lo(uw.x), bf_hi(uw.x), bf_lo(uw.y), bf_hi(uw.y)}; h = aa * h + uu; p = p * aa; }
        hl[item] = h; pc[item] = p;
    }
}
__device__ __forceinline__ void scan_b(const Args& a, const Frame& F) {
    const bf16_t* av = (const bf16_t*)(a.ws + WS_REC); const bf16_t* uv = (const bf16_t*)(a.ws + WS_U); const bf16_t* gb = (const bf16_t*)(a.ws + WS_GB); bf16_t* yb = (bf16_t*)(a.ws + WS_Y);
    const f32x4* hl = (const f32x4*)(a.ws + WS_HL); const f32x4* pc = (const f32x4*)(a.ws + WS_PC);
    if (F.tid >= 256) return;
    for (int item = blockIdx.x * 256 + F.tid; item < BATCH * SC_C * 256; item += F.G * 256) {
        const int cgp = item & 255, bc = item >> 8, ck = bc & (SC_C - 1), b0 = bc - ck; const size_t row0 = (size_t)bc * SC_L;
        f32x4 h = {0.f, 0.f, 0.f, 0.f};
        int j = 0;
        for (; j + 8 <= ck; j += 8) {
            f32x4 pp[8], hh[8];
#pragma unroll
            for (int e = 0; e < 8; ++e) { pp[e] = pc[(b0 + j + e) * 256 + cgp]; hh[e] = hl[(b0 + j + e) * 256 + cgp]; }
#pragma unroll
            for (int e = 0; e < 8; ++e) h = pp[e] * h + hh[e];
        }
        for (; j < ck; ++j) h = pc[(b0 + j) * 256 + cgp] * h + hl[(b0 + j) * 256 + cgp];
#pragma unroll 8
        for (int t = 0; t < SC_L; ++t) { const size_t off = (row0 + t) * D + 4 * cgp; const u32x2 aw = *(const u32x2*)(av + off); const f32x4 aa = {__builtin_amdgcn_exp2f(bf_lo(aw.x)), __builtin_amdgcn_exp2f(bf_hi(aw.x)), __builtin_amdgcn_exp2f(bf_lo(aw.y)), __builtin_amdgcn_exp2f(bf_hi(aw.y))}; const u32x2 uw = *(const u32x2*)(uv + off);
            const f32x4 uu = {bf_lo(uw.x), bf_hi(uw.x), bf_lo(uw.y), bf_hi(uw.y)}; h = aa * h + uu;
            const u32x2 gw = *(const u32x2*)(gb + off); u32x2 o; o.x = cvt_pk_bf16(h[0] * bf_lo(gw.x), h[1] * bf_hi(gw.x)); o.y = cvt_pk_bf16(h[2] * bf_lo(gw.y), h[3] * bf_hi(gw.y));
            *(u32x2*)(yb + off) = o; }
    }
}

constexpr float SB_TINY = 5.42e-20f;
struct SbFrag { bf16x8 kf[4]; bf16x8 vf[2][2]; };
constexpr int ATT_KSTR = 1088, ATT_VOFF = 4 * ATT_KSTR, ATT_SLOT = ATT_VOFF + 4096, WAVE_LDS = 2 * ATT_SLOT;
__device__ __forceinline__ void sb_dma(LAS unsigned char* slot, const bf16_t* kg, const bf16_t* vg, int k0) {
    const bf16_t* k = kg + (size_t)k0 * D; const bf16_t* v = vg + k0;
#define SB_GLDS(g, o) __builtin_amdgcn_global_load_lds((const unsigned*)(g), (LAS unsigned*)(slot + (o)), 16, 0, 0)
    SB_GLDS(k, 0); SB_GLDS(k + 8 * D, ATT_KSTR); SB_GLDS(k + 16 * D, 2 * ATT_KSTR); SB_GLDS(k + 24 * D, 3 * ATT_KSTR);
    SB_GLDS(v, ATT_VOFF); SB_GLDS(v + (size_t)16 * SEQ, ATT_VOFF + 1024); SB_GLDS(v + (size_t)32 * SEQ, ATT_VOFF + 2048); SB_GLDS(v + (size_t)48 * SEQ, ATT_VOFF + 3072);
#undef SB_GLDS
}
template <int N> __device__ __forceinline__ void sb_wait() { asm volatile("s_waitcnt vmcnt(%0)" :: "n"(N) : "memory"); }
struct SbAddr { int k[4]; int v[4]; };
__device__ __forceinline__ void sb_read(SbFrag& f, const LAS unsigned char* slot, const SbAddr& ad) {
#pragma unroll
    for (int d0 = 0; d0 < 4; ++d0) f.kf[d0] = *(const LAS bf16x8*)(slot + ad.k[d0]);
#pragma unroll
    for (int dh = 0; dh < 2; ++dh)
#pragma unroll
        for (int mm = 0; mm < 2; ++mm) f.vf[dh][mm] = *(const LAS bf16x8*)(slot + ad.v[dh * 2 + mm]);
}
template <bool DIAG> __device__ __forceinline__ void sb_tile(const SbFrag& f, const bf16x8 (&qf)[4], f32x16& o0, f32x16& o1, float& carry, int lim, int hi) {
    f32x16 s;
#pragma unroll
    for (int r = 0; r < 16; ++r) s[r] = 0.f;
#pragma unroll
    for (int d0 = 0; d0 < 4; ++d0) s = __builtin_amdgcn_mfma_f32_32x32x16_bf16(f.kf[d0], qf[d0], s, 0, 0, 0);
    float wv[16]; float run = 1.f;
#pragma unroll
    for (int r = 15; r >= 0; --r) {
        float stay = __builtin_amdgcn_rcpf(1.0f + __builtin_amdgcn_exp2f(s[r]));
        float beta = 1.0f - stay;
        if (DIAG) { const bool ok = r < lim; stay = ok ? stay : 1.0f; beta = ok ? beta : 0.f; }
        wv[r] = beta * run; run *= stay;
    }
    const float other = __shfl_xor(run, 32);
    const float base = carry * (hi == 0 ? other : 1.0f);
    carry *= run * other;
    u32x4 p0, p1;
    p0.x = cvt_pk_bf16(wv[0] * base, wv[1] * base); p0.y = cvt_pk_bf16(wv[2] * base, wv[3] * base); p0.z = cvt_pk_bf16(wv[4] * base, wv[5] * base); p0.w = cvt_pk_bf16(wv[6] * base, wv[7] * base);
    p1.x = cvt_pk_bf16(wv[8] * base, wv[9] * base); p1.y = cvt_pk_bf16(wv[10] * base, wv[11] * base); p1.z = cvt_pk_bf16(wv[12] * base, wv[13] * base); p1.w = cvt_pk_bf16(wv[14] * base, wv[15] * base);
    const bf16x8 pa0 = __builtin_bit_cast(bf16x8, p0), pa1 = __builtin_bit_cast(bf16x8, p1);
    o0 = __builtin_amdgcn_mfma_f32_32x32x16_bf16(pa0, f.vf[0][0], o0, 0, 0, 0); o0 = __builtin_amdgcn_mfma_f32_32x32x16_bf16(pa1, f.vf[0][1], o0, 0, 0, 0);
    o1 = __builtin_amdgcn_mfma_f32_32x32x16_bf16(pa0, f.vf[1][0], o1, 0, 0, 0); o1 = __builtin_amdgcn_mfma_f32_32x32x16_bf16(pa1, f.vf[1][1], o1, 0, 0, 0);
}
__device__ __forceinline__ void sb_unit(const bf16_t* Q, const bf16_t* K, const bf16_t* VT, bf16_t* O, int b, int h, int qb, int lane, LAS unsigned char* slotA, LAS unsigned char* slotB, const SbAddr& ad) {
    const int j = lane & 31, hi = lane >> 5, q0 = qb * 32; const size_t rowbase = (size_t)b * SEQ;
    const bf16_t* qp = Q + (rowbase + q0 + j) * D + h * HD + 8 * hi;
    bf16x8 qf[4];
#pragma unroll
    for (int d0 = 0; d0 < 4; ++d0) qf[d0] = *(const bf16x8*)(qp + 16 * d0);
    const int k8w = lane >> 3, cw = (lane & 7) ^ k8w, aw = lane >> 4, d16w = 4 * ((lane >> 2) & 3) + aw, pw = (lane & 3) ^ aw;
    const bf16_t* kg = K + (rowbase + k8w) * D + h * HD + 8 * cw;
    const bf16_t* vg = VT + ((size_t)(b * NH + h) * HD + d16w) * SEQ + 8 * pw;
    f32x16 o0, o1;
#pragma unroll
    for (int r = 0; r < 16; ++r) { o0[r] = 0.f; o1[r] = 0.f; }
    float carry = 1.f;
    SbFrag f;
    sb_dma(slotA, kg, vg, q0);
    sb_dma(slotB, kg, vg, qb > 0 ? q0 - 32 : 0);
    sb_wait<8>(); sb_read(f, slotA, ad);
    sb_tile<true>(f, qf, o0, o1, carry, j - 16 * hi, hi);
    for (int kt = qb - 1; kt >= 0; kt -= 2) {
        sb_dma(slotA, kg, vg, (kt > 0 ? kt - 1 : 0) * 32);
        sb_wait<8>(); sb_read(f, slotB, ad);
        sb_tile<false>(f, qf, o0, o1, carry, 64, hi);
        if (kt == 0 || __all(carry < SB_TINY)) break;
        sb_dma(slotB, kg, vg, (kt > 1 ? kt - 2 : 0) * 32);
        sb_wait<8>(); sb_read(f, slotA, ad);
        sb_tile<false>(f, qf, o0, o1, carry, 64, hi);
        if (__all(carry < SB_TINY)) break;
    }
    sb_wait<0>();
    bf16_t* op = O + (rowbase + q0) * D + h * HD + j;
#pragma unroll
    for (int r = 0; r < 16; ++r) { const int qr = (r & 3) + 8 * (r >> 2) + 4 * hi;
        op[(size_t)qr * D] = (bf16_t)(cvt_pk_bf16(o0[r], 0.f) & 0xffffu); op[(size_t)qr * D + 32] = (bf16_t)(cvt_pk_bf16(o1[r], 0.f) & 0xffffu); }
}
__device__ __forceinline__ void attn_phase(const Args& a, const Frame& F) {
    const bf16_t* Q = (const bf16_t*)(a.ws + WS_Q); const bf16_t* K = (const bf16_t*)(a.ws + WS_K); const bf16_t* VT = (const bf16_t*)(a.ws + WS_VT); bf16_t* O = (bf16_t*)(a.ws + WS_O);
    constexpr int NQB = SEQ / 32, NU = BATCH * NH * NQB;
    LAS unsigned char* slotA = F.lds + F.wave * WAVE_LDS;
    SbAddr ad;
    { const int j = F.lane & 31, hi = F.lane >> 5, key = 16 * ((j >> 2) & 1) + (j & 3) + 4 * (j >> 3), ki = key >> 3, k8 = key & 7;
#pragma unroll
      for (int d0 = 0; d0 < 4; ++d0) ad.k[d0] = ki * ATT_KSTR + (8 * k8 + ((2 * d0 + hi) ^ k8)) * 16;
#pragma unroll
      for (int dh = 0; dh < 2; ++dh)
#pragma unroll
          for (int mm = 0; mm < 2; ++mm) { const int dd = 32 * dh + j, vi = dd >> 4, d16 = dd & 15, a_ = d16 & 3, b_ = d16 >> 2, p = 2 * hi + mm; ad.v[dh * 2 + mm] = ATT_VOFF + vi * 1024 + (16 * a_ + 4 * b_ + (p ^ a_)) * 16; } }
    for (int u = F.gw; u < NU; u += F.NGW) { const int bh = u / NQB, qb = u % NQB; sb_unit(Q, K, VT, O, bh / NH, bh % NH, qb, F.lane, slotA, slotA + ATT_SLOT, ad); }
}

__global__ void __launch_bounds__(NTHR) fwd_kernel(Args args) {
    extern __shared__ __attribute__((aligned(16))) unsigned char lds_raw[];
    Frame F; F.lds = (LAS unsigned char*)lds_raw; F.tid = threadIdx.x; F.lane = F.tid & 63; F.wave = __builtin_amdgcn_readfirstlane(F.tid >> 6);
    F.G = gridDim.x; F.gw = blockIdx.x * NWAVES + F.wave; F.NGW = F.G * NWAVES;
    unsigned char* ws = args.ws;
    float* ss = (float*)(ws + WS_SS);
    const int lo = args.ph_lo, hi = args.ph_hi;
#if MK_COOP
    cg::grid_group grid = cg::this_grid();
    volatile LAS unsigned* MISC = (volatile LAS unsigned*)(F.lds + MISC_OFF);
    if (F.tid < 16) MISC[F.tid] = 0u;
    __syncthreads();
    const XcdBarrier xbar = xcd_barrier_post((unsigned*)ws, MISC + 8);
    if (hi > N_PHASES) grid.sync();
#define SEAM(k) do { if (lo <= (k) && (k) + 1 < hi) xcd_barrier(xbar); } while (0)
#else
#define SEAM(k) do { } while (0)
#endif
#ifndef PH_MASK
#define PH_MASK 0x3ffff
#endif
#define IN(k) (((PH_MASK >> (k)) & 1) && lo <= (k) && (k) < hi)
    using namespace pg8;
    bf16_t* XB = (bf16_t*)(ws + WS_XB); bf16_t* ACT = (bf16_t*)(ws + WS_ACT);
    const int bx = blockIdx.x;
#define RUN_GEMM(EPI, ALIGN, Aptr, Bptr, N_, K_, lda_, adiv_, ...) do { Gemm g{(const bf16_t*)(Aptr), (const bf16_t*)(Bptr), M, (N_), (K_), (lda_), (adiv_)}; StaticOrder S; S.init(M, (N_), F.G, bx); \
        EPI E{__VA_ARGS__}; gemm_phase<EPI, ALIGN>(F.lds, g, S, E); } while (0)

#ifndef DUP_MASK
#define DUP_MASK 0
#endif
#if MK_COOP
#define REDO_BAR() xcd_barrier(xbar)
#else
#define REDO_BAR() do { } while (0)
#endif
#define PHASE(k, ...) do { if (IN(k)) { __VA_ARGS__; if ((DUP_MASK >> (k)) & 1) { REDO_BAR(); __VA_ARGS__; } } SEAM(k); } while (0)
    PHASE(0, cvt_range(args, F, 0, 1, 0, F.G); p0_rows(args, F));
    const int T22 = (64 * 22) % F.G, T30 = (64 * 30) % F.G;
    PHASE(1, RUN_GEMM(EpiSwiglu, true, XB, ws + WS_WA13, 2 * FF, D, D, 0, ss, ACT); cvt_range(args, F, 1, 4, T22, F.G - T22); cvt_range(args, F, 7, 10, T22, F.G - T22));
    PHASE(2, RUN_GEMM(EpiResidIn, true, ACT, ws + WS_WA2, D, FF, FF, 0, args.in[I_X], nullptr, XB, ss + M, 0.5f));
    PHASE(3, RUN_GEMM(EpiWin, true, XB, ws + WS_WIN, 2048, D, D, 0, ss + M, (bf16_t*)(ws + WS_GB), (bf16_t*)(ws + WS_REC)));
    PHASE(4, conv_phase(args, F));
    PHASE(5, RUN_GEMM(EpiGate, true, ws + WS_Y, ws + WS_WRI, 2048, 256, D, 2, (const bf16_t*)(ws + WS_Y), args.in[I_ABR], args.in[I_ABI], (const float*)(ws + WS_SP8), (bf16_t*)(ws + WS_REC), (bf16_t*)(ws + WS_U)));
    PHASE(6, scan_a(args, F));
    PHASE(7, scan_b(args, F));
    PHASE(8, RUN_GEMM(EpiResidMid, true, ws + WS_Y, ws + WS_WOUT, D, D, D, 0, nullptr, nullptr, XB, ss + 2 * M, 1.0f));
    PHASE(9, RUN_GEMM(EpiSwiglu, true, XB, ws + WS_WB13, 2 * FF, D, D, 0, ss + 2 * M, ACT); cvt_range(args, F, 4, 7, T22, F.G - T22));
    PHASE(10, RUN_GEMM(EpiResidMid, true, ACT, ws + WS_WB2, D, FF, FF, 0, nullptr, nullptr, XB, ss + 3 * M, 0.5f));
    PHASE(11, RUN_GEMM(EpiKvSwiglu, true, XB, ws + WS_WKV, 2048 + 2 * FF, D, D, 0, ss + 3 * M, args.in[I_KN], (bf16_t*)(ws + WS_K), (bf16_t*)(ws + WS_VT), ACT); cvt_range(args, F, 10, 14, T30, F.G - T30));
    PHASE(12, RUN_GEMM(EpiResidMid, true, ACT, ws + WS_WC2, D, FF, FF, 0, nullptr, nullptr, XB, ss + 4 * M, 0.5f));
    PHASE(13, RUN_GEMM(EpiQ, true, XB, ws + WS_WQ, D, D, D, 0, ss + 4 * M, args.in[I_QN], (bf16_t*)(ws + WS_Q)));
    PHASE(14, attn_phase(args, F));
    PHASE(15, RUN_GEMM(EpiResidMid, true, ws + WS_O, ws + WS_WO, D, D, D, 0, nullptr, nullptr, XB, ss + 5 * M, 1.0f));
    PHASE(16, RUN_GEMM(EpiSwiglu, true, XB, ws + WS_WA13, 2 * FF, D, D, 0, ss + 5 * M, ACT));
    PHASE(17, RUN_GEMM(EpiResidOut, true, ACT, ws + WS_WA2, D, FF, FF, 0, nullptr, args.out, XB, nullptr, 0.5f));
}

extern "C" void kernel_launch(void* const* d_in, const int* in_sizes, int n_in, void* d_out, int out_size, void* d_ws, size_t ws_size, hipStream_t stream) {
    static int grid = 0;
    if (grid == 0) {
        if (n_in != 23 || out_size != M * D || ws_size < WS_END) { fprintf(stderr, "kernel_launch: unexpected problem (n_in %d out %d ws %zu)\n", n_in, out_size, ws_size); grid = -1; return; }
        int dev = 0, cus = 0, per_cu = 0;
        (void)hipGetDevice(&dev); (void)hipDeviceGetAttribute(&cus, hipDeviceAttributeMultiprocessorCount, dev);
        if (hipFuncSetAttribute((const void*)fwd_kernel, hipFuncAttributeMaxDynamicSharedMemorySize, LDS_BYTES) != hipSuccess) { fprintf(stderr, "kernel_launch: hipFuncSetAttribute failed\n"); grid = -1; return; }
        if (hipOccupancyMaxActiveBlocksPerMultiprocessor(&per_cu, (const void*)fwd_kernel, NTHR, LDS_BYTES) != hipSuccess || per_cu < 1) { fprintf(stderr, "kernel_launch: occupancy query says %d\n", per_cu); per_cu = 1; }
        (void)hipGetLastError();
        grid = cus * 1;
        if (grid <= 0) grid = 256;
    }
    if (grid < 0) return;
    Args a{};
    for (int i = 0; i < 23; ++i) a.in[i] = (const float*)d_in[i];
    a.out = (float*)d_out; a.ws = (unsigned char*)d_ws;
#if MK_COOP
    a.ph_lo = 0; a.ph_hi = N_PHASES;
    if (hipMemsetAsync(d_ws, 0, 16 * KiB, stream) != hipSuccess) { fprintf(stderr, "kernel_launch: memset of the barrier words failed\n"); return; }
    void* kargs[] = {&a};
    hipError_t e = hipLaunchCooperativeKernel((const void*)fwd_kernel, dim3(grid), dim3(NTHR), kargs, LDS_BYTES, stream);
    if (e != hipSuccess) fprintf(stderr, "kernel_launch: cooperative launch failed: %s (grid %d)\n", hipGetErrorString(e), grid);
#else
    for (int p = 0; p < N_PHASES; ++p) { a.ph_lo = p; a.ph_hi = p + 1; hipLaunchKernelGGL(fwd_kernel, dim3(grid), dim3(NTHR), LDS_BYTES, stream, a); }
#endif
}
```

```cpp
#include <hip/hip_runtime.h>
#include <hip/hip_cooperative_groups.h>
#include <cstdio>
#include <cstdint>
#include <cmath>
namespace cg = cooperative_groups;

#ifndef MK_COOP
#define MK_COOP 1
#endif

#define LAS __attribute__((address_space(3)))
typedef unsigned short bf16_t;
typedef short bf16x8 __attribute__((ext_vector_type(8)));
typedef float f32x4 __attribute__((ext_vector_type(4)));
typedef float f32x2 __attribute__((ext_vector_type(2)));
typedef float f32x16 __attribute__((ext_vector_type(16)));
typedef unsigned u32x4 __attribute__((ext_vector_type(4)));
typedef unsigned u32x2 __attribute__((ext_vector_type(2)));

constexpr int BATCH = 4, SEQ = 4096, D = 1024, FF = 2816, NH = 16, HD = 64;
constexpr int M = BATCH * SEQ;
constexpr float EPS = 1e-6f;
constexpr float LOG2E = 1.4426950408889634f, LN2 = 0.6931471805599453f;

constexpr size_t MiB = 1u << 20, KiB = 1u << 10;
constexpr size_t WS_SS = 64 * KiB;
constexpr size_t WS_SP8 = 32 * KiB;
constexpr size_t WS_HL = 1 * MiB, WS_PC = 2 * MiB;
constexpr size_t SZ_W13 = (size_t)2 * FF * D * 2, SZ_W2 = (size_t)D * FF * 2;
constexpr size_t WS_WA13 = 4 * MiB, WS_WA2 = WS_WA13 + SZ_W13;
constexpr size_t WS_WB13 = WS_WA2 + SZ_W2, WS_WB2 = WS_WB13 + SZ_W13;
constexpr size_t WS_WKV = WS_WB2 + SZ_W2, WS_WC13 = WS_WKV + 4 * MiB, WS_WC2 = WS_WC13 + SZ_W13;
constexpr size_t WS_WIN = WS_WC2 + SZ_W2, WS_WRI = WS_WIN + 4 * MiB, WS_WOUT = WS_WRI + 1 * MiB, WS_WQ = WS_WOUT + 2 * MiB, WS_WO = WS_WQ + 2 * MiB;
constexpr size_t WS_XB = 69 * MiB;
constexpr size_t WS_ACT = 101 * MiB;
constexpr size_t WS_K = 189 * MiB, WS_VT = 221 * MiB, WS_END = 253 * MiB;
constexpr size_t WS_GB = WS_ACT, WS_U = WS_ACT + 32 * MiB, WS_REC = WS_ACT + 64 * MiB;
constexpr size_t WS_Y = WS_ACT + 96 * MiB;
constexpr size_t WS_Q = WS_ACT, WS_O = WS_ACT + 32 * MiB;
static_assert(WS_WO + 2 * MiB <= WS_XB && WS_REC + 64 * MiB <= WS_END, "ws map");

__device__ __forceinline__ unsigned cvt_pk_bf16(float lo, float hi) {
    typedef __bf16 bf16x2_t __attribute__((ext_vector_type(2)));
    f32x2 v = {lo, hi}; bf16x2_t b = __builtin_convertvector(v, bf16x2_t); return __builtin_bit_cast(unsigned, b);
}
__device__ __forceinline__ float bf_lo(unsigned w) { return __uint_as_float(w << 16); }
__device__ __forceinline__ float bf_hi(unsigned w) { return __uint_as_float(w & 0xffff0000u); }
__device__ __forceinline__ float sigm(float x) { return __builtin_amdgcn_rcpf(1.0f + __builtin_amdgcn_exp2f(-x * LOG2E)); }
__device__ __forceinline__ float gelu_tanh(float x) { return x * sigm(1.5957691216057308f * (x + 0.044715f * x * x * x)); }
__device__ __forceinline__ float wave_sum(float v) {
#pragma unroll
    for (int o = 1; o < 64; o <<= 1) v += __shfl_xor(v, o);
    return v;
}
#define LDS_WAIT() asm volatile("s_waitcnt lgkmcnt(0)" ::: "memory")

namespace pg8 {
constexpr int BM = 256, BK = 64, HALF = 128, HTB = HALF * BK * 2, STAGE_BYTES = 8 * HTB, NXCD = 8, WGM = 4;
__host__ __device__ __forceinline__ int lds_byte(int r, int c) { const int st = (r >> 4) * 2 + (c >> 5), rr = r & 15, cc = c & 31, ob = rr * 64 + cc * 2; return st * 1024 + (ob ^ (((ob >> 9) & 1) << 5)); }
__host__ __device__ __forceinline__ void stage_rc(int b, int& R, int& C) { const int st = b / 1024, sb = b % 1024, swz = sb ^ (((sb >> 9) & 1) << 5); R = (st >> 1) * 16 + swz / 64; C = (st & 1) * 32 + (swz % 64) / 2; }
__host__ __device__ __forceinline__ int perm32(int rho) { const int n = rho >> 4, i = rho & 15; return 8 * (i >> 2) + 4 * n + (i & 3); }

struct Unit { int pm, pn; };
struct Gemm { const bf16_t* A; const bf16_t* Bt; int M, N, K, lda, adiv; };

struct StaticOrder {
    int nM, nN, nwg, G, c;
    __device__ void init(int M_, int N_, int G_, int c_) { nM = M_ / BM; nN = N_ / BM; nwg = nM * nN; G = G_; c = c_; }
    __device__ bool next(int i, Unit& u) const {
        const long L = (long)i * G + c; if (L >= nwg) return false;
        int wgid = (int)L; { const int q = nwg / NXCD, r = nwg % NXCD, xcd = wgid % NXCD, off = wgid / NXCD; wgid = (xcd < r ? xcd * (q + 1) : r * (q + 1) + (xcd - r) * q) + off; }
        const int nig = WGM * nN, gid = wgid / nig, fm = gid * WGM, gsz = (nM - fm) < WGM ? (nM - fm) : WGM;
        u.pm = fm + ((wgid % nig) % gsz); u.pn = (wgid % nig) / gsz; return true;
    }
};

template <class Epi, bool ALIGN_EPI>
__device__ __forceinline__ void gemm_phase(LAS unsigned char* lds, const Gemm g, const StaticOrder& S, const Epi& E) {
    const int tid = threadIdx.x, wid = __builtin_amdgcn_readfirstlane(tid >> 6), lane = tid & 63, wr = wid >> 2, wc = wid & 3, fr = lane & 15, fq = lane >> 4;
    const int K = g.K, nt = K / BK, lda = g.lda;
    unsigned voffA[2], voffB[2];
#pragma unroll
    for (int i = 0; i < 2; ++i) { int R, C; stage_rc(tid * 16 + i * 8192, R, C); const int Rb = (R & ~31) + perm32(R & 31);
        voffA[i] = (unsigned)(R * lda + C) * 2u; voffB[i] = (unsigned)(Rb * K + C) * 2u; }
    const size_t kstep = (size_t)(BK * 2);
    const size_t hA = (size_t)HALF * lda * 2, hB = (size_t)HALF * K * 2;
    const size_t tA = 2 * hA, tB = 2 * hB;
    const unsigned ldsw = (unsigned)wid * 1024u;
    const int aoff = lds_byte(wr * 64 + fr, fq * 8), boff = lds_byte(wc * 32 + fr, fq * 8);
#define PG8_SA(b, h) (((b) * 2 + (h)) * HTB)
#define PG8_SB(b, h) ((4 + (b) * 2 + (h)) * HTB)
#define PG8_STAGE(bufoff, gbase, voff) do { _Pragma("unroll") for (int _i = 0; _i < 2; ++_i) \
        __builtin_amdgcn_global_load_lds((const unsigned*)((const char*)(gbase) + (voff)[_i]), (LAS unsigned*)(lds + (bufoff) + ldsw + _i * 8192), 16, 0, 0); } while (0)
#define PG8_LDA(dst, b, h) do { _Pragma("unroll") for (int m = 0; m < 4; ++m) _Pragma("unroll") for (int k = 0; k < 2; ++k) dst[m][k] = *(const LAS bf16x8*)(lds + PG8_SA(b, h) + aoff + m * 2048 + k * 1024); } while (0)
#define PG8_LDB(dst, b, h) do { _Pragma("unroll") for (int n = 0; n < 2; ++n) _Pragma("unroll") for (int k = 0; k < 2; ++k) dst[n][k] = *(const LAS bf16x8*)(lds + PG8_SB(b, h) + boff + n * 2048 + k * 1024); } while (0)
#define PG8_MMA(ai, bj, At, Bt) do { __builtin_amdgcn_s_setprio(1); _Pragma("unroll") for (int m = 0; m < 4; ++m) _Pragma("unroll") for (int n = 0; n < 2; ++n) _Pragma("unroll") for (int k = 0; k < 2; ++k) \
        acc[ai][bj][m][n] = __builtin_amdgcn_mfma_f32_16x16x32_bf16(Bt[n][k], At[m][k], acc[ai][bj][m][n], 0, 0, 0); __builtin_amdgcn_s_setprio(0); } while (0)
#define PG8_WAIT_V(n) asm volatile("s_waitcnt vmcnt(" #n ")" ::: "memory")
#define PG8_WAIT_L(n) asm volatile("s_waitcnt lgkmcnt(" #n ")" ::: "memory")
#define PG8_BAR __builtin_amdgcn_s_barrier()
#define PG8_SCHED __builtin_amdgcn_sched_barrier(0)
#define PG8_ABASE(u) ((const char*)g.A + (size_t)(u).pm * tA + (g.adiv ? (size_t)((u).pn / g.adiv) * K * 2 : (size_t)0))
#define PG8_BBASE(u) ((const char*)g.Bt + (size_t)(u).pn * tB)
    Unit cur, nxt; int ui = 0;
    if (!S.next(0, cur)) return;
    f32x4 acc[2][2][4][2];
#pragma unroll
    for (int a = 0; a < 2; ++a)
#pragma unroll
        for (int b = 0; b < 2; ++b)
#pragma unroll
            for (int m = 0; m < 4; ++m)
#pragma unroll
                for (int n = 0; n < 2; ++n) acc[a][b][m][n] = (f32x4){0.f, 0.f, 0.f, 0.f};
    bf16x8 At[4][2], B0[2][2], B1[2][2];
    const char* cA = PG8_ABASE(cur); const char* cB = PG8_BBASE(cur);
    PG8_STAGE(PG8_SB(0, 0), cB, voffB); PG8_STAGE(PG8_SB(0, 1), cB + hB, voffB); PG8_STAGE(PG8_SA(0, 0), cA, voffA); PG8_STAGE(PG8_SA(0, 1), cA + hA, voffA);
    if (wr == 1) PG8_BAR;
    PG8_WAIT_V(2); PG8_BAR;
    PG8_STAGE(PG8_SB(1, 0), cB + kstep, voffB); PG8_STAGE(PG8_SA(1, 0), cA + kstep, voffA); PG8_STAGE(PG8_SB(1, 1), cB + hB + kstep, voffB);
    PG8_WAIT_V(6); PG8_BAR;
    for (;;) {
        const bool has_next = S.next(ui + 1, nxt);
        const char* nA = has_next ? PG8_ABASE(nxt) : cA; const char* nB = has_next ? PG8_BBASE(nxt) : cB;
#pragma unroll 1
        for (int t = 0; t < nt; t += 2) {
            const bool last = (t == nt - 2);
            const char* a1 = cA + (size_t)(t + 1) * kstep;
            const char* a2 = last ? nA : cA + (size_t)(t + 2) * kstep; const char* b2 = last ? nB : cB + (size_t)(t + 2) * kstep;
            const char* a3 = a2 + kstep; const char* b3 = b2 + kstep;
            PG8_LDB(B0, 0, 0); PG8_LDB(B1, 0, 1); PG8_SCHED; PG8_LDA(At, 0, 0); PG8_STAGE(PG8_SA(1, 1), a1 + hA, voffA);
            PG8_WAIT_V(8); PG8_WAIT_L(0); PG8_BAR; PG8_MMA(0, 0, At, B0); PG8_MMA(0, 1, At, B1); PG8_BAR; PG8_SCHED;
            PG8_LDA(At, 0, 1); PG8_STAGE(PG8_SB(0, 0), b2, voffB); PG8_STAGE(PG8_SB(0, 1), b2 + hB, voffB); PG8_STAGE(PG8_SA(0, 0), a2, voffA);
            PG8_WAIT_V(8); PG8_WAIT_L(0); PG8_BAR; PG8_MMA(1, 0, At, B0); PG8_MMA(1, 1, At, B1); PG8_BAR; PG8_SCHED;
            PG8_LDB(B0, 1, 0); PG8_LDB(B1, 1, 1); PG8_SCHED; PG8_LDA(At, 1, 0); PG8_STAGE(PG8_SA(0, 1), a2 + hA, voffA);
            PG8_WAIT_V(8); PG8_WAIT_L(0); PG8_BAR; PG8_MMA(0, 0, At, B0); PG8_MMA(0, 1, At, B1); PG8_BAR; PG8_SCHED;
            PG8_LDA(At, 1, 1); PG8_STAGE(PG8_SB(1, 0), b3, voffB); PG8_STAGE(PG8_SB(1, 1), b3 + hB, voffB); PG8_STAGE(PG8_SA(1, 0), a3, voffA);
            PG8_WAIT_V(8); PG8_WAIT_L(0); PG8_BAR; PG8_MMA(1, 0, At, B0); PG8_MMA(1, 1, At, B1); PG8_BAR; PG8_SCHED;
        }
        if constexpr (ALIGN_EPI) { if (wr == 0) PG8_BAR; }
        E(acc, cur, wr, wc, fr, fq);
        if (!has_next) break;
#pragma unroll
        for (int a = 0; a < 2; ++a)
#pragma unroll
            for (int b = 0; b < 2; ++b)
#pragma unroll
                for (int m = 0; m < 4; ++m)
#pragma unroll
                    for (int n = 0; n < 2; ++n) acc[a][b][m][n] = (f32x4){0.f, 0.f, 0.f, 0.f};
        cur = nxt; cA = nA; cB = nB; ++ui;
        if constexpr (ALIGN_EPI) { if (wr == 1) PG8_BAR; }
    }
    PG8_WAIT_V(0);
    if constexpr (!ALIGN_EPI) { if (wr == 0) PG8_BAR; }
    PG8_BAR;
#undef PG8_SA
#undef PG8_SB
#undef PG8_STAGE
#undef PG8_LDA
#undef PG8_LDB
#undef PG8_MMA
#undef PG8_WAIT_V
#undef PG8_WAIT_L
#undef PG8_BAR
#undef PG8_SCHED
#undef PG8_ABASE
#undef PG8_BBASE
}

typedef f32x4 Acc[2][2][4][2];
__device__ __forceinline__ float rstd_of(const float* ss, int row) { return 1.0f / sqrtf(ss[row] * (1.0f / D) + EPS); }

__device__ __forceinline__ void rstd8(const float* ss, int rbase, float (&rs)[2][4]) {
    float t[2][4];
#pragma unroll
    for (int ai = 0; ai < 2; ++ai)
#pragma unroll
        for (int m = 0; m < 4; ++m) t[ai][m] = ss[rbase + ai * HALF + m * 16];
#pragma unroll
    for (int ai = 0; ai < 2; ++ai)
#pragma unroll
        for (int m = 0; m < 4; ++m) rs[ai][m] = 1.0f / sqrtf(t[ai][m] * (1.0f / D) + EPS);
}
__device__ __forceinline__ void epi_swiglu(const Acc& acc, int pm, int pnf, int wr, int wc, int fr, int fq, const float* ss, bf16_t* act) {
    const int col = pnf * 128 + wc * 32 + 8 * fq;
    float rs8[2][4]; rstd8(ss, pm * BM + wr * 64 + fr, rs8);
#pragma unroll
    for (int ai = 0; ai < 2; ++ai)
#pragma unroll
        for (int m = 0; m < 4; ++m) {
            const int row = pm * BM + ai * HALF + wr * 64 + m * 16 + fr; const float rs = rs8[ai][m];
            float o[8];
#pragma unroll
            for (int n = 0; n < 2; ++n)
#pragma unroll
                for (int j = 0; j < 4; ++j) { const float gt = acc[ai][0][m][n][j] * rs, up = acc[ai][1][m][n][j] * rs; o[n * 4 + j] = gt * sigm(gt) * up; }
            u32x4 w; w.x = cvt_pk_bf16(o[0], o[1]); w.y = cvt_pk_bf16(o[2], o[3]); w.z = cvt_pk_bf16(o[4], o[5]); w.w = cvt_pk_bf16(o[6], o[7]);
            __builtin_nontemporal_store(w, (u32x4*)(act + (size_t)row * FF + col));
        }
}
struct EpiSwiglu { const float* ss; bf16_t* act;
    __device__ __forceinline__ void operator()(const Acc& acc, const Unit& u, int wr, int wc, int fr, int fq) const { epi_swiglu(acc, u.pm, u.pn, wr, wc, fr, fq, ss, act); } };

template <bool IN_F32, bool FINAL> struct EpiResid { const float* xin; float* xout; bf16_t* xb; float* ssn; float alpha;
    __device__ __forceinline__ void operator()(const Acc& acc, const Unit& u, int wr, int wc, int fr, int fq) const {
        const size_t cbase = (size_t)u.pn * BM + wc * 32 + 8 * fq;
#pragma unroll
        for (int ai = 0; ai < 2; ++ai) {
            f32x4 xr[4][2][2];
#pragma unroll
            for (int m = 0; m < 4; ++m)
#pragma unroll
                for (int bj = 0; bj < 2; ++bj) {
                    const size_t off = (size_t)(u.pm * BM + ai * HALF + wr * 64 + m * 16 + fr) * D + cbase + bj * HALF;
                    if (IN_F32) { xr[m][bj][0] = *(const f32x4*)(xin + off); xr[m][bj][1] = *(const f32x4*)(xin + off + 4); }
                    else { const u32x4 xw = *(const u32x4*)(xb + off); xr[m][bj][0] = __builtin_bit_cast(f32x4, xw); }
                }
#pragma unroll
            for (int m = 0; m < 4; ++m) {
                const int row = u.pm * BM + ai * HALF + wr * 64 + m * 16 + fr; float sq = 0.f;
#pragma unroll
                for (int bj = 0; bj < 2; ++bj) {
                    const size_t off = (size_t)row * D + cbase + bj * HALF;
                    f32x4 x0, x1;
                    if (IN_F32) { x0 = xr[m][bj][0]; x1 = xr[m][bj][1]; }
                    else { const u32x4 xw = __builtin_bit_cast(u32x4, xr[m][bj][0]); x0 = (f32x4){bf_lo(xw.x), bf_hi(xw.x), bf_lo(xw.y), bf_hi(xw.y)}; x1 = (f32x4){bf_lo(xw.z), bf_hi(xw.z), bf_lo(xw.w), bf_hi(xw.w)}; }
                    const f32x4 y0 = x0 + acc[ai][bj][m][0] * alpha, y1 = x1 + acc[ai][bj][m][1] * alpha;
                    if (FINAL) { *(f32x4*)(xout + off) = y0; *(f32x4*)(xout + off + 4) = y1; }
                    else {
                        sq += (y0[0] * y0[0] + y0[1] * y0[1]) + (y0[2] * y0[2] + y0[3] * y0[3]) + (y1[0] * y1[0] + y1[1] * y1[1]) + (y1[2] * y1[2] + y1[3] * y1[3]);
                        u32x4 w; w.x = cvt_pk_bf16(y0[0], y0[1]); w.y = cvt_pk_bf16(y0[2], y0[3]); w.z = cvt_pk_bf16(y1[0], y1[1]); w.w = cvt_pk_bf16(y1[2], y1[3]);
                        *(u32x4*)(xb + off) = w;
                    }
                }
                if (!FINAL) { sq += __shfl_xor(sq, 16); sq += __shfl_xor(sq, 32); if (fq == 0) atomicAdd(ssn + row, sq); }
            }
        }
    } };
typedef EpiResid<true, false> EpiResidIn; typedef EpiResid<false, false> EpiResidMid; typedef EpiResid<false, true> EpiResidOut;

struct EpiWin { const float* ss; bf16_t* gb; bf16_t* rec;
    __device__ __forceinline__ void operator()(const Acc& acc, const Unit& u, int wr, int wc, int fr, int fq) const {
        const bool isg = u.pn < 4; const int ct = (u.pn & 3) * BM;
        float rs8[2][4]; rstd8(ss, u.pm * BM + wr * 64 + fr, rs8);
#pragma unroll
        for (int ai = 0; ai < 2; ++ai)
#pragma unroll
            for (int m = 0; m < 4; ++m) {
                const int row = u.pm * BM + ai * HALF + wr * 64 + m * 16 + fr; const float rs = rs8[ai][m];
#pragma unroll
                for (int bj = 0; bj < 2; ++bj) {
                    const size_t off = (size_t)row * D + ct + bj * HALF + wc * 32 + 8 * fq;
                    const f32x4 v0 = acc[ai][bj][m][0] * rs, v1 = acc[ai][bj][m][1] * rs;
                    if (isg) { u32x4 w; w.x = cvt_pk_bf16(gelu_tanh(v0[0]), gelu_tanh(v0[1])); w.y = cvt_pk_bf16(gelu_tanh(v0[2]), gelu_tanh(v0[3]));
                        w.z = cvt_pk_bf16(gelu_tanh(v1[0]), gelu_tanh(v1[1])); w.w = cvt_pk_bf16(gelu_tanh(v1[2]), gelu_tanh(v1[3])); *(u32x4*)(gb + off) = w; }
                    else { u32x4 w; w.x = cvt_pk_bf16(v0[0], v0[1]); w.y = cvt_pk_bf16(v0[2], v0[3]); w.z = cvt_pk_bf16(v1[0], v1[1]); w.w = cvt_pk_bf16(v1[2], v1[3]); *(u32x4*)(rec + off) = w; }
                }
            }
    } };

struct EpiGate { const bf16_t* xc; const float* b_r; const float* b_i; const float* sp8; bf16_t* aout; bf16_t* uout;
    __device__ __forceinline__ void operator()(const Acc& acc, const Unit& u, int wr, int wc, int fr, int fq) const {
        const int ch = u.pn * 128 + wc * 32 + 8 * fq;
        float br[8], bi[8], sp[8];
#pragma unroll
        for (int n = 0; n < 2; ++n) { const f32x4 a_ = *(const f32x4*)(b_r + ch + 4 * n), b_ = *(const f32x4*)(b_i + ch + 4 * n), c_ = *(const f32x4*)(sp8 + ch + 4 * n);
#pragma unroll
            for (int j = 0; j < 4; ++j) { br[4 * n + j] = a_[j]; bi[4 * n + j] = b_[j]; sp[4 * n + j] = c_[j]; } }
        u32x4 xcw[2][4];
#pragma unroll
        for (int ai = 0; ai < 2; ++ai)
#pragma unroll
            for (int m = 0; m < 4; ++m) xcw[ai][m] = *(const u32x4*)(xc + (size_t)(u.pm * BM + ai * HALF + wr * 64 + m * 16 + fr) * D + ch);
#pragma unroll
        for (int ai = 0; ai < 2; ++ai)
#pragma unroll
            for (int m = 0; m < 4; ++m) {
                const int row = u.pm * BM + ai * HALF + wr * 64 + m * 16 + fr; const size_t off = (size_t)row * D + ch;
                const u32x4 xw = xcw[ai][m];
                const float xv[8] = {bf_lo(xw.x), bf_hi(xw.x), bf_lo(xw.y), bf_hi(xw.y), bf_lo(xw.z), bf_hi(xw.z), bf_lo(xw.w), bf_hi(xw.w)};
                float av[8], uv[8];
#pragma unroll
                for (int j = 0; j < 8; ++j) {
                    const float r = sigm(acc[ai][0][m][j >> 2][j & 3] + br[j]), ig = sigm(acc[ai][1][m][j >> 2][j & 3] + bi[j]);
                    const float la2 = r * sp[j];
                    const float a = __builtin_amdgcn_exp2f(la2);
                    av[j] = la2; uv[j] = __builtin_amdgcn_sqrtf(fmaxf(1.0f - a * a, 0.f)) * ig * xv[j];
                }
                u32x4 wa; wa.x = cvt_pk_bf16(av[0], av[1]); wa.y = cvt_pk_bf16(av[2], av[3]); wa.z = cvt_pk_bf16(av[4], av[5]); wa.w = cvt_pk_bf16(av[6], av[7]);
                *(u32x4*)(aout + off) = wa;
                u32x4 w; w.x = cvt_pk_bf16(uv[0], uv[1]); w.y = cvt_pk_bf16(uv[2], uv[3]); w.z = cvt_pk_bf16(uv[4], uv[5]); w.w = cvt_pk_bf16(uv[6], uv[7]);
                *(u32x4*)(uout + off) = w;
            }
    } };

__device__ __forceinline__ void epi_headnorm(const Acc& acc, int pm, int pnh, int wr, int wc, int fr, int fq, const float* ss, const float* gain, float oscale, bf16_t* out) {
    const int head = 4 * pnh + wc;
    float sc[2][4]; rstd8(ss, pm * BM + wr * 64 + fr, sc);
#pragma unroll
    for (int ai = 0; ai < 2; ++ai)
#pragma unroll
        for (int m = 0; m < 4; ++m) {
            const float rs = sc[ai][m];
            float sq = 0.f;
#pragma unroll
            for (int bj = 0; bj < 2; ++bj)
#pragma unroll
                for (int n = 0; n < 2; ++n) { const f32x4 v = acc[ai][bj][m][n]; sq += (v[0] * v[0] + v[1] * v[1]) + (v[2] * v[2] + v[3] * v[3]); }
            sq += __shfl_xor(sq, 16); sq += __shfl_xor(sq, 32);
            sc[ai][m] = rs * oscale / sqrtf(sq * rs * rs * (1.0f / HD) + EPS);
        }
#pragma unroll
    for (int bj = 0; bj < 2; ++bj) {
        const f32x4 g0 = *(const f32x4*)(gain + 32 * bj + 8 * fq), g1 = *(const f32x4*)(gain + 32 * bj + 8 * fq + 4);
#pragma unroll
        for (int ai = 0; ai < 2; ++ai)
#pragma unroll
            for (int m = 0; m < 4; ++m) {
                const int row = pm * BM + ai * HALF + wr * 64 + m * 16 + fr;
                const f32x4 v0 = acc[ai][bj][m][0] * g0 * sc[ai][m], v1 = acc[ai][bj][m][1] * g1 * sc[ai][m];
                u32x4 w; w.x = cvt_pk_bf16(v0[0], v0[1]); w.y = cvt_pk_bf16(v0[2], v0[3]); w.z = cvt_pk_bf16(v1[0], v1[1]); w.w = cvt_pk_bf16(v1[2], v1[3]);
                *(u32x4*)(out + (size_t)row * D + head * HD + 32 * bj + 8 * fq) = w;
                asm volatile("" ::: "memory");
            }
    }
}
struct EpiQ { const float* ss; const float* gain; bf16_t* q;
    __device__ __forceinline__ void operator()(const Acc& acc, const Unit& u, int wr, int wc, int fr, int fq) const { epi_headnorm(acc, u.pm, u.pn, wr, wc, fr, fq, ss, gain, 0.125f * LOG2E, q); } };
struct EpiKvSwiglu { const float* ss; const float* kgain; bf16_t* kout; bf16_t* vt; bf16_t* act;
    __device__ __forceinline__ void operator()(const Acc& acc, const Unit& u, int wr, int wc, int fr, int fq) const {
        if (u.pn >= 8) { epi_swiglu(acc, u.pm, u.pn - 8, wr, wc, fr, fq, ss, act); return; }
        if (u.pn < 4) { epi_headnorm(acc, u.pm, u.pn, wr, wc, fr, fq, ss, kgain, 1.0f, kout); return; }
        const int head = 4 * (u.pn - 4) + wc;
        float rs8[2][4]; rstd8(ss, u.pm * BM + wr * 64 + fr, rs8);
        const int row0 = u.pm * BM + wr * 64 + fr, b = row0 / SEQ, s0 = row0 % SEQ;
        bf16_t* base = vt + ((size_t)(b * NH + head) * HD + 8 * fq) * SEQ + s0;
#pragma unroll
        for (int bj = 0; bj < 2; ++bj)
#pragma unroll
            for (int j = 0; j < 8; ++j) {
                bf16_t* p = base + (size_t)(32 * bj + j) * SEQ;
#pragma unroll
                for (int ai = 0; ai < 2; ++ai)
#pragma unroll
                    for (int m = 0; m < 4; ++m) p[ai * HALF + m * 16] = (bf16_t)(cvt_pk_bf16(acc[ai][bj][m][j >> 2][j & 3] * rs8[ai][m], 0.f) & 0xffffu);
                asm volatile("" ::: "memory");
            }
    } };
}


#define XB_TMO      128
#define XB_XCNT(j)  (256  + 64 * (j))
#define XB_XSUB(j)  (1280 + 64 * (j))
#define XB_XGEN(j)  (2304 + 64 * (j))
#define XB_TOP      3328
#define XB_TOPGEN   3392
#define XCD_BAR_WORDS 3456
#define XB_SPIN_CAP (1u << 18)
__device__ __forceinline__ unsigned xb_ld(unsigned* p)              { return __hip_atomic_load(p, __ATOMIC_RELAXED, __HIP_MEMORY_SCOPE_AGENT); }
__device__ __forceinline__ unsigned xb_add(unsigned* p, unsigned v) { return __hip_atomic_fetch_add(p, v, __ATOMIC_RELAXED, __HIP_MEMORY_SCOPE_AGENT); }
__device__ __forceinline__ unsigned xb_xcc_id() { return (unsigned)__builtin_amdgcn_s_getreg((3 << 11) | 20) & 0xFu; }
#define XB_SPIN(cond, bar) do { unsigned _sp = 0; while (cond) { __builtin_amdgcn_s_sleep(1); \
    if ((++_sp & 255u) == 0u) { if (xb_ld(&(bar)[XB_TMO])) break; if (_sp > XB_SPIN_CAP) { atomicAdd(&(bar)[XB_TMO], 1u); break; } } } } while (0)
struct XcdBarrier { unsigned* bar; unsigned x; volatile LAS unsigned* st; };
__device__ __forceinline__ XcdBarrier xcd_barrier_post(unsigned* bar, volatile LAS unsigned* st) {
    XcdBarrier b; b.bar = bar; b.x = xb_xcc_id(); b.st = st;
    if (threadIdx.x == 0) (void)xb_add(&bar[XB_XCNT(b.x)], 1u);
    return b;
}
__device__ __forceinline__ void xcd_barrier_complete(unsigned* bar, unsigned x, unsigned& nloc, unsigned& nx) {
    const unsigned G = gridDim.x * gridDim.y * gridDim.z;
    unsigned sum, cnt, mine, sp = 0u;
    for (;;) {
        sum = 0u; cnt = 0u; mine = 0u;
#pragma unroll
        for (unsigned j = 0; j < 16; ++j) { const unsigned c = xb_ld(&bar[XB_XCNT(j)]); sum += c; cnt += (c > 0u) ? 1u : 0u; mine = (j == x) ? c : mine; }
        if (sum == G) break;
        __builtin_amdgcn_s_sleep(1);
        if ((++sp & 255u) == 0u) { if (xb_ld(&bar[XB_TMO])) break; if (sp > XB_SPIN_CAP) { atomicAdd(&bar[XB_TMO], 1u); break; } }
    }
    nloc = mine > 0u ? mine : 1u; nx = cnt > 0u ? cnt : 1u;
}
__device__ __forceinline__ void xcd_barrier(const XcdBarrier& b) {
    asm volatile("s_waitcnt vmcnt(0)" ::: "memory");
    __syncthreads();
    if (threadIdx.x == 0) {
        unsigned* bar = b.bar;
        __builtin_amdgcn_s_waitcnt(0);
        unsigned nloc = b.st[0], nx = b.st[1];
        if (nloc == 0u) { xcd_barrier_complete(bar, b.x, nloc, nx); b.st[0] = nloc; b.st[1] = nx; }
        const unsigned old = xb_add(&bar[XB_XSUB(b.x)], 1u);
        const unsigned gen = old / nloc;
        if (old + 1u == (gen + 1u) * nloc) {
            __builtin_amdgcn_fence(__ATOMIC_RELEASE, "agent");
            asm volatile("s_waitcnt vmcnt(0)" ::: "memory");
            const unsigned og = xb_add(&bar[XB_TOP], 1u);
            const unsigned tg = og / nx;
            if (og + 1u == (tg + 1u) * nx) xb_add(&bar[XB_TOPGEN], 1u);
            else XB_SPIN(xb_ld(&bar[XB_TOPGEN]) == tg, bar);
            __builtin_amdgcn_fence(__ATOMIC_ACQUIRE, "agent");
            xb_add(&bar[XB_XGEN(b.x)], 1u);
            asm volatile("s_waitcnt vmcnt(0)" ::: "memory");
        } else {
            XB_SPIN(xb_ld(&bar[XB_XGEN(b.x)]) == gen, bar);
            __builtin_amdgcn_fence(__ATOMIC_ACQUIRE, "agent");
            asm volatile("s_waitcnt vmcnt(0)" ::: "memory");
        }
    }
    __syncthreads();
}

constexpr int N_PHASES = 18;
constexpr int NWAVES = 8, NTHR = NWAVES * 64;
constexpr int MISC_OFF = 8 * 16896, LDS_BYTES = MISC_OFF + 256;

struct Args { const float* in[23]; float* out; unsigned char* ws; int ph_lo, ph_hi; };

struct Frame { LAS unsigned char* lds; int tid, lane, wave, G, gw, NGW; };

struct CvtDesc { const float* W; const float* W2; bf16_t* dst; const float* gain; int ldw, K, nb, mode; };
constexpr int SCR_STRIDE = 64 * 65 * 4;
__device__ __forceinline__ void cvt_item(const CvtDesc& d, int local, LAS float* scr, int lane) {
    const int kb = local / d.nb, gI = local % d.nb, k0 = 64 * kb, n0 = 64 * gI;
    const int l16 = lane & 15, l4 = lane >> 4, n = n0 + 4 * l16;
    const float* W = d.W; int c0;
    if (d.mode == 0) c0 = n;
    else if (d.mode == 1) { const int tile = n >> 8, bj = (n >> 7) & 1, j0 = n & 127; c0 = bj * FF + tile * 128 + j0; }
    else if (d.mode == 2) { const int pn = n >> 8, bj = (n >> 7) & 1, wc = (n >> 5) & 3, j0 = n & 31; c0 = 256 * pn + 64 * wc + 32 * bj + j0; }
    else { const int t = n >> 8, blk = t >> 1, half = t & 1, which = (n >> 7) & 1, j0 = n & 127; W = (which ? d.W2 : d.W) + (size_t)blk * 65536; c0 = half * 128 + j0; }
    const float* wp = W + (size_t)(k0 + l4) * d.ldw + c0;
    f32x4 v[16];
#pragma unroll
    for (int i = 0; i < 16; ++i) v[i] = *(const f32x4*)(wp + (size_t)(4 * i) * d.ldw);
    if (d.gain) {
#pragma unroll
        for (int i = 0; i < 16; ++i) v[i] *= d.gain[k0 + 4 * i + l4];
    }
#pragma unroll
    for (int i = 0; i < 16; ++i) { LAS float* s = scr + (4 * i + l4) * 65 + 4 * l16; s[0] = v[i][0]; s[1] = v[i][1]; s[2] = v[i][2]; s[3] = v[i][3]; }
    LDS_WAIT(); asm volatile("" ::: "memory");
    const int c = lane & 7;
#pragma unroll
    for (int j = 0; j < 8; ++j) { const int nn = (lane >> 3) + 8 * j; const LAS float* s = scr + (8 * c) * 65 + nn;
        u32x4 o; o.x = cvt_pk_bf16(s[0 * 65], s[1 * 65]); o.y = cvt_pk_bf16(s[2 * 65], s[3 * 65]); o.z = cvt_pk_bf16(s[4 * 65], s[5 * 65]); o.w = cvt_pk_bf16(s[6 * 65], s[7 * 65]);
        *(u32x4*)(d.dst + (size_t)(n0 + nn) * d.K + k0 + 8 * c) = o; }
    LDS_WAIT(); asm volatile("" ::: "memory");
}
enum { I_X = 0, I_F1N, I_F1W13, I_F1W2, I_MIXN, I_AWIN, I_ACW, I_ACB, I_AWR, I_ABR, I_AWI, I_ABI, I_ALAM, I_AWOUT, I_KVN, I_WKV, I_KN, I_BWQ, I_QN, I_BWO, I_F2N, I_F2W13, I_F2W2 };
constexpr int IT_W13 = (D / 64) * (2 * FF / 64), IT_W2 = (FF / 64) * (D / 64), IT_2048 = (D / 64) * (2048 / 64), IT_1024 = (D / 64) * (D / 64), IT_RI = (256 / 64) * (2048 / 64);
__device__ __forceinline__ CvtDesc cvt_desc(const Args& a, int id) {
    unsigned char* ws = a.ws; CvtDesc d; d.W2 = nullptr; d.gain = nullptr;
    switch (id) {
    case 0: d = {a.in[I_F1W13], nullptr, (bf16_t*)(ws + WS_WA13), a.in[I_F1N], 2 * FF, D, 2 * FF / 64, 1}; break;
    case 1: d = {a.in[I_F1W2], nullptr, (bf16_t*)(ws + WS_WA2), nullptr, D, FF, D / 64, 0}; break;
    case 2: d = {a.in[I_F2W13], nullptr, (bf16_t*)(ws + WS_WB13), a.in[I_F2N], 2 * FF, D, 2 * FF / 64, 1}; break;
    case 3: d = {a.in[I_F2W2], nullptr, (bf16_t*)(ws + WS_WB2), nullptr, D, FF, D / 64, 0}; break;
    case 4: d = {a.in[I_WKV], nullptr, (bf16_t*)(ws + WS_WKV), a.in[I_KVN], 2048, D, 2048 / 64, 2}; break;
    case 5: d = {a.in[I_F1W13] + (size_t)D * 2 * FF, nullptr, (bf16_t*)(ws + WS_WC13), a.in[I_F1N] + D, 2 * FF, D, 2 * FF / 64, 1}; break;
    case 6: d = {a.in[I_F1W2] + (size_t)FF * D, nullptr, (bf16_t*)(ws + WS_WC2), nullptr, D, FF, D / 64, 0}; break;
    case 7: d = {a.in[I_AWIN], nullptr, (bf16_t*)(ws + WS_WIN), a.in[I_MIXN], 2048, D, 2048 / 64, 0}; break;
    case 8: d = {a.in[I_AWR], a.in[I_AWI], (bf16_t*)(ws + WS_WRI), nullptr, 256, 256, 2048 / 64, 3}; break;
    case 9: d = {a.in[I_AWOUT], nullptr, (bf16_t*)(ws + WS_WOUT), nullptr, D, D, D / 64, 0}; break;
    case 10: d = {a.in[I_BWQ], nullptr, (bf16_t*)(ws + WS_WQ), a.in[I_MIXN] + D, D, D, D / 64, 2}; break;
    case 11: d = {a.in[I_BWO], nullptr, (bf16_t*)(ws + WS_WO), nullptr, D, D, D / 64, 0}; break;
    case 12: d = {a.in[I_F2W13] + (size_t)D * 2 * FF, nullptr, (bf16_t*)(ws + WS_WA13), a.in[I_F2N] + D, 2 * FF, D, 2 * FF / 64, 1}; break;
    default: d = {a.in[I_F2W2] + (size_t)FF * D, nullptr, (bf16_t*)(ws + WS_WA2), nullptr, D, FF, D / 64, 0}; break;
    }
    return d;
}
__device__ __forceinline__ int cvt_items(int id) {
    switch (id) { case 0: case 2: case 5: case 12: return IT_W13; case 1: case 3: case 6: case 13: return IT_W2; case 4: case 7: return IT_2048; case 8: return IT_RI; default: return IT_1024; }
}
__device__ __forceinline__ void cvt_range(const Args& a, const Frame& F, int id_lo, int id_hi, int wg_lo, int wg_n) {
    LAS float* scr = (LAS float*)(F.lds + F.wave * 16896);
    int total = 0; for (int id = id_lo; id < id_hi; ++id) total += cvt_items(id);
    const int rank = (int)blockIdx.x - wg_lo; if (rank < 0 || rank >= wg_n) return;
    for (int it = rank * NWAVES + F.wave; it < total; it += wg_n * NWAVES) {
        int r = it, id = id_lo; while (r >= cvt_items(id)) { r -= cvt_items(id); ++id; }
        const CvtDesc d = cvt_desc(a, id); cvt_item(d, r, scr, F.lane);
    }
}

__device__ __forceinline__ void p0_rows(const Args& a, const Frame& F) {
    const float* x = a.in[I_X]; bf16_t* xb = (bf16_t*)(a.ws + WS_XB); float* ss = (float*)(a.ws + WS_SS);
    for (int m = F.gw; m < M; m += 2 * F.NGW) {
        const int m2 = m + F.NGW;
        const bool has2 = m2 < M;
        const f32x4* xr = (const f32x4*)(x + (size_t)m * D) + F.lane; const f32x4* xr2 = (const f32x4*)(x + (size_t)(has2 ? m2 : m) * D) + F.lane;
        f32x4 v[4], v2[4]; float s = 0.f, s2 = 0.f;
#pragma unroll
        for (int j = 0; j < 4; ++j) { v[j] = xr[64 * j]; v2[j] = xr2[64 * j]; }
#pragma unroll
        for (int j = 0; j < 4; ++j) { s += (v[j][0] * v[j][0] + v[j][1] * v[j][1]) + (v[j][2] * v[j][2] + v[j][3] * v[j][3]); s2 += (v2[j][0] * v2[j][0] + v2[j][1] * v2[j][1]) + (v2[j][2] * v2[j][2] + v2[j][3] * v2[j][3]); }
        s = wave_sum(s); s2 = wave_sum(s2);
        u32x2* o = (u32x2*)(xb + (size_t)m * D) + F.lane; u32x2* o2 = (u32x2*)(xb + (size_t)m2 * D) + F.lane;
#pragma unroll
        for (int j = 0; j < 4; ++j) { u32x2 w; w.x = cvt_pk_bf16(v[j][0], v[j][1]); w.y = cvt_pk_bf16(v[j][2], v[j][3]); o[64 * j] = w;
            if (has2) { u32x2 w2; w2.x = cvt_pk_bf16(v2[j][0], v2[j][1]); w2.y = cvt_pk_bf16(v2[j][2], v2[j][3]); o2[64 * j] = w2; } }
        if (F.lane == 0) { ss[m] = s; if (has2) ss[m2] = s2; }
    }
    for (int i = blockIdx.x * NTHR + F.tid; i < 5 * M; i += F.G * NTHR) ss[M + i] = 0.f;
    if (blockIdx.x == 0) for (int c = F.tid; c < D; c += NTHR) { const float l = a.in[I_ALAM][c]; ((float*)(a.ws + WS_SP8))[c] = -8.0f * LOG2E * (fmaxf(-l, 0.f) + log1pf(expf(-fabsf(l)))); }
}

__device__ __forceinline__ void conv_phase(const Args& a, const Frame& F) {
    const bf16_t* rec = (const bf16_t*)(a.ws + WS_REC); bf16_t* xc = (bf16_t*)(a.ws + WS_Y);
    constexpr int CR = 16, NITEM = (M / CR) * 4;
    for (int it = F.gw; it < NITEM; it += F.NGW) {
        const int cq = it & 3, m0 = (it >> 2) * CR, t0 = m0 & (SEQ - 1), ch = cq * 256 + 4 * F.lane;
        f32x4 w[4];
#pragma unroll
        for (int k = 0; k < 4; ++k) w[k] = *(const f32x4*)(a.in[I_ACW] + k * D + ch);
        const f32x4 bv = *(const f32x4*)(a.in[I_ACB] + ch);
        u32x2 rw[CR + 3];
#pragma unroll
        for (int i = 0; i < CR + 3; ++i) { const int r = m0 - 3 + i; rw[i] = (i >= 3 || t0 > 0) ? *(const u32x2*)(rec + (size_t)r * D + ch) : (u32x2){0u, 0u}; }
#pragma unroll
        for (int i = 0; i < CR; ++i) {
            f32x4 y = bv;
#pragma unroll
            for (int k = 0; k < 4; ++k) { const u32x2 q = rw[i + k]; y += w[k] * (f32x4){bf_lo(q.x), bf_hi(q.x), bf_lo(q.y), bf_hi(q.y)}; }
            u32x2 o; o.x = cvt_pk_bf16(y[0], y[1]); o.y = cvt_pk_bf16(y[2], y[3]); *(u32x2*)(xc + (size_t)(m0 + i) * D + ch) = o;
        }
    }
}

constexpr int SC_L = 64, SC_C = SEQ / SC_L;
__device__ __forceinline__ void scan_a(const Args& a, const Frame& F) {
    const bf16_t* av = (const bf16_t*)(a.ws + WS_REC); const bf16_t* uv = (const bf16_t*)(a.ws + WS_U);
    f32x4* hl = (f32x4*)(a.ws + WS_HL); f32x4* pc = (f32x4*)(a.ws + WS_PC);
    if (F.tid >= 256) return;
    for (int item = blockIdx.x * 256 + F.tid; item < BATCH * SC_C * 256; item += F.G * 256) {
        const int cgp = item & 255, bc = item >> 8; const size_t row0 = (size_t)bc * SC_L;
        f32x4 h = {0.f, 0.f, 0.f, 0.f}, p = {1.f, 1.f, 1.f, 1.f};
#pragma unroll 8
        for (int t = 0; t < SC_L; ++t) { const u32x2 aw = *(const u32x2*)(av + (row0 + t) * D + 4 * cgp); const f32x4 aa = {__builtin_amdgcn_exp2f(bf_lo(aw.x)), __builtin_amdgcn_exp2f(bf_hi(aw.x)), __builtin_amdgcn_exp2f(bf_lo(aw.y)), __builtin_amdgcn_exp2f(bf_hi(aw.y))}; const u32x2 uw = *(const u32x2*)(uv + (row0 + t) * D + 4 * cgp);
            const f32x4 uu = {bf_lo(uw.x), bf_hi(uw.x), bf_lo(uw.y), bf_hi(uw.y)}; h = aa * h + uu; p = p * aa; }
        hl[item] = h; pc[item] = p;
    }
}
__device__ __forceinline__ void scan_b(const Args& a, const Frame& F) {
    const bf16_t* av = (const bf16_t*)(a.ws + WS_REC); const bf16_t* uv = (const bf16_t*)(a.ws + WS_U); const bf16_t* gb = (const bf16_t*)(a.ws + WS_GB); bf16_t* yb = (bf16_t*)(a.ws + WS_Y);
    const f32x4* hl = (const f32x4*)(a.ws + WS_HL); const f32x4* pc = (const f32x4*)(a.ws + WS_PC);
    if (F.tid >= 256) return;
    for (int item = blockIdx.x * 256 + F.tid; item < BATCH * SC_C * 256; item += F.G * 256) {
        const int cgp = item & 255, bc = item >> 8, ck = bc & (SC_C - 1), b0 = bc - ck; const size_t row0 = (size_t)bc * SC_L;
        f32x4 h = {0.f, 0.f, 0.f, 0.f};
        int j = 0;
        for (; j + 8 <= ck; j += 8) {
            f32x4 pp[8], hh[8];
#pragma unroll
            for (int e = 0; e < 8; ++e) { pp[e] = pc[(b0 + j + e) * 256 + cgp]; hh[e] = hl[(b0 + j + e) * 256 + cgp]; }
#pragma unroll
            for (int e = 0; e < 8; ++e) h = pp[e] * h + hh[e];
        }
        for (; j < ck; ++j) h = pc[(b0 + j) * 256 + cgp] * h + hl[(b0 + j) * 256 + cgp];
#pragma unroll 8
        for (int t = 0; t < SC_L; ++t) { const size_t off = (row0 + t) * D + 4 * cgp; const u32x2 aw = *(const u32x2*)(av + off); const f32x4 aa = {__builtin_amdgcn_exp2f(bf_lo(aw.x)), __builtin_amdgcn_exp2f(bf_hi(aw.x)), __builtin_amdgcn_exp2f(bf_lo(aw.y)), __builtin_amdgcn_exp2f(bf_hi(aw.y))}; const u32x2 uw = *(const u32x2*)(uv + off);
            const f32x4 uu = {bf_lo(uw.x), bf_hi(uw.x), bf_lo(uw.y), bf_hi(uw.y)}; h = aa * h + uu;
            const u32x2 gw = *(const u32x2*)(gb + off); u32x2 o; o.x = cvt_pk_bf16(h[0] * bf_lo(gw.x), h[1] * bf_hi(gw.x)); o.y = cvt_pk_bf16(h[2] * bf_lo(gw.y), h[3] * bf_hi(gw.y));
            *(u32x2*)(yb + off) = o; }
    }
}

constexpr float SB_TINY = 5.42e-20f;
struct SbFrag { bf16x8 kf[4]; bf16x8 vf[2][2]; };
constexpr int ATT_KSTR = 1088, ATT_VOFF = 4 * ATT_KSTR, ATT_SLOT = ATT_VOFF + 4096, WAVE_LDS = 2 * ATT_SLOT;
__device__ __forceinline__ void sb_dma(LAS unsigned char* slot, const bf16_t* kg, const bf16_t* vg, int k0) {
    const bf16_t* k = kg + (size_t)k0 * D; const bf16_t* v = vg + k0;
#define SB_GLDS(g, o) __builtin_amdgcn_global_load_lds((const unsigned*)(g), (LAS unsigned*)(slot + (o)), 16, 0, 0)
    SB_GLDS(k, 0); SB_GLDS(k + 8 * D, ATT_KSTR); SB_GLDS(k + 16 * D, 2 * ATT_KSTR); SB_GLDS(k + 24 * D, 3 * ATT_KSTR);
    SB_GLDS(v, ATT_VOFF); SB_GLDS(v + (size_t)16 * SEQ, ATT_VOFF + 1024); SB_GLDS(v + (size_t)32 * SEQ, ATT_VOFF + 2048); SB_GLDS(v + (size_t)48 * SEQ, ATT_VOFF + 3072);
#undef SB_GLDS
}
template <int N> __device__ __forceinline__ void sb_wait() { asm volatile("s_waitcnt vmcnt(%0)" :: "n"(N) : "memory"); }
struct SbAddr { int k[4]; int v[4]; };
__device__ __forceinline__ void sb_read(SbFrag& f, const LAS unsigned char* slot, const SbAddr& ad) {
#pragma unroll
    for (int d0 = 0; d0 < 4; ++d0) f.kf[d0] = *(const LAS bf16x8*)(slot + ad.k[d0]);
#pragma unroll
    for (int dh = 0; dh < 2; ++dh)
#pragma unroll
        for (int mm = 0; mm < 2; ++mm) f.vf[dh][mm] = *(const LAS bf16x8*)(slot + ad.v[dh * 2 + mm]);
}
template <bool DIAG> __device__ __forceinline__ void sb_tile(const SbFrag& f, const bf16x8 (&qf)[4], f32x16& o0, f32x16& o1, float& carry, int lim, int hi) {
    f32x16 s;
#pragma unroll
    for (int r = 0; r < 16; ++r) s[r] = 0.f;
    __builtin_amdgcn_s_setprio(1);
#pragma unroll
    for (int d0 = 0; d0 < 4; ++d0) s = __builtin_amdgcn_mfma_f32_32x32x16_bf16(f.kf[d0], qf[d0], s, 0, 0, 0);
    __builtin_amdgcn_s_setprio(0);
    float wv[16]; float run = 1.f;
#pragma unroll
    for (int r = 15; r >= 0; --r) {
        float stay = __builtin_amdgcn_rcpf(1.0f + __builtin_amdgcn_exp2f(s[r]));
        float beta = 1.0f - stay;
        if (DIAG) { const bool ok = r < lim; stay = ok ? stay : 1.0f; beta = ok ? beta : 0.f; }
        wv[r] = beta * run; run *= stay;
    }
    const float other = __shfl_xor(run, 32);
    const float base = carry * (hi == 0 ? other : 1.0f);
    carry *= run * other;
    u32x4 p0, p1;
    p0.x = cvt_pk_bf16(wv[0] * base, wv[1] * base); p0.y = cvt_pk_bf16(wv[2] * base, wv[3] * base); p0.z = cvt_pk_bf16(wv[4] * base, wv[5] * base); p0.w = cvt_pk_bf16(wv[6] * base, wv[7] * base);
    p1.x = cvt_pk_bf16(wv[8] * base, wv[9] * base); p1.y = cvt_pk_bf16(wv[10] * base, wv[11] * base); p1.z = cvt_pk_bf16(wv[12] * base, wv[13] * base); p1.w = cvt_pk_bf16(wv[14] * base, wv[15] * base);
    const bf16x8 pa0 = __builtin_bit_cast(bf16x8, p0), pa1 = __builtin_bit_cast(bf16x8, p1);
    __builtin_amdgcn_s_setprio(1);
    o0 = __builtin_amdgcn_mfma_f32_32x32x16_bf16(pa0, f.vf[0][0], o0, 0, 0, 0); o0 = __builtin_amdgcn_mfma_f32_32x32x16_bf16(pa1, f.vf[0][1], o0, 0, 0, 0);
    o1 = __builtin_amdgcn_mfma_f32_32x32x16_bf16(pa0, f.vf[1][0], o1, 0, 0, 0); o1 = __builtin_amdgcn_mfma_f32_32x32x16_bf16(pa1, f.vf[1][1], o1, 0, 0, 0);
    __builtin_amdgcn_s_setprio(0);
}
__device__ __forceinline__ void sb_unit(const bf16_t* Q, const bf16_t* K, const bf16_t* VT, bf16_t* O, int b, int h, int qb, int lane, LAS unsigned char* slotA, LAS unsigned char* slotB, const SbAddr& ad) {
    const int j = lane & 31, hi = lane >> 5, q0 = qb * 32; const size_t rowbase = (size_t)b * SEQ;
    const bf16_t* qp = Q + (rowbase + q0 + j) * D + h * HD + 8 * hi;
    bf16x8 qf[4];
#pragma unroll
    for (int d0 = 0; d0 < 4; ++d0) qf[d0] = *(const bf16x8*)(qp + 16 * d0);
    const int k8w = lane >> 3, cw = (lane & 7) ^ k8w, aw = lane >> 4, d16w = 4 * ((lane >> 2) & 3) + aw, pw = (lane & 3) ^ aw;
    const bf16_t* kg = K + (rowbase + k8w) * D + h * HD + 8 * cw;
    const bf16_t* vg = VT + ((size_t)(b * NH + h) * HD + d16w) * SEQ + 8 * pw;
    f32x16 o0, o1;
#pragma unroll
    for (int r = 0; r < 16; ++r) { o0[r] = 0.f; o1[r] = 0.f; }
    float carry = 1.f;
    SbFrag f;
    sb_dma(slotA, kg, vg, q0);
    sb_dma(slotB, kg, vg, qb > 0 ? q0 - 32 : 0);
    sb_wait<8>(); sb_read(f, slotA, ad);
    sb_tile<true>(f, qf, o0, o1, carry, j - 16 * hi, hi);
    for (int kt = qb - 1; kt >= 0; kt -= 2) {
        sb_dma(slotA, kg, vg, (kt > 0 ? kt - 1 : 0) * 32);
        sb_wait<8>(); sb_read(f, slotB, ad);
        sb_tile<false>(f, qf, o0, o1, carry, 64, hi);
        if (kt == 0 || __all(carry < SB_TINY)) break;
        sb_dma(slotB, kg, vg, (kt > 1 ? kt - 2 : 0) * 32);
        sb_wait<8>(); sb_read(f, slotA, ad);
        sb_tile<false>(f, qf, o0, o1, carry, 64, hi);
        if (__all(carry < SB_TINY)) break;
    }
    sb_wait<0>();
    bf16_t* op = O + (rowbase + q0) * D + h * HD + j;
#pragma unroll
    for (int r = 0; r < 16; ++r) { const int qr = (r & 3) + 8 * (r >> 2) + 4 * hi;
        op[(size_t)qr * D] = (bf16_t)(cvt_pk_bf16(o0[r], 0.f) & 0xffffu); op[(size_t)qr * D + 32] = (bf16_t)(cvt_pk_bf16(o1[r], 0.f) & 0xffffu); }
}
__device__ __forceinline__ void attn_phase(const Args& a, const Frame& F) {
    const bf16_t* Q = (const bf16_t*)(a.ws + WS_Q); const bf16_t* K = (const bf16_t*)(a.ws + WS_K); const bf16_t* VT = (const bf16_t*)(a.ws + WS_VT); bf16_t* O = (bf16_t*)(a.ws + WS_O);
    constexpr int NQB = SEQ / 32, NU = BATCH * NH * NQB;
    LAS unsigned char* slotA = F.lds + F.wave * WAVE_LDS;
    SbAddr ad;
    { const int j = F.lane & 31, hi = F.lane >> 5, key = 16 * ((j >> 2) & 1) + (j & 3) + 4 * (j >> 3), ki = key >> 3, k8 = key & 7;
#pragma unroll
      for (int d0 = 0; d0 < 4; ++d0) ad.k[d0] = ki * ATT_KSTR + (8 * k8 + ((2 * d0 + hi) ^ k8)) * 16;
#pragma unroll
      for (int dh = 0; dh < 2; ++dh)
#pragma unroll
          for (int mm = 0; mm < 2; ++mm) { const int dd = 32 * dh + j, vi = dd >> 4, d16 = dd & 15, a_ = d16 & 3, b_ = d16 >> 2, p = 2 * hi + mm; ad.v[dh * 2 + mm] = ATT_VOFF + vi * 1024 + (16 * a_ + 4 * b_ + (p ^ a_)) * 16; } }
    for (int u = F.gw; u < NU; u += F.NGW) { const int bh = u / NQB, qb = u % NQB; sb_unit(Q, K, VT, O, bh / NH, bh % NH, qb, F.lane, slotA, slotA + ATT_SLOT, ad); }
}

__global__ void __launch_bounds__(NTHR) fwd_kernel(Args args) {
    extern __shared__ __attribute__((aligned(16))) unsigned char lds_raw[];
    Frame F; F.lds = (LAS unsigned char*)lds_raw; F.tid = threadIdx.x; F.lane = F.tid & 63; F.wave = __builtin_amdgcn_readfirstlane(F.tid >> 6);
    F.G = gridDim.x; F.gw = blockIdx.x * NWAVES + F.wave; F.NGW = F.G * NWAVES;
    unsigned char* ws = args.ws;
    float* ss = (float*)(ws + WS_SS);
    const int lo = args.ph_lo, hi = args.ph_hi;
#if MK_COOP
    cg::grid_group grid = cg::this_grid();
    volatile LAS unsigned* MISC = (volatile LAS unsigned*)(F.lds + MISC_OFF);
    if (F.tid < 16) MISC[F.tid] = 0u;
    __syncthreads();
    const XcdBarrier xbar = xcd_barrier_post((unsigned*)ws, MISC + 8);
    if (hi > N_PHASES) grid.sync();
#define SEAM(k) do { if (lo <= (k) && (k) + 1 < hi) xcd_barrier(xbar); } while (0)
#else
#define SEAM(k) do { } while (0)
#endif
#ifndef PH_MASK
#define PH_MASK 0x3ffff
#endif
#define IN(k) (((PH_MASK >> (k)) & 1) && lo <= (k) && (k) < hi)
    using namespace pg8;
    bf16_t* XB = (bf16_t*)(ws + WS_XB); bf16_t* ACT = (bf16_t*)(ws + WS_ACT);
    const int bx = blockIdx.x;
#define RUN_GEMM(EPI, ALIGN, Aptr, Bptr, N_, K_, lda_, adiv_, ...) do { Gemm g{(const bf16_t*)(Aptr), (const bf16_t*)(Bptr), M, (N_), (K_), (lda_), (adiv_)}; StaticOrder S; S.init(M, (N_), F.G, bx); \
        EPI E{__VA_ARGS__}; gemm_phase<EPI, ALIGN>(F.lds, g, S, E); } while (0)

#ifndef DUP_MASK
#define DUP_MASK 0
#endif
#if MK_COOP
#define REDO_BAR() xcd_barrier(xbar)
#else
#define REDO_BAR() do { } while (0)
#endif
#define PHASE(k, ...) do { if (IN(k)) { __VA_ARGS__; if ((DUP_MASK >> (k)) & 1) { REDO_BAR(); __VA_ARGS__; } } SEAM(k); } while (0)
    PHASE(0, cvt_range(args, F, 0, 1, 0, F.G); p0_rows(args, F));
    const int T22 = (64 * 22) % F.G, T30 = (64 * 30) % F.G;
    PHASE(1, RUN_GEMM(EpiSwiglu, true, XB, ws + WS_WA13, 2 * FF, D, D, 0, ss, ACT); cvt_range(args, F, 1, 4, T22, F.G - T22); cvt_range(args, F, 7, 10, T22, F.G - T22));
    PHASE(2, RUN_GEMM(EpiResidIn, true, ACT, ws + WS_WA2, D, FF, FF, 0, args.in[I_X], nullptr, XB, ss + M, 0.5f));
    PHASE(3, RUN_GEMM(EpiWin, true, XB, ws + WS_WIN, 2048, D, D, 0, ss + M, (bf16_t*)(ws + WS_GB), (bf16_t*)(ws + WS_REC)));
    PHASE(4, conv_phase(args, F));
    PHASE(5, RUN_GEMM(EpiGate, true, ws + WS_Y, ws + WS_WRI, 2048, 256, D, 2, (const bf16_t*)(ws + WS_Y), args.in[I_ABR], args.in[I_ABI], (const float*)(ws + WS_SP8), (bf16_t*)(ws + WS_REC), (bf16_t*)(ws + WS_U)));
    PHASE(6, scan_a(args, F));
    PHASE(7, scan_b(args, F));
    PHASE(8, RUN_GEMM(EpiResidMid, true, ws + WS_Y, ws + WS_WOUT, D, D, D, 0, nullptr, nullptr, XB, ss + 2 * M, 1.0f));
    PHASE(9, RUN_GEMM(EpiSwiglu, true, XB, ws + WS_WB13, 2 * FF, D, D, 0, ss + 2 * M, ACT); cvt_range(args, F, 4, 7, T22, F.G - T22));
    PHASE(10, RUN_GEMM(EpiResidMid, true, ACT, ws + WS_WB2, D, FF, FF, 0, nullptr, nullptr, XB, ss + 3 * M, 0.5f));
    PHASE(11, RUN_GEMM(EpiKvSwiglu, true, XB, ws + WS_WKV, 2048 + 2 * FF, D, D, 0, ss + 3 * M, args.in[I_KN], (bf16_t*)(ws + WS_K), (bf16_t*)(ws + WS_VT), ACT); cvt_range(args, F, 10, 14, T30, F.G - T30));
    PHASE(12, RUN_GEMM(EpiResidMid, true, ACT, ws + WS_WC2, D, FF, FF, 0, nullptr, nullptr, XB, ss + 4 * M, 0.5f));
    PHASE(13, RUN_GEMM(EpiQ, true, XB, ws + WS_WQ, D, D, D, 0, ss + 4 * M, args.in[I_QN], (bf16_t*)(ws + WS_Q)));
    PHASE(14, attn_phase(args, F));
    PHASE(15, RUN_GEMM(EpiResidMid, true, ws + WS_O, ws + WS_WO, D, D, D, 0, nullptr, nullptr, XB, ss + 5 * M, 1.0f));
    PHASE(16, RUN_GEMM(EpiSwiglu, true, XB, ws + WS_WA13, 2 * FF, D, D, 0, ss + 5 * M, ACT));
    PHASE(17, RUN_GEMM(EpiResidOut, true, ACT, ws + WS_WA2, D, FF, FF, 0, nullptr, args.out, XB, nullptr, 0.5f));
}

extern "C" void kernel_launch(void* const* d_in, const int* in_sizes, int n_in, void* d_out, int out_size, void* d_ws, size_t ws_size, hipStream_t stream) {
    static int grid = 0;
    if (grid == 0) {
        if (n_in != 23 || out_size != M * D || ws_size < WS_END) { fprintf(stderr, "kernel_launch: unexpected problem (n_in %d out %d ws %zu)\n", n_in, out_size, ws_size); grid = -1; return; }
        int dev = 0, cus = 0, per_cu = 0;
        (void)hipGetDevice(&dev); (void)hipDeviceGetAttribute(&cus, hipDeviceAttributeMultiprocessorCount, dev);
        if (hipFuncSetAttribute((const void*)fwd_kernel, hipFuncAttributeMaxDynamicSharedMemorySize, LDS_BYTES) != hipSuccess) { fprintf(stderr, "kernel_launch: hipFuncSetAttribute failed\n"); grid = -1; return; }
        if (hipOccupancyMaxActiveBlocksPerMultiprocessor(&per_cu, (const void*)fwd_kernel, NTHR, LDS_BYTES) != hipSuccess || per_cu < 1) { fprintf(stderr, "kernel_launch: occupancy query says %d\n", per_cu); per_cu = 1; }
        (void)hipGetLastError();
        grid = cus * 1;
        if (grid <= 0) grid = 256;
    }
    if (grid < 0) return;
    Args a{};
    for (int i = 0; i < 23; ++i) a.in[i] = (const float*)d_in[i];
    a.out = (float*)d_out; a.ws = (unsigned char*)d_ws;
#if MK_COOP
    a.ph_lo = 0; a.ph_hi = N_PHASES;
    if (hipMemsetAsync(d_ws, 0, 16 * KiB, stream) != hipSuccess) { fprintf(stderr, "kernel_launch: memset of the barrier words failed\n"); return; }
    void* kargs[] = {&a};
    hipError_t e = hipLaunchCooperativeKernel((const void*)fwd_kernel, dim3(grid), dim3(NTHR), kargs, LDS_BYTES, stream);
    if (e != hipSuccess) fprintf(stderr, "kernel_launch: cooperative launch failed: %s (grid %d)\n", hipGetErrorString(e), grid);
#else
    for (int p = 0; p < N_PHASES; ++p) { a.ph_lo = p; a.ph_hi = p + 1; hipLaunchKernelGGL(fwd_kernel, dim3(grid), dim3(NTHR), LDS_BYTES, stream, a); }
#endif
}
```

```cpp
#include <hip/hip_runtime.h>
#include <hip/hip_cooperative_groups.h>
#include <cstdio>
#include <cstdint>
#include <cmath>
namespace cg = cooperative_groups;

#ifndef MK_COOP
#define MK_COOP 1
#endif

#define LAS __attribute__((address_space(3)))
typedef unsigned short bf16_t;
typedef short bf16x8 __attribute__((ext_vector_type(8)));
typedef float f32x4 __attribute__((ext_vector_type(4)));
typedef float f32x2 __attribute__((ext_vector_type(2)));
typedef float f32x16 __attribute__((ext_vector_type(16)));
typedef unsigned u32x4 __attribute__((ext_vector_type(4)));
typedef unsigned u32x2 __attribute__((ext_vector_type(2)));

constexpr int BATCH = 4, SEQ = 4096, D = 1024, FF = 2816, NH = 16, HD = 64;
constexpr int M = BATCH * SEQ;
constexpr float EPS = 1e-6f;
constexpr float LOG2E = 1.4426950408889634f, LN2 = 0.6931471805599453f;

constexpr size_t MiB = 1u << 20, KiB = 1u << 10;
constexpr size_t WS_SS = 64 * KiB;
constexpr size_t WS_SP8 = 32 * KiB;
constexpr size_t WS_HL = 1 * MiB, WS_PC = 2 * MiB;
constexpr size_t SZ_W13 = (size_t)2 * FF * D * 2, SZ_W2 = (size_t)D * FF * 2;
constexpr size_t WS_WA13 = 4 * MiB, WS_WA2 = WS_WA13 + SZ_W13;
constexpr size_t WS_WB13 = WS_WA2 + SZ_W2, WS_WB2 = WS_WB13 + SZ_W13;
constexpr size_t WS_WKV = WS_WB2 + SZ_W2, WS_WC13 = WS_WKV + 4 * MiB, WS_WC2 = WS_WC13 + SZ_W13;
constexpr size_t WS_WIN = WS_WC2 + SZ_W2, WS_WRI = WS_WIN + 4 * MiB, WS_WOUT = WS_WRI + 1 * MiB, WS_WQ = WS_WOUT + 2 * MiB, WS_WO = WS_WQ + 2 * MiB;
constexpr size_t WS_XB = 69 * MiB;
constexpr size_t WS_ACT = 101 * MiB;
constexpr size_t WS_K = 189 * MiB, WS_VT = 221 * MiB, WS_END = 253 * MiB;
constexpr size_t WS_GB = WS_ACT, WS_U = WS_ACT + 32 * MiB, WS_REC = WS_ACT + 64 * MiB;
constexpr size_t WS_Y = WS_ACT + 96 * MiB;
constexpr size_t WS_Q = WS_ACT, WS_O = WS_ACT + 32 * MiB;
static_assert(WS_WO + 2 * MiB <= WS_XB && WS_REC + 64 * MiB <= WS_END, "ws map");

__device__ __forceinline__ unsigned cvt_pk_bf16(float lo, float hi) {
    typedef __bf16 bf16x2_t __attribute__((ext_vector_type(2)));
    f32x2 v = {lo, hi}; bf16x2_t b = __builtin_convertvector(v, bf16x2_t); return __builtin_bit_cast(unsigned, b);
}
__device__ __forceinline__ float bf_lo(unsigned w) { return __uint_as_float(w << 16); }
__device__ __forceinline__ float bf_hi(unsigned w) { return __uint_as_float(w & 0xffff0000u); }
__device__ __forceinline__ float sigm(float x) { return __builtin_amdgcn_rcpf(1.0f + __builtin_amdgcn_exp2f(-x * LOG2E)); }
__device__ __forceinline__ float gelu_tanh(float x) { return x * sigm(1.5957691216057308f * (x + 0.044715f * x * x * x)); }
__device__ __forceinline__ float wave_sum(float v) {
#pragma unroll
    for (int o = 1; o < 64; o <<= 1) v += __shfl_xor(v, o);
    return v;
}
#define LDS_WAIT() asm volatile("s_waitcnt lgkmcnt(0)" ::: "memory")

namespace pg8 {
constexpr int BM = 256, BK = 64, HALF = 128, HTB = HALF * BK * 2, STAGE_BYTES = 8 * HTB, NXCD = 8, WGM = 4;
__host__ __device__ __forceinline__ int lds_byte(int r, int c) { const int st = (r >> 4) * 2 + (c >> 5), rr = r & 15, cc = c & 31, ob = rr * 64 + cc * 2; return st * 1024 + (ob ^ (((ob >> 9) & 1) << 5)); }
__host__ __device__ __forceinline__ void stage_rc(int b, int& R, int& C) { const int st = b / 1024, sb = b % 1024, swz = sb ^ (((sb >> 9) & 1) << 5); R = (st >> 1) * 16 + swz / 64; C = (st & 1) * 32 + (swz % 64) / 2; }
__host__ __device__ __forceinline__ int perm32(int rho) { const int n = rho >> 4, i = rho & 15; return 8 * (i >> 2) + 4 * n + (i & 3); }

struct Unit { int pm, pn; };
struct Gemm { const bf16_t* A; const bf16_t* Bt; int M, N, K, lda, adiv; };

struct StaticOrder {
    int nM, nN, nwg, G, c;
    __device__ void init(int M_, int N_, int G_, int c_) { nM = M_ / BM; nN = N_ / BM; nwg = nM * nN; G = G_; c = c_; }
    __device__ bool next(int i, Unit& u) const {
        const long L = (long)i * G + c; if (L >= nwg) return false;
        int wgid = (int)L; { const int q = nwg / NXCD, r = nwg % NXCD, xcd = wgid % NXCD, off = wgid / NXCD; wgid = (xcd < r ? xcd * (q + 1) : r * (q + 1) + (xcd - r) * q) + off; }
        const int nig = WGM * nN, gid = wgid / nig, fm = gid * WGM, gsz = (nM - fm) < WGM ? (nM - fm) : WGM;
        u.pm = fm + ((wgid % nig) % gsz); u.pn = (wgid % nig) / gsz; return true;
    }
};

template <class Epi, bool ALIGN_EPI>
__device__ __forceinline__ void gemm_phase(LAS unsigned char* lds, const Gemm g, const StaticOrder& S, const Epi& E) {
    const int tid = threadIdx.x, wid = __builtin_amdgcn_readfirstlane(tid >> 6), lane = tid & 63, wr = wid >> 2, wc = wid & 3, fr = lane & 15, fq = lane >> 4;
    const int K = g.K, nt = K / BK, lda = g.lda;
    unsigned voffA[2], voffB[2];
#pragma unroll
    for (int i = 0; i < 2; ++i) { int R, C; stage_rc(tid * 16 + i * 8192, R, C); const int Rb = (R & ~31) + perm32(R & 31);
        voffA[i] = (unsigned)(R * lda + C) * 2u; voffB[i] = (unsigned)(Rb * K + C) * 2u; }
    const size_t kstep = (size_t)(BK * 2);
    const size_t hA = (size_t)HALF * lda * 2, hB = (size_t)HALF * K * 2;
    const size_t tA = 2 * hA, tB = 2 * hB;
    const unsigned ldsw = (unsigned)wid * 1024u;
    const int aoff = lds_byte(wr * 64 + fr, fq * 8), boff = lds_byte(wc * 32 + fr, fq * 8);
#define PG8_SA(b, h) (((b) * 2 + (h)) * HTB)
#define PG8_SB(b, h) ((4 + (b) * 2 + (h)) * HTB)
#define PG8_STAGE(bufoff, gbase, voff) do { _Pragma("unroll") for (int _i = 0; _i < 2; ++_i) \
        __builtin_amdgcn_global_load_lds((const unsigned*)((const char*)(gbase) + (voff)[_i]), (LAS unsigned*)(lds + (bufoff) + ldsw + _i * 8192), 16, 0, 0); } while (0)
#define PG8_LDA(dst, b, h) do { _Pragma("unroll") for (int m = 0; m < 4; ++m) _Pragma("unroll") for (int k = 0; k < 2; ++k) dst[m][k] = *(const LAS bf16x8*)(lds + PG8_SA(b, h) + aoff + m * 2048 + k * 1024); } while (0)
#define PG8_LDB(dst, b, h) do { _Pragma("unroll") for (int n = 0; n < 2; ++n) _Pragma("unroll") for (int k = 0; k < 2; ++k) dst[n][k] = *(const LAS bf16x8*)(lds + PG8_SB(b, h) + boff + n * 2048 + k * 1024); } while (0)
#define PG8_MMA(ai, bj, At, Bt) do { __builtin_amdgcn_s_setprio(1); _Pragma("unroll") for (int m = 0; m < 4; ++m) _Pragma("unroll") for (int n = 0; n < 2; ++n) _Pragma("unroll") for (int k = 0; k < 2; ++k) \
        acc[ai][bj][m][n] = __builtin_amdgcn_mfma_f32_16x16x32_bf16(Bt[n][k], At[m][k], acc[ai][bj][m][n], 0, 0, 0); __builtin_amdgcn_s_setprio(0); } while (0)
#define PG8_WAIT_V(n) asm volatile("s_waitcnt vmcnt(" #n ")" ::: "memory")
#define PG8_WAIT_L(n) asm volatile("s_waitcnt lgkmcnt(" #n ")" ::: "memory")
#define PG8_BAR __builtin_amdgcn_s_barrier()
#define PG8_SCHED __builtin_amdgcn_sched_barrier(0)
#define PG8_ABASE(u) ((const char*)g.A + (size_t)(u).pm * tA + (g.adiv ? (size_t)((u).pn / g.adiv) * K * 2 : (size_t)0))
#define PG8_BBASE(u) ((const char*)g.Bt + (size_t)(u).pn * tB)
    Unit cur, nxt; int ui = 0;
    if (!S.next(0, cur)) return;
    f32x4 acc[2][2][4][2];
#pragma unroll
    for (int a = 0; a < 2; ++a)
#pragma unroll
        for (int b = 0; b < 2; ++b)
#pragma unroll
            for (int m = 0; m < 4; ++m)
#pragma unroll
                for (int n = 0; n < 2; ++n) acc[a][b][m][n] = (f32x4){0.f, 0.f, 0.f, 0.f};
    bf16x8 At[4][2], B0[2][2], B1[2][2];
    const char* cA = PG8_ABASE(cur); const char* cB = PG8_BBASE(cur);
    PG8_STAGE(PG8_SB(0, 0), cB, voffB); PG8_STAGE(PG8_SB(0, 1), cB + hB, voffB); PG8_STAGE(PG8_SA(0, 0), cA, voffA); PG8_STAGE(PG8_SA(0, 1), cA + hA, voffA);
    if (wr == 1) PG8_BAR;
    PG8_WAIT_V(2); PG8_BAR;
    PG8_STAGE(PG8_SB(1, 0), cB + kstep, voffB); PG8_STAGE(PG8_SA(1, 0), cA + kstep, voffA); PG8_STAGE(PG8_SB(1, 1), cB + hB + kstep, voffB);
    PG8_WAIT_V(6); PG8_BAR;
    for (;;) {
        const bool has_next = S.next(ui + 1, nxt);
        const char* nA = has_next ? PG8_ABASE(nxt) : cA; const char* nB = has_next ? PG8_BBASE(nxt) : cB;
#pragma unroll 1
        for (int t = 0; t < nt; t += 2) {
            const bool last = (t == nt - 2);
            const char* a1 = cA + (size_t)(t + 1) * kstep;
            const char* a2 = last ? nA : cA + (size_t)(t + 2) * kstep; const char* b2 = last ? nB : cB + (size_t)(t + 2) * kstep;
            const char* a3 = a2 + kstep; const char* b3 = b2 + kstep;
            PG8_LDB(B0, 0, 0); PG8_LDB(B1, 0, 1); PG8_SCHED; PG8_LDA(At, 0, 0); PG8_STAGE(PG8_SA(1, 1), a1 + hA, voffA);
            PG8_WAIT_V(8); PG8_WAIT_L(0); PG8_BAR; PG8_MMA(0, 0, At, B0); PG8_MMA(0, 1, At, B1); PG8_BAR; PG8_SCHED;
            PG8_LDA(At, 0, 1); PG8_STAGE(PG8_SB(0, 0), b2, voffB); PG8_STAGE(PG8_SB(0, 1), b2 + hB, voffB); PG8_STAGE(PG8_SA(0, 0), a2, voffA);
            PG8_WAIT_V(8); PG8_WAIT_L(0); PG8_BAR; PG8_MMA(1, 0, At, B0); PG8_MMA(1, 1, At, B1); PG8_BAR; PG8_SCHED;
            PG8_LDB(B0, 1, 0); PG8_LDB(B1, 1, 1); PG8_SCHED; PG8_LDA(At, 1, 0); PG8_STAGE(PG8_SA(0, 1), a2 + hA, voffA);
            PG8_WAIT_V(8); PG8_WAIT_L(0); PG8_BAR; PG8_MMA(0, 0, At, B0); PG8_MMA(0, 1, At, B1); PG8_BAR; PG8_SCHED;
            PG8_LDA(At, 1, 1); PG8_STAGE(PG8_SB(1, 0), b3, voffB); PG8_STAGE(PG8_SB(1, 1), b3 + hB, voffB); PG8_STAGE(PG8_SA(1, 0), a3, voffA);
            PG8_WAIT_V(8); PG8_WAIT_L(0); PG8_BAR; PG8_MMA(1, 0, At, B0); PG8_MMA(1, 1, At, B1); PG8_BAR; PG8_SCHED;
        }
        if constexpr (ALIGN_EPI) { if (wr == 0) PG8_BAR; }
        E(acc, cur, wr, wc, fr, fq);
        if (!has_next) break;
#pragma unroll
        for (int a = 0; a < 2; ++a)
#pragma unroll
            for (int b = 0; b < 2; ++b)
#pragma unroll
                for (int m = 0; m < 4; ++m)
#pragma unroll
                    for (int n = 0; n < 2; ++n) acc[a][b][m][n] = (f32x4){0.f, 0.f, 0.f, 0.f};
        cur = nxt; cA = nA; cB = nB; ++ui;
        if constexpr (ALIGN_EPI) { if (wr == 1) PG8_BAR; }
    }
    PG8_WAIT_V(0);
    if constexpr (!ALIGN_EPI) { if (wr == 0) PG8_BAR; }
    PG8_BAR;
#undef PG8_SA
#undef PG8_SB
#undef PG8_STAGE
#undef PG8_LDA
#undef PG8_LDB
#undef PG8_MMA
#undef PG8_WAIT_V
#undef PG8_WAIT_L
#undef PG8_BAR
#undef PG8_SCHED
#undef PG8_ABASE
#undef PG8_BBASE
}

typedef f32x4 Acc[2][2][4][2];
__device__ __forceinline__ float rstd_of(const float* ss, int row) { return 1.0f / sqrtf(ss[row] * (1.0f / D) + EPS); }

__device__ __forceinline__ void rstd8(const float* ss, int rbase, float (&rs)[2][4]) {
    float t[2][4];
#pragma unroll
    for (int ai = 0; ai < 2; ++ai)
#pragma unroll
        for (int m = 0; m < 4; ++m) t[ai][m] = ss[rbase + ai * HALF + m * 16];
#pragma unroll
    for (int ai = 0; ai < 2; ++ai)
#pragma unroll
        for (int m = 0; m < 4; ++m) rs[ai][m] = 1.0f / sqrtf(t[ai][m] * (1.0f / D) + EPS);
}
__device__ __forceinline__ void epi_swiglu(const Acc& acc, int pm, int pnf, int wr, int wc, int fr, int fq, const float* ss, bf16_t* act) {
    const int col = pnf * 128 + wc * 32 + 8 * fq;
    float rs8[2][4]; rstd8(ss, pm * BM + wr * 64 + fr, rs8);
#pragma unroll
    for (int ai = 0; ai < 2; ++ai)
#pragma unroll
        for (int m = 0; m < 4; ++m) {
            const int row = pm * BM + ai * HALF + wr * 64 + m * 16 + fr; const float rs = rs8[ai][m];
            float o[8];
#pragma unroll
            for (int n = 0; n < 2; ++n)
#pragma unroll
                for (int j = 0; j < 4; ++j) { const float gt = acc[ai][0][m][n][j] * rs, up = acc[ai][1][m][n][j] * rs; o[n * 4 + j] = gt * sigm(gt) * up; }
            u32x4 w; w.x = cvt_pk_bf16(o[0], o[1]); w.y = cvt_pk_bf16(o[2], o[3]); w.z = cvt_pk_bf16(o[4], o[5]); w.w = cvt_pk_bf16(o[6], o[7]);
            __builtin_nontemporal_store(w, (u32x4*)(act + (size_t)row * FF + col));
        }
}
struct EpiSwiglu { const float* ss; bf16_t* act;
    __device__ __forceinline__ void operator()(const Acc& acc, const Unit& u, int wr, int wc, int fr, int fq) const { epi_swiglu(acc, u.pm, u.pn, wr, wc, fr, fq, ss, act); } };

template <bool IN_F32, bool FINAL> struct EpiResid { const float* xin; float* xout; bf16_t* xb; float* ssn; float alpha; LAS float* red;
    __device__ __forceinline__ void operator()(const Acc& acc, const Unit& u, int wr, int wc, int fr, int fq) const {
        const size_t cbase = (size_t)u.pn * BM + wc * 32 + 8 * fq;
#pragma unroll
        for (int ai = 0; ai < 2; ++ai) {
            f32x4 xr[4][2][2];
#pragma unroll
            for (int m = 0; m < 4; ++m)
#pragma unroll
                for (int bj = 0; bj < 2; ++bj) {
                    const size_t off = (size_t)(u.pm * BM + ai * HALF + wr * 64 + m * 16 + fr) * D + cbase + bj * HALF;
                    if (IN_F32) { xr[m][bj][0] = *(const f32x4*)(xin + off); xr[m][bj][1] = *(const f32x4*)(xin + off + 4); }
                    else { const u32x4 xw = *(const u32x4*)(xb + off); xr[m][bj][0] = __builtin_bit_cast(f32x4, xw); }
                }
#pragma unroll
            for (int m = 0; m < 4; ++m) {
                const int row = u.pm * BM + ai * HALF + wr * 64 + m * 16 + fr; float sq = 0.f;
#pragma unroll
                for (int bj = 0; bj < 2; ++bj) {
                    const size_t off = (size_t)row * D + cbase + bj * HALF;
                    f32x4 x0, x1;
                    if (IN_F32) { x0 = xr[m][bj][0]; x1 = xr[m][bj][1]; }
                    else { const u32x4 xw = __builtin_bit_cast(u32x4, xr[m][bj][0]); x0 = (f32x4){bf_lo(xw.x), bf_hi(xw.x), bf_lo(xw.y), bf_hi(xw.y)}; x1 = (f32x4){bf_lo(xw.z), bf_hi(xw.z), bf_lo(xw.w), bf_hi(xw.w)}; }
                    const f32x4 y0 = x0 + acc[ai][bj][m][0] * alpha, y1 = x1 + acc[ai][bj][m][1] * alpha;
                    if (FINAL) { *(f32x4*)(xout + off) = y0; *(f32x4*)(xout + off + 4) = y1; }
                    else {
                        sq += (y0[0] * y0[0] + y0[1] * y0[1]) + (y0[2] * y0[2] + y0[3] * y0[3]) + (y1[0] * y1[0] + y1[1] * y1[1]) + (y1[2] * y1[2] + y1[3] * y1[3]);
                        u32x4 w; w.x = cvt_pk_bf16(y0[0], y0[1]); w.y = cvt_pk_bf16(y0[2], y0[3]); w.z = cvt_pk_bf16(y1[0], y1[1]); w.w = cvt_pk_bf16(y1[2], y1[3]);
                        *(u32x4*)(xb + off) = w;
                    }
                }
                if (!FINAL) { sq += __shfl_xor(sq, 16); sq += __shfl_xor(sq, 32); if (fq == 0) red[(ai * HALF + wr * 64 + m * 16 + fr) * 4 + wc] = sq; }
            }
        }
        if (!FINAL) {
            asm volatile("s_waitcnt lgkmcnt(0)" ::: "memory"); __builtin_amdgcn_s_barrier(); asm volatile("" ::: "memory");
            const int t = threadIdx.x;
            if (t < BM) { const f32x4 v = ((const LAS f32x4*)red)[t]; atomicAdd(ssn + u.pm * BM + t, (v[0] + v[1]) + (v[2] + v[3])); }
        }
    } };
typedef EpiResid<true, false> EpiResidIn; typedef EpiResid<false, false> EpiResidMid; typedef EpiResid<false, true> EpiResidOut;

struct EpiWin { const float* ss; bf16_t* gb; bf16_t* rec;
    __device__ __forceinline__ void operator()(const Acc& acc, const Unit& u, int wr, int wc, int fr, int fq) const {
        const bool isg = u.pn < 4; const int ct = (u.pn & 3) * BM;
        float rs8[2][4]; rstd8(ss, u.pm * BM + wr * 64 + fr, rs8);
#pragma unroll
        for (int ai = 0; ai < 2; ++ai)
#pragma unroll
            for (int m = 0; m < 4; ++m) {
                const int row = u.pm * BM + ai * HALF + wr * 64 + m * 16 + fr; const float rs = rs8[ai][m];
#pragma unroll
                for (int bj = 0; bj < 2; ++bj) {
                    const size_t off = (size_t)row * D + ct + bj * HALF + wc * 32 + 8 * fq;
                    const f32x4 v0 = acc[ai][bj][m][0] * rs, v1 = acc[ai][bj][m][1] * rs;
                    if (isg) { u32x4 w; w.x = cvt_pk_bf16(gelu_tanh(v0[0]), gelu_tanh(v0[1])); w.y = cvt_pk_bf16(gelu_tanh(v0[2]), gelu_tanh(v0[3]));
                        w.z = cvt_pk_bf16(gelu_tanh(v1[0]), gelu_tanh(v1[1])); w.w = cvt_pk_bf16(gelu_tanh(v1[2]), gelu_tanh(v1[3])); *(u32x4*)(gb + off) = w; }
                    else { u32x4 w; w.x = cvt_pk_bf16(v0[0], v0[1]); w.y = cvt_pk_bf16(v0[2], v0[3]); w.z = cvt_pk_bf16(v1[0], v1[1]); w.w = cvt_pk_bf16(v1[2], v1[3]); *(u32x4*)(rec + off) = w; }
                }
            }
    } };

struct EpiGate { const bf16_t* xc; const float* b_r; const float* b_i; const float* sp8; bf16_t* aout; bf16_t* uout;
    __device__ __forceinline__ void operator()(const Acc& acc, const Unit& u, int wr, int wc, int fr, int fq) const {
        const int ch = u.pn * 128 + wc * 32 + 8 * fq;
        float br[8], bi[8], sp[8];
#pragma unroll
        for (int n = 0; n < 2; ++n) { const f32x4 a_ = *(const f32x4*)(b_r + ch + 4 * n), b_ = *(const f32x4*)(b_i + ch + 4 * n), c_ = *(const f32x4*)(sp8 + ch + 4 * n);
#pragma unroll
            for (int j = 0; j < 4; ++j) { br[4 * n + j] = a_[j]; bi[4 * n + j] = b_[j]; sp[4 * n + j] = c_[j]; } }
        u32x4 xcw[2][4];
#pragma unroll
        for (int ai = 0; ai < 2; ++ai)
#pragma unroll
            for (int m = 0; m < 4; ++m) xcw[ai][m] = *(const u32x4*)(xc + (size_t)(u.pm * BM + ai * HALF + wr * 64 + m * 16 + fr) * D + ch);
#pragma unroll
        for (int ai = 0; ai < 2; ++ai)
#pragma unroll
            for (int m = 0; m < 4; ++m) {
                const int row = u.pm * BM + ai * HALF + wr * 64 + m * 16 + fr; const size_t off = (size_t)row * D + ch;
                const u32x4 xw = xcw[ai][m];
                const float xv[8] = {bf_lo(xw.x), bf_hi(xw.x), bf_lo(xw.y), bf_hi(xw.y), bf_lo(xw.z), bf_hi(xw.z), bf_lo(xw.w), bf_hi(xw.w)};
                float av[8], uv[8];
#pragma unroll
                for (int j = 0; j < 8; ++j) {
                    const float r = sigm(acc[ai][0][m][j >> 2][j & 3] + br[j]), ig = sigm(acc[ai][1][m][j >> 2][j & 3] + bi[j]);
                    const float la2 = r * sp[j];
                    const float a = __builtin_amdgcn_exp2f(la2);
                    av[j] = la2; uv[j] = __builtin_amdgcn_sqrtf(fmaxf(1.0f - a * a, 0.f)) * ig * xv[j];
                }
                u32x4 wa; wa.x = cvt_pk_bf16(av[0], av[1]); wa.y = cvt_pk_bf16(av[2], av[3]); wa.z = cvt_pk_bf16(av[4], av[5]); wa.w = cvt_pk_bf16(av[6], av[7]);
                *(u32x4*)(aout + off) = wa;
                u32x4 w; w.x = cvt_pk_bf16(uv[0], uv[1]); w.y = cvt_pk_bf16(uv[2], uv[3]); w.z = cvt_pk_bf16(uv[4], uv[5]); w.w = cvt_pk_bf16(uv[6], uv[7]);
                *(u32x4*)(uout + off) = w;
            }
    } };

__device__ __forceinline__ void epi_headnorm(const Acc& acc, int pm, int pnh, int wr, int wc, int fr, int fq, const float* ss, const float* gain, float oscale, bf16_t* out) {
    const int head = 4 * pnh + wc;
    float sc[2][4]; rstd8(ss, pm * BM + wr * 64 + fr, sc);
#pragma unroll
    for (int ai = 0; ai < 2; ++ai)
#pragma unroll
        for (int m = 0; m < 4; ++m) {
            const float rs = sc[ai][m];
            float sq = 0.f;
#pragma unroll
            for (int bj = 0; bj < 2; ++bj)
#pragma unroll
                for (int n = 0; n < 2; ++n) { const f32x4 v = acc[ai][bj][m][n]; sq += (v[0] * v[0] + v[1] * v[1]) + (v[2] * v[2] + v[3] * v[3]); }
            sq += __shfl_xor(sq, 16); sq += __shfl_xor(sq, 32);
            sc[ai][m] = rs * oscale / sqrtf(sq * rs * rs * (1.0f / HD) + EPS);
        }
#pragma unroll
    for (int bj = 0; bj < 2; ++bj) {
        const f32x4 g0 = *(const f32x4*)(gain + 32 * bj + 8 * fq), g1 = *(const f32x4*)(gain + 32 * bj + 8 * fq + 4);
#pragma unroll
        for (int ai = 0; ai < 2; ++ai)
#pragma unroll
            for (int m = 0; m < 4; ++m) {
                const int row = pm * BM + ai * HALF + wr * 64 + m * 16 + fr;
                const f32x4 v0 = acc[ai][bj][m][0] * g0 * sc[ai][m], v1 = acc[ai][bj][m][1] * g1 * sc[ai][m];
                u32x4 w; w.x = cvt_pk_bf16(v0[0], v0[1]); w.y = cvt_pk_bf16(v0[2], v0[3]); w.z = cvt_pk_bf16(v1[0], v1[1]); w.w = cvt_pk_bf16(v1[2], v1[3]);
                *(u32x4*)(out + (size_t)row * D + head * HD + 32 * bj + 8 * fq) = w;
                asm volatile("" ::: "memory");
            }
    }
}
struct EpiQ { const float* ss; const float* gain; bf16_t* q;
    __device__ __forceinline__ void operator()(const Acc& acc, const Unit& u, int wr, int wc, int fr, int fq) const { epi_headnorm(acc, u.pm, u.pn, wr, wc, fr, fq, ss, gain, 0.125f * LOG2E, q); } };
struct EpiKvSwiglu { const float* ss; const float* kgain; bf16_t* kout; bf16_t* vt; bf16_t* act;
    __device__ __forceinline__ void operator()(const Acc& acc, const Unit& u, int wr, int wc, int fr, int fq) const {
        if (u.pn >= 8) { epi_swiglu(acc, u.pm, u.pn - 8, wr, wc, fr, fq, ss, act); return; }
        if (u.pn < 4) { epi_headnorm(acc, u.pm, u.pn, wr, wc, fr, fq, ss, kgain, 1.0f, kout); return; }
        const int head = 4 * (u.pn - 4) + wc;
        float rs8[2][4]; rstd8(ss, u.pm * BM + wr * 64 + fr, rs8);
        const int row0 = u.pm * BM + wr * 64 + fr, b = row0 / SEQ, s0 = row0 % SEQ;
        bf16_t* base = vt + ((size_t)(b * NH + head) * HD + 8 * fq) * SEQ + s0;
#pragma unroll
        for (int bj = 0; bj < 2; ++bj)
#pragma unroll
            for (int j = 0; j < 8; ++j) {
                bf16_t* p = base + (size_t)(32 * bj + j) * SEQ;
#pragma unroll
                for (int ai = 0; ai < 2; ++ai)
#pragma unroll
                    for (int m = 0; m < 4; ++m) p[ai * HALF + m * 16] = (bf16_t)(cvt_pk_bf16(acc[ai][bj][m][j >> 2][j & 3] * rs8[ai][m], 0.f) & 0xffffu);
                asm volatile("" ::: "memory");
            }
    } };
}


#define XB_TMO      128
#define XB_XCNT(j)  (256  + 64 * (j))
#define XB_XSUB(j)  (1280 + 64 * (j))
#define XB_XGEN(j)  (2304 + 64 * (j))
#define XB_TOP      3328
#define XB_TOPGEN   3392
#define XCD_BAR_WORDS 3456
#define XB_SPIN_CAP (1u << 18)
__device__ __forceinline__ unsigned xb_ld(unsigned* p)              { return __hip_atomic_load(p, __ATOMIC_RELAXED, __HIP_MEMORY_SCOPE_AGENT); }
__device__ __forceinline__ unsigned xb_add(unsigned* p, unsigned v) { return __hip_atomic_fetch_add(p, v, __ATOMIC_RELAXED, __HIP_MEMORY_SCOPE_AGENT); }
__device__ __forceinline__ unsigned xb_xcc_id() { return (unsigned)__builtin_amdgcn_s_getreg((3 << 11) | 20) & 0xFu; }
#define XB_SPIN(cond, bar) do { unsigned _sp = 0; while (cond) { __builtin_amdgcn_s_sleep(1); \
    if ((++_sp & 255u) == 0u) { if (xb_ld(&(bar)[XB_TMO])) break; if (_sp > XB_SPIN_CAP) { atomicAdd(&(bar)[XB_TMO], 1u); break; } } } } while (0)
struct XcdBarrier { unsigned* bar; unsigned x; volatile LAS unsigned* st; };
__device__ __forceinline__ XcdBarrier xcd_barrier_post(unsigned* bar, volatile LAS unsigned* st) {
    XcdBarrier b; b.bar = bar; b.x = xb_xcc_id(); b.st = st;
    if (threadIdx.x == 0) (void)xb_add(&bar[XB_XCNT(b.x)], 1u);
    return b;
}
__device__ __forceinline__ void xcd_barrier_complete(unsigned* bar, unsigned x, unsigned& nloc, unsigned& nx) {
    const unsigned G = gridDim.x * gridDim.y * gridDim.z;
    unsigned sum, cnt, mine, sp = 0u;
    for (;;) {
        sum = 0u; cnt = 0u; mine = 0u;
#pragma unroll
        for (unsigned j = 0; j < 16; ++j) { const unsigned c = xb_ld(&bar[XB_XCNT(j)]); sum += c; cnt += (c > 0u) ? 1u : 0u; mine = (j == x) ? c : mine; }
        if (sum == G) break;
        __builtin_amdgcn_s_sleep(1);
        if ((++sp & 255u) == 0u) { if (xb_ld(&bar[XB_TMO])) break; if (sp > XB_SPIN_CAP) { atomicAdd(&bar[XB_TMO], 1u); break; } }
    }
    nloc = mine > 0u ? mine : 1u; nx = cnt > 0u ? cnt : 1u;
}
__device__ __forceinline__ void xcd_barrier(const XcdBarrier& b) {
    asm volatile("s_waitcnt vmcnt(0)" ::: "memory");
    __syncthreads();
    if (threadIdx.x == 0) {
        unsigned* bar = b.bar;
        __builtin_amdgcn_s_waitcnt(0);
        unsigned nloc = b.st[0], nx = b.st[1];
        if (nloc == 0u) { xcd_barrier_complete(bar, b.x, nloc, nx); b.st[0] = nloc; b.st[1] = nx; }
        const unsigned old = xb_add(&bar[XB_XSUB(b.x)], 1u);
        const unsigned gen = old / nloc;
        if (old + 1u == (gen + 1u) * nloc) {
            __builtin_amdgcn_fence(__ATOMIC_RELEASE, "agent");
            asm volatile("s_waitcnt vmcnt(0)" ::: "memory");
            const unsigned og = xb_add(&bar[XB_TOP], 1u);
            const unsigned tg = og / nx;
            if (og + 1u == (tg + 1u) * nx) xb_add(&bar[XB_TOPGEN], 1u);
            else XB_SPIN(xb_ld(&bar[XB_TOPGEN]) == tg, bar);
            __builtin_amdgcn_fence(__ATOMIC_ACQUIRE, "agent");
            xb_add(&bar[XB_XGEN(b.x)], 1u);
            asm volatile("s_waitcnt vmcnt(0)" ::: "memory");
        } else {
            XB_SPIN(xb_ld(&bar[XB_XGEN(b.x)]) == gen, bar);
            __builtin_amdgcn_fence(__ATOMIC_ACQUIRE, "agent");
            asm volatile("s_waitcnt vmcnt(0)" ::: "memory");
        }
    }
    __syncthreads();
}

constexpr int N_PHASES = 18;
constexpr int NWAVES = 8, NTHR = NWAVES * 64;
constexpr int MISC_OFF = 8 * 16896, LDS_BYTES = MISC_OFF + 256;

struct Args { const float* in[23]; float* out; unsigned char* ws; int ph_lo, ph_hi; };

struct Frame { LAS unsigned char* lds; int tid, lane, wave, G, gw, NGW; };

struct CvtDesc { const float* W; const float* W2; bf16_t* dst; const float* gain; int ldw, K, nb, mode; };
constexpr int SCR_STRIDE = 64 * 65 * 4;
__device__ __forceinline__ void cvt_item(const CvtDesc& d, int local, LAS float* scr, int lane) {
    const int kb = local / d.nb, gI = local % d.nb, k0 = 64 * kb, n0 = 64 * gI;
    const int l16 = lane & 15, l4 = lane >> 4, n = n0 + 4 * l16;
    const float* W = d.W; int c0;
    if (d.mode == 0) c0 = n;
    else if (d.mode == 1) { const int tile = n >> 8, bj = (n >> 7) & 1, j0 = n & 127; c0 = bj * FF + tile * 128 + j0; }
    else if (d.mode == 2) { const int pn = n >> 8, bj = (n >> 7) & 1, wc = (n >> 5) & 3, j0 = n & 31; c0 = 256 * pn + 64 * wc + 32 * bj + j0; }
    else { const int t = n >> 8, blk = t >> 1, half = t & 1, which = (n >> 7) & 1, j0 = n & 127; W = (which ? d.W2 : d.W) + (size_t)blk * 65536; c0 = half * 128 + j0; }
    const float* wp = W + (size_t)(k0 + l4) * d.ldw + c0;
    f32x4 v[16];
#pragma unroll
    for (int i = 0; i < 16; ++i) v[i] = *(const f32x4*)(wp + (size_t)(4 * i) * d.ldw);
    if (d.gain) {
#pragma unroll
        for (int i = 0; i < 16; ++i) v[i] *= d.gain[k0 + 4 * i + l4];
    }
#pragma unroll
    for (int i = 0; i < 16; ++i) { LAS float* s = scr + (4 * i + l4) * 65 + 4 * l16; s[0] = v[i][0]; s[1] = v[i][1]; s[2] = v[i][2]; s[3] = v[i][3]; }
    LDS_WAIT(); asm volatile("" ::: "memory");
    const int c = lane & 7;
#pragma unroll
    for (int j = 0; j < 8; ++j) { const int nn = (lane >> 3) + 8 * j; const LAS float* s = scr + (8 * c) * 65 + nn;
        u32x4 o; o.x = cvt_pk_bf16(s[0 * 65], s[1 * 65]); o.y = cvt_pk_bf16(s[2 * 65], s[3 * 65]); o.z = cvt_pk_bf16(s[4 * 65], s[5 * 65]); o.w = cvt_pk_bf16(s[6 * 65], s[7 * 65]);
        *(u32x4*)(d.dst + (size_t)(n0 + nn) * d.K + k0 + 8 * c) = o; }
    LDS_WAIT(); asm volatile("" ::: "memory");
}
enum { I_X = 0, I_F1N, I_F1W13, I_F1W2, I_MIXN, I_AWIN, I_ACW, I_ACB, I_AWR, I_ABR, I_AWI, I_ABI, I_ALAM, I_AWOUT, I_KVN, I_WKV, I_KN, I_BWQ, I_QN, I_BWO, I_F2N, I_F2W13, I_F2W2 };
constexpr int IT_W13 = (D / 64) * (2 * FF / 64), IT_W2 = (FF / 64) * (D / 64), IT_2048 = (D / 64) * (2048 / 64), IT_1024 = (D / 64) * (D / 64), IT_RI = (256 / 64) * (2048 / 64);
__device__ __forceinline__ CvtDesc cvt_desc(const Args& a, int id) {
    unsigned char* ws = a.ws; CvtDesc d; d.W2 = nullptr; d.gain = nullptr;
    switch (id) {
    case 0: d = {a.in[I_F1W13], nullptr, (bf16_t*)(ws + WS_WA13), a.in[I_F1N], 2 * FF, D, 2 * FF / 64, 1}; break;
    case 1: d = {a.in[I_F1W2], nullptr, (bf16_t*)(ws + WS_WA2), nullptr, D, FF, D / 64, 0}; break;
    case 2: d = {a.in[I_F2W13], nullptr, (bf16_t*)(ws + WS_WB13), a.in[I_F2N], 2 * FF, D, 2 * FF / 64, 1}; break;
    case 3: d = {a.in[I_F2W2], nullptr, (bf16_t*)(ws + WS_WB2), nullptr, D, FF, D / 64, 0}; break;
    case 4: d = {a.in[I_WKV], nullptr, (bf16_t*)(ws + WS_WKV), a.in[I_KVN], 2048, D, 2048 / 64, 2}; break;
    case 5: d = {a.in[I_F1W13] + (size_t)D * 2 * FF, nullptr, (bf16_t*)(ws + WS_WC13), a.in[I_F1N] + D, 2 * FF, D, 2 * FF / 64, 1}; break;
    case 6: d = {a.in[I_F1W2] + (size_t)FF * D, nullptr, (bf16_t*)(ws + WS_WC2), nullptr, D, FF, D / 64, 0}; break;
    case 7: d = {a.in[I_AWIN], nullptr, (bf16_t*)(ws + WS_WIN), a.in[I_MIXN], 2048, D, 2048 / 64, 0}; break;
    case 8: d = {a.in[I_AWR], a.in[I_AWI], (bf16_t*)(ws + WS_WRI), nullptr, 256, 256, 2048 / 64, 3}; break;
    case 9: d = {a.in[I_AWOUT], nullptr, (bf16_t*)(ws + WS_WOUT), nullptr, D, D, D / 64, 0}; break;
    case 10: d = {a.in[I_BWQ], nullptr, (bf16_t*)(ws + WS_WQ), a.in[I_MIXN] + D, D, D, D / 64, 2}; break;
    case 11: d = {a.in[I_BWO], nullptr, (bf16_t*)(ws + WS_WO), nullptr, D, D, D / 64, 0}; break;
    case 12: d = {a.in[I_F2W13] + (size_t)D * 2 * FF, nullptr, (bf16_t*)(ws + WS_WA13), a.in[I_F2N] + D, 2 * FF, D, 2 * FF / 64, 1}; break;
    default: d = {a.in[I_F2W2] + (size_t)FF * D, nullptr, (bf16_t*)(ws + WS_WA2), nullptr, D, FF, D / 64, 0}; break;
    }
    return d;
}
__device__ __forceinline__ int cvt_items(int id) {
    switch (id) { case 0: case 2: case 5: case 12: return IT_W13; case 1: case 3: case 6: case 13: return IT_W2; case 4: case 7: return IT_2048; case 8: return IT_RI; default: return IT_1024; }
}
__device__ __forceinline__ void cvt_range(const Args& a, const Frame& F, int id_lo, int id_hi, int wg_lo, int wg_n) {
    LAS float* scr = (LAS float*)(F.lds + F.wave * 16896);
    int total = 0; for (int id = id_lo; id < id_hi; ++id) total += cvt_items(id);
    const int rank = (int)blockIdx.x - wg_lo; if (rank < 0 || rank >= wg_n) return;
    for (int it = rank * NWAVES + F.wave; it < total; it += wg_n * NWAVES) {
        int r = it, id = id_lo; while (r >= cvt_items(id)) { r -= cvt_items(id); ++id; }
        const CvtDesc d = cvt_desc(a, id); cvt_item(d, r, scr, F.lane);
    }
}

__device__ __forceinline__ void p0_rows(const Args& a, const Frame& F) {
    const float* x = a.in[I_X]; bf16_t* xb = (bf16_t*)(a.ws + WS_XB); float* ss = (float*)(a.ws + WS_SS);
    for (int m = F.gw; m < M; m += 2 * F.NGW) {
        const int m2 = m + F.NGW;
        const bool has2 = m2 < M;
        const f32x4* xr = (const f32x4*)(x + (size_t)m * D) + F.lane; const f32x4* xr2 = (const f32x4*)(x + (size_t)(has2 ? m2 : m) * D) + F.lane;
        f32x4 v[4], v2[4]; float s = 0.f, s2 = 0.f;
#pragma unroll
        for (int j = 0; j < 4; ++j) { v[j] = xr[64 * j]; v2[j] = xr2[64 * j]; }
#pragma unroll
        for (int j = 0; j < 4; ++j) { s += (v[j][0] * v[j][0] + v[j][1] * v[j][1]) + (v[j][2] * v[j][2] + v[j][3] * v[j][3]); s2 += (v2[j][0] * v2[j][0] + v2[j][1] * v2[j][1]) + (v2[j][2] * v2[j][2] + v2[j][3] * v2[j][3]); }
        s = wave_sum(s); s2 = wave_sum(s2);
        u32x2* o = (u32x2*)(xb + (size_t)m * D) + F.lane; u32x2* o2 = (u32x2*)(xb + (size_t)m2 * D) + F.lane;
#pragma unroll
        for (int j = 0; j < 4; ++j) { u32x2 w; w.x = cvt_pk_bf16(v[j][0], v[j][1]); w.y = cvt_pk_bf16(v[j][2], v[j][3]); o[64 * j] = w;
            if (has2) { u32x2 w2; w2.x = cvt_pk_bf16(v2[j][0], v2[j][1]); w2.y = cvt_pk_bf16(v2[j][2], v2[j][3]); o2[64 * j] = w2; } }
        if (F.lane == 0) { ss[m] = s; if (has2) ss[m2] = s2; }
    }
    for (int i = blockIdx.x * NTHR + F.tid; i < 5 * M; i += F.G * NTHR) ss[M + i] = 0.f;
    if (blockIdx.x == 0) for (int c = F.tid; c < D; c += NTHR) { const float l = a.in[I_ALAM][c]; ((float*)(a.ws + WS_SP8))[c] = -8.0f * LOG2E * (fmaxf(-l, 0.f) + log1pf(expf(-fabsf(l)))); }
}

__device__ __forceinline__ void conv_phase(const Args& a, const Frame& F) {
    const bf16_t* rec = (const bf16_t*)(a.ws + WS_REC); bf16_t* xc = (bf16_t*)(a.ws + WS_Y);
    constexpr int CR = 16, NITEM = (M / CR) * 4;
    for (int it = F.gw; it < NITEM; it += F.NGW) {
        const int cq = it & 3, m0 = (it >> 2) * CR, t0 = m0 & (SEQ - 1), ch = cq * 256 + 4 * F.lane;
        f32x4 w[4];
#pragma unroll
        for (int k = 0; k < 4; ++k) w[k] = *(const f32x4*)(a.in[I_ACW] + k * D + ch);
        const f32x4 bv = *(const f32x4*)(a.in[I_ACB] + ch);
        u32x2 rw[CR + 3];
#pragma unroll
        for (int i = 0; i < CR + 3; ++i) { const int r = m0 - 3 + i; rw[i] = (i >= 3 || t0 > 0) ? *(const u32x2*)(rec + (size_t)r * D + ch) : (u32x2){0u, 0u}; }
#pragma unroll
        for (int i = 0; i < CR; ++i) {
            f32x4 y = bv;
#pragma unroll
            for (int k = 0; k < 4; ++k) { const u32x2 q = rw[i + k]; y += w[k] * (f32x4){bf_lo(q.x), bf_hi(q.x), bf_lo(q.y), bf_hi(q.y)}; }
            u32x2 o; o.x = cvt_pk_bf16(y[0], y[1]); o.y = cvt_pk_bf16(y[2], y[3]); *(u32x2*)(xc + (size_t)(m0 + i) * D + ch) = o;
        }
    }
}

constexpr int SC_L = 64, SC_C = SEQ / SC_L;
__device__ __forceinline__ void scan_a(const Args& a, const Frame& F) {
    const bf16_t* av = (const bf16_t*)(a.ws + WS_REC); const bf16_t* uv = (const bf16_t*)(a.ws + WS_U);
    f32x4* hl = (f32x4*)(a.ws + WS_HL); f32x4* pc = (f32x4*)(a.ws + WS_PC);
    if (F.tid >= 256) return;
    for (int item = blockIdx.x * 256 + F.tid; item < BATCH * SC_C * 256; item += F.G * 256) {
        const int cgp = item & 255, bc = item >> 8; const size_t row0 = (size_t)bc * SC_L;
        f32x4 h = {0.f, 0.f, 0.f, 0.f}, p = {1.f, 1.f, 1.f, 1.f};
#pragma unroll 8
        for (int t = 0; t < SC_L; ++t) { const u32x2 aw = *(const u32x2*)(av + (row0 + t) * D + 4 * cgp); const f32x4 aa = {__builtin_amdgcn_exp2f(bf_lo(aw.x)), __builtin_amdgcn_exp2f(bf_hi(aw.x)), __builtin_amdgcn_exp2f(bf_lo(aw.y)), __builtin_amdgcn_exp2f(bf_hi(aw.y))}; const u32x2 uw = *(const u32x2*)(uv + (row0 + t) * D + 4 * cgp);
            const f32x4 uu = {bf_lo(uw.x), bf_hi(uw.x), bf_lo(uw.y), bf_hi(uw.y)}; h = aa * h + uu; p = p * aa; }
        hl[item] = h; pc[item] = p;
    }
}
__device__ __forceinline__ void scan_b(const Args& a, const Frame& F) {
    const bf16_t* av = (const bf16_t*)(a.ws + WS_REC); const bf16_t* uv = (const bf16_t*)(a.ws + WS_U); const bf16_t* gb = (const bf16_t*)(a.ws + WS_GB); bf16_t* yb = (bf16_t*)(a.ws + WS_Y);
    const f32x4* hl = (const f32x4*)(a.ws + WS_HL); const f32x4* pc = (const f32x4*)(a.ws + WS_PC);
    if (F.tid >= 256) return;
    for (int item = blockIdx.x * 256 + F.tid; item < BATCH * SC_C * 256; item += F.G * 256) {
        const int cgp = item & 255, bc = item >> 8, ck = bc & (SC_C - 1), b0 = bc - ck; const size_t row0 = (size_t)bc * SC_L;
        f32x4 h = {0.f, 0.f, 0.f, 0.f};
        int j = 0;
        for (; j + 8 <= ck; j += 8) {
            f32x4 pp[8], hh[8];
#pragma unroll
            for (int e = 0; e < 8; ++e) { pp[e] = pc[(b0 + j + e) * 256 + cgp]; hh[e] = hl[(b0 + j + e) * 256 + cgp]; }
#pragma unroll
            for (int e = 0; e < 8; ++e) h = pp[e] * h + hh[e];
        }
        for (; j < ck; ++j) h = pc[(b0 + j) * 256 + cgp] * h + hl[(b0 + j) * 256 + cgp];
#pragma unroll 8
        for (int t = 0; t < SC_L; ++t) { const size_t off = (row0 + t) * D + 4 * cgp; const u32x2 aw = *(const u32x2*)(av + off); const f32x4 aa = {__builtin_amdgcn_exp2f(bf_lo(aw.x)), __builtin_amdgcn_exp2f(bf_hi(aw.x)), __builtin_amdgcn_exp2f(bf_lo(aw.y)), __builtin_amdgcn_exp2f(bf_hi(aw.y))}; const u32x2 uw = *(const u32x2*)(uv + off);
            const f32x4 uu = {bf_lo(uw.x), bf_hi(uw.x), bf_lo(uw.y), bf_hi(uw.y)}; h = aa * h + uu;
            const u32x2 gw = *(const u32x2*)(gb + off); u32x2 o; o.x = cvt_pk_bf16(h[0] * bf_lo(gw.x), h[1] * bf_hi(gw.x)); o.y = cvt_pk_bf16(h[2] * bf_lo(gw.y), h[3] * bf_hi(gw.y));
            *(u32x2*)(yb + off) = o; }
    }
}

constexpr float SB_TINY = 5.42e-20f;
struct SbFrag { bf16x8 kf[4]; bf16x8 vf[2][2]; };
constexpr int ATT_KSTR = 1088, ATT_VOFF = 4 * ATT_KSTR, ATT_SLOT = ATT_VOFF + 4096, WAVE_LDS = 2 * ATT_SLOT;
__device__ __forceinline__ void sb_dma(LAS unsigned char* slot, const bf16_t* kg, const bf16_t* vg, int k0) {
    const bf16_t* k = kg + (size_t)k0 * D; const bf16_t* v = vg + k0;
#define SB_GLDS(g, o) __builtin_amdgcn_global_load_lds((const unsigned*)(g), (LAS unsigned*)(slot + (o)), 16, 0, 0)
    SB_GLDS(k, 0); SB_GLDS(k + 8 * D, ATT_KSTR); SB_GLDS(k + 16 * D, 2 * ATT_KSTR); SB_GLDS(k + 24 * D, 3 * ATT_KSTR);
    SB_GLDS(v, ATT_VOFF); SB_GLDS(v + (size_t)16 * SEQ, ATT_VOFF + 1024); SB_GLDS(v + (size_t)32 * SEQ, ATT_VOFF + 2048); SB_GLDS(v + (size_t)48 * SEQ, ATT_VOFF + 3072);
#undef SB_GLDS
}
template <int N> __device__ __forceinline__ void sb_wait() { asm volatile("s_waitcnt vmcnt(%0)" :: "n"(N) : "memory"); }
struct SbAddr { int k[4]; int v[4]; };
__device__ __forceinline__ void sb_read(SbFrag& f, const LAS unsigned char* slot, const SbAddr& ad) {
#pragma unroll
    for (int d0 = 0; d0 < 4; ++d0) f.kf[d0] = *(const LAS bf16x8*)(slot + ad.k[d0]);
#pragma unroll
    for (int dh = 0; dh < 2; ++dh)
#pragma unroll
        for (int mm = 0; mm < 2; ++mm) f.vf[dh][mm] = *(const LAS bf16x8*)(slot + ad.v[dh * 2 + mm]);
}
template <bool DIAG> __device__ __forceinline__ void sb_tile(const SbFrag& f, const bf16x8 (&qf)[4], f32x16& o0, f32x16& o1, float& carry, int lim, int hi) {
    f32x16 s;
#pragma unroll
    for (int r = 0; r < 16; ++r) s[r] = 0.f;
#pragma unroll
    for (int d0 = 0; d0 < 4; ++d0) s = __builtin_amdgcn_mfma_f32_32x32x16_bf16(f.kf[d0], qf[d0], s, 0, 0, 0);
    float wv[16]; float run = 1.f;
#pragma unroll
    for (int r = 15; r >= 0; --r) {
        float stay = __builtin_amdgcn_rcpf(1.0f + __builtin_amdgcn_exp2f(s[r]));
        float beta = 1.0f - stay;
        if (DIAG) { const bool ok = r < lim; stay = ok ? stay : 1.0f; beta = ok ? beta : 0.f; }
        wv[r] = beta * run; run *= stay;
    }
    const float other = __shfl_xor(run, 32);
    const float base = carry * (hi == 0 ? other : 1.0f);
    carry *= run * other;
    u32x4 p0, p1;
    p0.x = cvt_pk_bf16(wv[0] * base, wv[1] * base); p0.y = cvt_pk_bf16(wv[2] * base, wv[3] * base); p0.z = cvt_pk_bf16(wv[4] * base, wv[5] * base); p0.w = cvt_pk_bf16(wv[6] * base, wv[7] * base);
    p1.x = cvt_pk_bf16(wv[8] * base, wv[9] * base); p1.y = cvt_pk_bf16(wv[10] * base, wv[11] * base); p1.z = cvt_pk_bf16(wv[12] * base, wv[13] * base); p1.w = cvt_pk_bf16(wv[14] * base, wv[15] * base);
    const bf16x8 pa0 = __builtin_bit_cast(bf16x8, p0), pa1 = __builtin_bit_cast(bf16x8, p1);
    o0 = __builtin_amdgcn_mfma_f32_32x32x16_bf16(pa0, f.vf[0][0], o0, 0, 0, 0); o0 = __builtin_amdgcn_mfma_f32_32x32x16_bf16(pa1, f.vf[0][1], o0, 0, 0, 0);
    o1 = __builtin_amdgcn_mfma_f32_32x32x16_bf16(pa0, f.vf[1][0], o1, 0, 0, 0); o1 = __builtin_amdgcn_mfma_f32_32x32x16_bf16(pa1, f.vf[1][1], o1, 0, 0, 0);
}
__device__ __forceinline__ void sb_unit(const bf16_t* Q, const bf16_t* K, const bf16_t* VT, bf16_t* O, int b, int h, int qb, int lane, LAS unsigned char* slotA, LAS unsigned char* slotB, const SbAddr& ad) {
    const int j = lane & 31, hi = lane >> 5, q0 = qb * 32; const size_t rowbase = (size_t)b * SEQ;
    const bf16_t* qp = Q + (rowbase + q0 + j) * D + h * HD + 8 * hi;
    bf16x8 qf[4];
#pragma unroll
    for (int d0 = 0; d0 < 4; ++d0) qf[d0] = *(const bf16x8*)(qp + 16 * d0);
    const int k8w = lane >> 3, cw = (lane & 7) ^ k8w, aw = lane >> 4, d16w = 4 * ((lane >> 2) & 3) + aw, pw = (lane & 3) ^ aw;
    const bf16_t* kg = K + (rowbase + k8w) * D + h * HD + 8 * cw;
    const bf16_t* vg = VT + ((size_t)(b * NH + h) * HD + d16w) * SEQ + 8 * pw;
    f32x16 o0, o1;
#pragma unroll
    for (int r = 0; r < 16; ++r) { o0[r] = 0.f; o1[r] = 0.f; }
    float carry = 1.f;
    SbFrag f;
    sb_dma(slotA, kg, vg, q0);
    sb_dma(slotB, kg, vg, qb > 0 ? q0 - 32 : 0);
    sb_wait<8>(); sb_read(f, slotA, ad);
    sb_tile<true>(f, qf, o0, o1, carry, j - 16 * hi, hi);
    for (int kt = qb - 1; kt >= 0; kt -= 2) {
        sb_dma(slotA, kg, vg, (kt > 0 ? kt - 1 : 0) * 32);
        sb_wait<8>(); sb_read(f, slotB, ad);
        sb_tile<false>(f, qf, o0, o1, carry, 64, hi);
        if (kt == 0 || __all(carry < SB_TINY)) break;
        sb_dma(slotB, kg, vg, (kt > 1 ? kt - 2 : 0) * 32);
        sb_wait<8>(); sb_read(f, slotA, ad);
        sb_tile<false>(f, qf, o0, o1, carry, 64, hi);
        if (__all(carry < SB_TINY)) break;
    }
    sb_wait<0>();
    bf16_t* op = O + (rowbase + q0) * D + h * HD + j;
#pragma unroll
    for (int r = 0; r < 16; ++r) { const int qr = (r & 3) + 8 * (r >> 2) + 4 * hi;
        op[(size_t)qr * D] = (bf16_t)(cvt_pk_bf16(o0[r], 0.f) & 0xffffu); op[(size_t)qr * D + 32] = (bf16_t)(cvt_pk_bf16(o1[r], 0.f) & 0xffffu); }
}
__device__ __forceinline__ void attn_phase(const Args& a, const Frame& F) {
    const bf16_t* Q = (const bf16_t*)(a.ws + WS_Q); const bf16_t* K = (const bf16_t*)(a.ws + WS_K); const bf16_t* VT = (const bf16_t*)(a.ws + WS_VT); bf16_t* O = (bf16_t*)(a.ws + WS_O);
    constexpr int NQB = SEQ / 32, NU = BATCH * NH * NQB;
    LAS unsigned char* slotA = F.lds + F.wave * WAVE_LDS;
    SbAddr ad;
    { const int j = F.lane & 31, hi = F.lane >> 5, key = 16 * ((j >> 2) & 1) + (j & 3) + 4 * (j >> 3), ki = key >> 3, k8 = key & 7;
#pragma unroll
      for (int d0 = 0; d0 < 4; ++d0) ad.k[d0] = ki * ATT_KSTR + (8 * k8 + ((2 * d0 + hi) ^ k8)) * 16;
#pragma unroll
      for (int dh = 0; dh < 2; ++dh)
#pragma unroll
          for (int mm = 0; mm < 2; ++mm) { const int dd = 32 * dh + j, vi = dd >> 4, d16 = dd & 15, a_ = d16 & 3, b_ = d16 >> 2, p = 2 * hi + mm; ad.v[dh * 2 + mm] = ATT_VOFF + vi * 1024 + (16 * a_ + 4 * b_ + (p ^ a_)) * 16; } }
    for (int u = F.gw; u < NU; u += F.NGW) { const int bh = u / NQB, qb = u % NQB; sb_unit(Q, K, VT, O, bh / NH, bh % NH, qb, F.lane, slotA, slotA + ATT_SLOT, ad); }
}

__global__ void __launch_bounds__(NTHR) fwd_kernel(Args args) {
    extern __shared__ __attribute__((aligned(16))) unsigned char lds_raw[];
    Frame F; F.lds = (LAS unsigned char*)lds_raw; F.tid = threadIdx.x; F.lane = F.tid & 63; F.wave = __builtin_amdgcn_readfirstlane(F.tid >> 6);
    F.G = gridDim.x; F.gw = blockIdx.x * NWAVES + F.wave; F.NGW = F.G * NWAVES;
    unsigned char* ws = args.ws;
    float* ss = (float*)(ws + WS_SS); LAS float* RED = (LAS float*)(F.lds + 131072);
    const int lo = args.ph_lo, hi = args.ph_hi;
#if MK_COOP
    cg::grid_group grid = cg::this_grid();
    volatile LAS unsigned* MISC = (volatile LAS unsigned*)(F.lds + MISC_OFF);
    if (F.tid < 16) MISC[F.tid] = 0u;
    __syncthreads();
    const XcdBarrier xbar = xcd_barrier_post((unsigned*)ws, MISC + 8);
    if (hi > N_PHASES) grid.sync();
#define SEAM(k) do { if (lo <= (k) && (k) + 1 < hi) xcd_barrier(xbar); } while (0)
#else
#define SEAM(k) do { } while (0)
#endif
#ifndef PH_MASK
#define PH_MASK 0x3ffff
#endif
#define IN(k) (((PH_MASK >> (k)) & 1) && lo <= (k) && (k) < hi)
    using namespace pg8;
    bf16_t* XB = (bf16_t*)(ws + WS_XB); bf16_t* ACT = (bf16_t*)(ws + WS_ACT);
    const int bx = blockIdx.x;
#define RUN_GEMM(EPI, ALIGN, Aptr, Bptr, N_, K_, lda_, adiv_, ...) do { Gemm g{(const bf16_t*)(Aptr), (const bf16_t*)(Bptr), M, (N_), (K_), (lda_), (adiv_)}; StaticOrder S; S.init(M, (N_), F.G, bx); \
        EPI E{__VA_ARGS__}; gemm_phase<EPI, ALIGN>(F.lds, g, S, E); } while (0)

#ifndef DUP_MASK
#define DUP_MASK 0
#endif
#if MK_COOP
#define REDO_BAR() xcd_barrier(xbar)
#else
#define REDO_BAR() do { } while (0)
#endif
#define PHASE(k, ...) do { if (IN(k)) { __VA_ARGS__; if ((DUP_MASK >> (k)) & 1) { REDO_BAR(); __VA_ARGS__; } } SEAM(k); } while (0)
    PHASE(0, cvt_range(args, F, 0, 1, 0, F.G); p0_rows(args, F));
    const int T22 = (64 * 22) % F.G, T30 = (64 * 30) % F.G;
    PHASE(1, RUN_GEMM(EpiSwiglu, true, XB, ws + WS_WA13, 2 * FF, D, D, 0, ss, ACT); cvt_range(args, F, 1, 4, T22, F.G - T22); cvt_range(args, F, 7, 10, T22, F.G - T22));
    PHASE(2, RUN_GEMM(EpiResidIn, true, ACT, ws + WS_WA2, D, FF, FF, 0, args.in[I_X], nullptr, XB, ss + M, 0.5f, RED));
    PHASE(3, RUN_GEMM(EpiWin, true, XB, ws + WS_WIN, 2048, D, D, 0, ss + M, (bf16_t*)(ws + WS_GB), (bf16_t*)(ws + WS_REC)));
    PHASE(4, conv_phase(args, F));
    PHASE(5, RUN_GEMM(EpiGate, true, ws + WS_Y, ws + WS_WRI, 2048, 256, D, 2, (const bf16_t*)(ws + WS_Y), args.in[I_ABR], args.in[I_ABI], (const float*)(ws + WS_SP8), (bf16_t*)(ws + WS_REC), (bf16_t*)(ws + WS_U)));
    PHASE(6, scan_a(args, F));
    PHASE(7, scan_b(args, F));
    PHASE(8, RUN_GEMM(EpiResidMid, true, ws + WS_Y, ws + WS_WOUT, D, D, D, 0, nullptr, nullptr, XB, ss + 2 * M, 1.0f, RED));
    PHASE(9, RUN_GEMM(EpiSwiglu, true, XB, ws + WS_WB13, 2 * FF, D, D, 0, ss + 2 * M, ACT); cvt_range(args, F, 4, 7, T22, F.G - T22));
    PHASE(10, RUN_GEMM(EpiResidMid, true, ACT, ws + WS_WB2, D, FF, FF, 0, nullptr, nullptr, XB, ss + 3 * M, 0.5f, RED));
    PHASE(11, RUN_GEMM(EpiKvSwiglu, true, XB, ws + WS_WKV, 2048 + 2 * FF, D, D, 0, ss + 3 * M, args.in[I_KN], (bf16_t*)(ws + WS_K), (bf16_t*)(ws + WS_VT), ACT); cvt_range(args, F, 10, 14, T30, F.G - T30));
    PHASE(12, RUN_GEMM(EpiResidMid, true, ACT, ws + WS_WC2, D, FF, FF, 0, nullptr, nullptr, XB, ss + 4 * M, 0.5f, RED));
    PHASE(13, RUN_GEMM(EpiQ, true, XB, ws + WS_WQ, D, D, D, 0, ss + 4 * M, args.in[I_QN], (bf16_t*)(ws + WS_Q)));
    PHASE(14, attn_phase(args, F));
    PHASE(15, RUN_GEMM(EpiResidMid, true, ws + WS_O, ws + WS_WO, D, D, D, 0, nullptr, nullptr, XB, ss + 5 * M, 1.0f, RED));
    PHASE(16, RUN_GEMM(EpiSwiglu, true, XB, ws + WS_WA13, 2 * FF, D, D, 0, ss + 5 * M, ACT));
    PHASE(17, RUN_GEMM(EpiResidOut, true, ACT, ws + WS_WA2, D, FF, FF, 0, nullptr, args.out, XB, nullptr, 0.5f, RED));
}

extern "C" void kernel_launch(void* const* d_in, const int* in_sizes, int n_in, void* d_out, int out_size, void* d_ws, size_t ws_size, hipStream_t stream) {
    static int grid = 0;
    if (grid == 0) {
        if (n_in != 23 || out_size != M * D || ws_size < WS_END) { fprintf(stderr, "kernel_launch: unexpected problem (n_in %d out %d ws %zu)\n", n_in, out_size, ws_size); grid = -1; return; }
        int dev = 0, cus = 0, per_cu = 0;
        (void)hipGetDevice(&dev); (void)hipDeviceGetAttribute(&cus, hipDeviceAttributeMultiprocessorCount, dev);
        if (hipFuncSetAttribute((const void*)fwd_kernel, hipFuncAttributeMaxDynamicSharedMemorySize, LDS_BYTES) != hipSuccess) { fprintf(stderr, "kernel_launch: hipFuncSetAttribute failed\n"); grid = -1; return; }
        if (hipOccupancyMaxActiveBlocksPerMultiprocessor(&per_cu, (const void*)fwd_kernel, NTHR, LDS_BYTES) != hipSuccess || per_cu < 1) { fprintf(stderr, "kernel_launch: occupancy query says %d\n", per_cu); per_cu = 1; }
        (void)hipGetLastError();
        grid = cus * 1;
        if (grid <= 0) grid = 256;
    }
    if (grid < 0) return;
    Args a{};
    for (int i = 0; i < 23; ++i) a.in[i] = (const float*)d_in[i];
    a.out = (float*)d_out; a.ws = (unsigned char*)d_ws;
#if MK_COOP
    a.ph_lo = 0; a.ph_hi = N_PHASES;
    if (hipMemsetAsync(d_ws, 0, 16 * KiB, stream) != hipSuccess) { fprintf(stderr, "kernel_launch: memset of the barrier words failed\n"); return; }
    void* kargs[] = {&a};
    hipError_t e = hipLaunchCooperativeKernel((const void*)fwd_kernel, dim3(grid), dim3(NTHR), kargs, LDS_BYTES, stream);
    if (e != hipSuccess) fprintf(stderr, "kernel_launch: cooperative launch failed: %s (grid %d)\n", hipGetErrorString(e), grid);
#else
    for (int p = 0; p < N_PHASES; ++p) { a.ph_lo = p; a.ph_hi = p + 1; hipLaunchKernelGGL(fwd_kernel, dim3(grid), dim3(NTHR), LDS_BYTES, stream, a); }
#endif
}
```

```cpp
#include <hip/hip_runtime.h>
#include <hip/hip_cooperative_groups.h>
#include <cstdio>
#include <cstdint>
#include <cmath>
namespace cg = cooperative_groups;

#ifndef MK_COOP
#define MK_COOP 1
#endif

#define LAS __attribute__((address_space(3)))
typedef unsigned short bf16_t;
typedef short bf16x8 __attribute__((ext_vector_type(8)));
typedef float f32x4 __attribute__((ext_vector_type(4)));
typedef float f32x2 __attribute__((ext_vector_type(2)));
typedef float f32x16 __attribute__((ext_vector_type(16)));
typedef unsigned u32x4 __attribute__((ext_vector_type(4)));
typedef unsigned u32x2 __attribute__((ext_vector_type(2)));

constexpr int BATCH = 4, SEQ = 4096, D = 1024, FF = 2816, NH = 16, HD = 64;
constexpr int M = BATCH * SEQ;
constexpr float EPS = 1e-6f;
constexpr float LOG2E = 1.4426950408889634f, LN2 = 0.6931471805599453f;

constexpr size_t MiB = 1u << 20, KiB = 1u << 10;
constexpr size_t WS_SS = 64 * KiB;
constexpr size_t WS_SP8 = 32 * KiB;
constexpr size_t WS_HL = 1 * MiB, WS_PC = 2 * MiB;
constexpr size_t SZ_W13 = (size_t)2 * FF * D * 2, SZ_W2 = (size_t)D * FF * 2;
constexpr size_t WS_WA13 = 4 * MiB, WS_WA2 = WS_WA13 + SZ_W13;
constexpr size_t WS_WB13 = WS_WA2 + SZ_W2, WS_WB2 = WS_WB13 + SZ_W13;
constexpr size_t WS_WKV = WS_WB2 + SZ_W2, WS_WC13 = WS_WKV + 4 * MiB, WS_WC2 = WS_WC13 + SZ_W13;
constexpr size_t WS_WIN = WS_WC2 + SZ_W2, WS_WRI = WS_WIN + 4 * MiB, WS_WOUT = WS_WRI + 1 * MiB, WS_WQ = WS_WOUT + 2 * MiB, WS_WO = WS_WQ + 2 * MiB;
constexpr size_t WS_XB = 69 * MiB;
constexpr size_t WS_ACT = 101 * MiB;
constexpr size_t WS_K = 189 * MiB, WS_VT = 221 * MiB, WS_END = 253 * MiB;
constexpr size_t WS_GB = WS_ACT, WS_U = WS_ACT + 32 * MiB, WS_REC = WS_ACT + 64 * MiB;
constexpr size_t WS_Y = WS_ACT + 96 * MiB;
constexpr size_t WS_Q = WS_ACT, WS_O = WS_ACT + 32 * MiB;
static_assert(WS_WO + 2 * MiB <= WS_XB && WS_REC + 64 * MiB <= WS_END, "ws map");

__device__ __forceinline__ unsigned cvt_pk_bf16(float lo, float hi) {
    typedef __bf16 bf16x2_t __attribute__((ext_vector_type(2)));
    f32x2 v = {lo, hi}; bf16x2_t b = __builtin_convertvector(v, bf16x2_t); return __builtin_bit_cast(unsigned, b);
}
__device__ __forceinline__ float bf_lo(unsigned w) { return __uint_as_float(w << 16); }
__device__ __forceinline__ float bf_hi(unsigned w) { return __uint_as_float(w & 0xffff0000u); }
__device__ __forceinline__ float sigm(float x) { return __builtin_amdgcn_rcpf(1.0f + __builtin_amdgcn_exp2f(-x * LOG2E)); }
__device__ __forceinline__ float gelu_tanh(float x) { return x * sigm(1.5957691216057308f * (x + 0.044715f * x * x * x)); }
__device__ __forceinline__ float wave_sum(float v) {
#pragma unroll
    for (int o = 1; o < 64; o <<= 1) v += __shfl_xor(v, o);
    return v;
}
#define LDS_WAIT() asm volatile("s_waitcnt lgkmcnt(0)" ::: "memory")

namespace pg8 {
constexpr int BM = 256, BK = 64, HALF = 128, HTB = HALF * BK * 2, STAGE_BYTES = 8 * HTB, NXCD = 8, WGM = 4;
__host__ __device__ __forceinline__ int lds_byte(int r, int c) { const int st = (r >> 4) * 2 + (c >> 5), rr = r & 15, cc = c & 31, ob = rr * 64 + cc * 2; return st * 1024 + (ob ^ (((ob >> 9) & 1) << 5)); }
__host__ __device__ __forceinline__ void stage_rc(int b, int& R, int& C) { const int st = b / 1024, sb = b % 1024, swz = sb ^ (((sb >> 9) & 1) << 5); R = (st >> 1) * 16 + swz / 64; C = (st & 1) * 32 + (swz % 64) / 2; }
__host__ __device__ __forceinline__ int perm32(int rho) { const int n = rho >> 4, i = rho & 15; return 8 * (i >> 2) + 4 * n + (i & 3); }

struct Unit { int pm, pn; };
struct Gemm { const bf16_t* A; const bf16_t* Bt; int M, N, K, lda, adiv; };

struct StaticOrder {
    int nM, nN, nwg, G, c;
    __device__ void init(int M_, int N_, int G_, int c_) { nM = M_ / BM; nN = N_ / BM; nwg = nM * nN; G = G_; c = c_; }
    __device__ bool next(int i, Unit& u) const {
        const long L = (long)i * G + c; if (L >= nwg) return false;
        int wgid = (int)L; { const int q = nwg / NXCD, r = nwg % NXCD, xcd = wgid % NXCD, off = wgid / NXCD; wgid = (xcd < r ? xcd * (q + 1) : r * (q + 1) + (xcd - r) * q) + off; }
        const int nig = WGM * nN, gid = wgid / nig, fm = gid * WGM, gsz = (nM - fm) < WGM ? (nM - fm) : WGM;
        u.pm = fm + ((wgid % nig) % gsz); u.pn = (wgid % nig) / gsz; return true;
    }
};

template <class Epi, bool ALIGN_EPI>
__device__ __forceinline__ void gemm_phase(LAS unsigned char* lds, const Gemm g, const StaticOrder& S, const Epi& E) {
    const int tid = threadIdx.x, wid = __builtin_amdgcn_readfirstlane(tid >> 6), lane = tid & 63, wr = wid >> 2, wc = wid & 3, fr = lane & 15, fq = lane >> 4;
    const int K = g.K, nt = K / BK, lda = g.lda;
    unsigned voffA[2], voffB[2];
#pragma unroll
    for (int i = 0; i < 2; ++i) { int R, C; stage_rc(tid * 16 + i * 8192, R, C); const int Rb = (R & ~31) + perm32(R & 31);
        voffA[i] = (unsigned)(R * lda + C) * 2u; voffB[i] = (unsigned)(Rb * K + C) * 2u; }
    const size_t kstep = (size_t)(BK * 2);
    const size_t hA = (size_t)HALF * lda * 2, hB = (size_t)HALF * K * 2;
    const size_t tA = 2 * hA, tB = 2 * hB;
    const unsigned ldsw = (unsigned)wid * 1024u;
    const int aoff = lds_byte(wr * 64 + fr, fq * 8), boff = lds_byte(wc * 32 + fr, fq * 8);
#define PG8_SA(b, h) (((b) * 2 + (h)) * HTB)
#define PG8_SB(b, h) ((4 + (b) * 2 + (h)) * HTB)
#define PG8_STAGE(bufoff, gbase, voff) do { _Pragma("unroll") for (int _i = 0; _i < 2; ++_i) \
        __builtin_amdgcn_global_load_lds((const unsigned*)((const char*)(gbase) + (voff)[_i]), (LAS unsigned*)(lds + (bufoff) + ldsw + _i * 8192), 16, 0, 0); } while (0)
#define PG8_LDA(dst, b, h) do { _Pragma("unroll") for (int m = 0; m < 4; ++m) _Pragma("unroll") for (int k = 0; k < 2; ++k) dst[m][k] = *(const LAS bf16x8*)(lds + PG8_SA(b, h) + aoff + m * 2048 + k * 1024); } while (0)
#define PG8_LDB(dst, b, h) do { _Pragma("unroll") for (int n = 0; n < 2; ++n) _Pragma("unroll") for (int k = 0; k < 2; ++k) dst[n][k] = *(const LAS bf16x8*)(lds + PG8_SB(b, h) + boff + n * 2048 + k * 1024); } while (0)
#define PG8_MMA(ai, bj, At, Bt) do { __builtin_amdgcn_s_setprio(1); _Pragma("unroll") for (int m = 0; m < 4; ++m) _Pragma("unroll") for (int n = 0; n < 2; ++n) _Pragma("unroll") for (int k = 0; k < 2; ++k) \
        acc[ai][bj][m][n] = __builtin_amdgcn_mfma_f32_16x16x32_bf16(Bt[n][k], At[m][k], acc[ai][bj][m][n], 0, 0, 0); __builtin_amdgcn_s_setprio(0); } while (0)
#define PG8_WAIT_V(n) asm volatile("s_waitcnt vmcnt(" #n ")" ::: "memory")
#define PG8_WAIT_L(n) asm volatile("s_waitcnt lgkmcnt(" #n ")" ::: "memory")
#define PG8_BAR __builtin_amdgcn_s_barrier()
#define PG8_SCHED __builtin_amdgcn_sched_barrier(0)
#define PG8_ABASE(u) ((const char*)g.A + (size_t)(u).pm * tA + (g.adiv ? (size_t)((u).pn / g.adiv) * K * 2 : (size_t)0))
#define PG8_BBASE(u) ((const char*)g.Bt + (size_t)(u).pn * tB)
    Unit cur, nxt; int ui = 0;
    if (!S.next(0, cur)) return;
    f32x4 acc[2][2][4][2];
#pragma unroll
    for (int a = 0; a < 2; ++a)
#pragma unroll
        for (int b = 0; b < 2; ++b)
#pragma unroll
            for (int m = 0; m < 4; ++m)
#pragma unroll
                for (int n = 0; n < 2; ++n) acc[a][b][m][n] = (f32x4){0.f, 0.f, 0.f, 0.f};
    bf16x8 At[4][2], B0[2][2], B1[2][2];
    const char* cA = PG8_ABASE(cur); const char* cB = PG8_BBASE(cur);
    PG8_STAGE(PG8_SB(0, 0), cB, voffB); PG8_STAGE(PG8_SB(0, 1), cB + hB, voffB); PG8_STAGE(PG8_SA(0, 0), cA, voffA); PG8_STAGE(PG8_SA(0, 1), cA + hA, voffA);
    if (wr == 1) PG8_BAR;
    PG8_WAIT_V(2); PG8_BAR;
    PG8_STAGE(PG8_SB(1, 0), cB + kstep, voffB); PG8_STAGE(PG8_SA(1, 0), cA + kstep, voffA); PG8_STAGE(PG8_SB(1, 1), cB + hB + kstep, voffB);
    PG8_WAIT_V(6); PG8_BAR;
    for (;;) {
        const bool has_next = S.next(ui + 1, nxt);
        const char* nA = has_next ? PG8_ABASE(nxt) : cA; const char* nB = has_next ? PG8_BBASE(nxt) : cB;
#pragma unroll 1
        for (int t = 0; t < nt; t += 2) {
            const bool last = (t == nt - 2);
            const char* a1 = cA + (size_t)(t + 1) * kstep;
            const char* a2 = last ? nA : cA + (size_t)(t + 2) * kstep; const char* b2 = last ? nB : cB + (size_t)(t + 2) * kstep;
            const char* a3 = a2 + kstep; const char* b3 = b2 + kstep;
            PG8_LDB(B0, 0, 0); PG8_LDB(B1, 0, 1); PG8_SCHED; PG8_LDA(At, 0, 0); PG8_STAGE(PG8_SA(1, 1), a1 + hA, voffA);
            PG8_WAIT_V(8); PG8_WAIT_L(0); PG8_BAR; PG8_MMA(0, 0, At, B0); PG8_MMA(0, 1, At, B1); PG8_BAR; PG8_SCHED;
            PG8_LDA(At, 0, 1); PG8_STAGE(PG8_SB(0, 0), b2, voffB); PG8_STAGE(PG8_SB(0, 1), b2 + hB, voffB); PG8_STAGE(PG8_SA(0, 0), a2, voffA);
            PG8_WAIT_V(8); PG8_WAIT_L(0); PG8_BAR; PG8_MMA(1, 0, At, B0); PG8_MMA(1, 1, At, B1); PG8_BAR; PG8_SCHED;
            PG8_LDB(B0, 1, 0); PG8_LDB(B1, 1, 1); PG8_SCHED; PG8_LDA(At, 1, 0); PG8_STAGE(PG8_SA(0, 1), a2 + hA, voffA);
            PG8_WAIT_V(8); PG8_WAIT_L(0); PG8_BAR; PG8_MMA(0, 0, At, B0); PG8_MMA(0, 1, At, B1); PG8_BAR; PG8_SCHED;
            PG8_LDA(At, 1, 1); PG8_STAGE(PG8_SB(1, 0), b3, voffB); PG8_STAGE(PG8_SB(1, 1), b3 + hB, voffB); PG8_STAGE(PG8_SA(1, 0), a3, voffA);
            PG8_WAIT_V(8); PG8_WAIT_L(0); PG8_BAR; PG8_MMA(1, 0, At, B0); PG8_MMA(1, 1, At, B1); PG8_BAR; PG8_SCHED;
        }
        if constexpr (ALIGN_EPI) { if (wr == 0) PG8_BAR; }
        E(acc, cur, wr, wc, fr, fq);
        if (!has_next) break;
#pragma unroll
        for (int a = 0; a < 2; ++a)
#pragma unroll
            for (int b = 0; b < 2; ++b)
#pragma unroll
                for (int m = 0; m < 4; ++m)
#pragma unroll
                    for (int n = 0; n < 2; ++n) acc[a][b][m][n] = (f32x4){0.f, 0.f, 0.f, 0.f};
        cur = nxt; cA = nA; cB = nB; ++ui;
        if constexpr (ALIGN_EPI) { if (wr == 1) PG8_BAR; }
    }
    PG8_WAIT_V(0);
    if constexpr (!ALIGN_EPI) { if (wr == 0) PG8_BAR; }
    PG8_BAR;
#undef PG8_SA
#undef PG8_SB
#undef PG8_STAGE
#undef PG8_LDA
#undef PG8_LDB
#undef PG8_MMA
#undef PG8_WAIT_V
#undef PG8_WAIT_L
#undef PG8_BAR
#undef PG8_SCHED
#undef PG8_ABASE
#undef PG8_BBASE
}

typedef f32x4 Acc[2][2][4][2];
__device__ __forceinline__ float rstd_of(const float* ss, int row) { return 1.0f / sqrtf(ss[row] * (1.0f / D) + EPS); }

__device__ __forceinline__ void rstd8(const float* ss, int rbase, float (&rs)[2][4]) {
    float t[2][4];
#pragma unroll
    for (int ai = 0; ai < 2; ++ai)
#pragma unroll
        for (int m = 0; m < 4; ++m) t[ai][m] = ss[rbase + ai * HALF + m * 16];
#pragma unroll
    for (int ai = 0; ai < 2; ++ai)
#pragma unroll
        for (int m = 0; m < 4; ++m) rs[ai][m] = __builtin_amdgcn_rsqf(t[ai][m] * (1.0f / D) + EPS);
}
__device__ __forceinline__ void epi_swiglu(const Acc& acc, int pm, int pnf, int wr, int wc, int fr, int fq, const float* ss, bf16_t* act) {
    const int col = pnf * 128 + wc * 32 + 8 * fq;
    float rs8[2][4]; rstd8(ss, pm * BM + wr * 64 + fr, rs8);
#pragma unroll
    for (int ai = 0; ai < 2; ++ai)
#pragma unroll
        for (int m = 0; m < 4; ++m) {
            const int row = pm * BM + ai * HALF + wr * 64 + m * 16 + fr; const float rs = rs8[ai][m];
            float o[8];
#pragma unroll
            for (int n = 0; n < 2; ++n)
#pragma unroll
                for (int j = 0; j < 4; ++j) { const float gt = acc[ai][0][m][n][j] * rs, up = acc[ai][1][m][n][j] * rs; o[n * 4 + j] = gt * sigm(gt) * up; }
            u32x4 w; w.x = cvt_pk_bf16(o[0], o[1]); w.y = cvt_pk_bf16(o[2], o[3]); w.z = cvt_pk_bf16(o[4], o[5]); w.w = cvt_pk_bf16(o[6], o[7]);
            __builtin_nontemporal_store(w, (u32x4*)(act + (size_t)row * FF + col));
        }
}
struct EpiSwiglu { const float* ss; bf16_t* act;
    __device__ __forceinline__ void operator()(const Acc& acc, const Unit& u, int wr, int wc, int fr, int fq) const { epi_swiglu(acc, u.pm, u.pn, wr, wc, fr, fq, ss, act); } };

template <bool IN_F32, bool FINAL> struct EpiResid { const float* xin; float* xout; bf16_t* xb; float* ssn; float alpha; LAS float* red;
    __device__ __forceinline__ void operator()(const Acc& acc, const Unit& u, int wr, int wc, int fr, int fq) const {
        const size_t cbase = (size_t)u.pn * BM + wc * 32 + 8 * fq;
#pragma unroll
        for (int ai = 0; ai < 2; ++ai) {
            f32x4 xr[4][2][2];
#pragma unroll
            for (int m = 0; m < 4; ++m)
#pragma unroll
                for (int bj = 0; bj < 2; ++bj) {
                    const size_t off = (size_t)(u.pm * BM + ai * HALF + wr * 64 + m * 16 + fr) * D + cbase + bj * HALF;
                    if (IN_F32) { xr[m][bj][0] = *(const f32x4*)(xin + off); xr[m][bj][1] = *(const f32x4*)(xin + off + 4); }
                    else { const u32x4 xw = *(const u32x4*)(xb + off); xr[m][bj][0] = __builtin_bit_cast(f32x4, xw); }
                }
#pragma unroll
            for (int m = 0; m < 4; ++m) {
                const int row = u.pm * BM + ai * HALF + wr * 64 + m * 16 + fr; float sq = 0.f;
#pragma unroll
                for (int bj = 0; bj < 2; ++bj) {
                    const size_t off = (size_t)row * D + cbase + bj * HALF;
                    f32x4 x0, x1;
                    if (IN_F32) { x0 = xr[m][bj][0]; x1 = xr[m][bj][1]; }
                    else { const u32x4 xw = __builtin_bit_cast(u32x4, xr[m][bj][0]); x0 = (f32x4){bf_lo(xw.x), bf_hi(xw.x), bf_lo(xw.y), bf_hi(xw.y)}; x1 = (f32x4){bf_lo(xw.z), bf_hi(xw.z), bf_lo(xw.w), bf_hi(xw.w)}; }
                    const f32x4 y0 = x0 + acc[ai][bj][m][0] * alpha, y1 = x1 + acc[ai][bj][m][1] * alpha;
                    if (FINAL) { *(f32x4*)(xout + off) = y0; *(f32x4*)(xout + off + 4) = y1; }
                    else {
                        sq += (y0[0] * y0[0] + y0[1] * y0[1]) + (y0[2] * y0[2] + y0[3] * y0[3]) + (y1[0] * y1[0] + y1[1] * y1[1]) + (y1[2] * y1[2] + y1[3] * y1[3]);
                        u32x4 w; w.x = cvt_pk_bf16(y0[0], y0[1]); w.y = cvt_pk_bf16(y0[2], y0[3]); w.z = cvt_pk_bf16(y1[0], y1[1]); w.w = cvt_pk_bf16(y1[2], y1[3]);
                        *(u32x4*)(xb + off) = w;
                    }
                }
                if (!FINAL) { sq += __shfl_xor(sq, 16); sq += __shfl_xor(sq, 32); if (fq == 0) red[(ai * HALF + wr * 64 + m * 16 + fr) * 4 + wc] = sq; }
            }
        }
        if (!FINAL) {
            asm volatile("s_waitcnt lgkmcnt(0)" ::: "memory"); __builtin_amdgcn_s_barrier(); asm volatile("" ::: "memory");
            const int t = threadIdx.x;
            if (t < BM) { const f32x4 v = ((const LAS f32x4*)red)[t]; atomicAdd(ssn + u.pm * BM + t, (v[0] + v[1]) + (v[2] + v[3])); }
        }
    } };
typedef EpiResid<true, false> EpiResidIn; typedef EpiResid<false, false> EpiResidMid; typedef EpiResid<false, true> EpiResidOut;

struct EpiWin { const float* ss; bf16_t* gb; bf16_t* rec;
    __device__ __forceinline__ void operator()(const Acc& acc, const Unit& u, int wr, int wc, int fr, int fq) const {
        const bool isg = u.pn < 4; const int ct = (u.pn & 3) * BM;
        float rs8[2][4]; rstd8(ss, u.pm * BM + wr * 64 + fr, rs8);
#pragma unroll
        for (int ai = 0; ai < 2; ++ai)
#pragma unroll
            for (int m = 0; m < 4; ++m) {
                const int row = u.pm * BM + ai * HALF + wr * 64 + m * 16 + fr; const float rs = rs8[ai][m];
#pragma unroll
                for (int bj = 0; bj < 2; ++bj) {
                    const size_t off = (size_t)row * D + ct + bj * HALF + wc * 32 + 8 * fq;
                    const f32x4 v0 = acc[ai][bj][m][0] * rs, v1 = acc[ai][bj][m][1] * rs;
                    if (isg) { u32x4 w; w.x = cvt_pk_bf16(gelu_tanh(v0[0]), gelu_tanh(v0[1])); w.y = cvt_pk_bf16(gelu_tanh(v0[2]), gelu_tanh(v0[3]));
                        w.z = cvt_pk_bf16(gelu_tanh(v1[0]), gelu_tanh(v1[1])); w.w = cvt_pk_bf16(gelu_tanh(v1[2]), gelu_tanh(v1[3])); *(u32x4*)(gb + off) = w; }
                    else { u32x4 w; w.x = cvt_pk_bf16(v0[0], v0[1]); w.y = cvt_pk_bf16(v0[2], v0[3]); w.z = cvt_pk_bf16(v1[0], v1[1]); w.w = cvt_pk_bf16(v1[2], v1[3]); *(u32x4*)(rec + off) = w; }
                }
            }
    } };

struct EpiGate { const bf16_t* xc; const float* b_r; const float* b_i; const float* sp8; bf16_t* aout; bf16_t* uout;
    __device__ __forceinline__ void operator()(const Acc& acc, const Unit& u, int wr, int wc, int fr, int fq) const {
        const int ch = u.pn * 128 + wc * 32 + 8 * fq;
        float br[8], bi[8], sp[8];
#pragma unroll
        for (int n = 0; n < 2; ++n) { const f32x4 a_ = *(const f32x4*)(b_r + ch + 4 * n), b_ = *(const f32x4*)(b_i + ch + 4 * n), c_ = *(const f32x4*)(sp8 + ch + 4 * n);
#pragma unroll
            for (int j = 0; j < 4; ++j) { br[4 * n + j] = a_[j]; bi[4 * n + j] = b_[j]; sp[4 * n + j] = c_[j]; } }
        u32x4 xcw[2][4];
#pragma unroll
        for (int ai = 0; ai < 2; ++ai)
#pragma unroll
            for (int m = 0; m < 4; ++m) xcw[ai][m] = *(const u32x4*)(xc + (size_t)(u.pm * BM + ai * HALF + wr * 64 + m * 16 + fr) * D + ch);
#pragma unroll
        for (int ai = 0; ai < 2; ++ai)
#pragma unroll
            for (int m = 0; m < 4; ++m) {
                const int row = u.pm * BM + ai * HALF + wr * 64 + m * 16 + fr; const size_t off = (size_t)row * D + ch;
                const u32x4 xw = xcw[ai][m];
                const float xv[8] = {bf_lo(xw.x), bf_hi(xw.x), bf_lo(xw.y), bf_hi(xw.y), bf_lo(xw.z), bf_hi(xw.z), bf_lo(xw.w), bf_hi(xw.w)};
                float av[8], uv[8];
#pragma unroll
                for (int j = 0; j < 8; ++j) {
                    const float r = sigm(acc[ai][0][m][j >> 2][j & 3] + br[j]), ig = sigm(acc[ai][1][m][j >> 2][j & 3] + bi[j]);
                    const float la2 = r * sp[j];
                    const float a = __builtin_amdgcn_exp2f(la2);
                    av[j] = la2; uv[j] = __builtin_amdgcn_sqrtf(fmaxf(1.0f - a * a, 0.f)) * ig * xv[j];
                }
                u32x4 wa; wa.x = cvt_pk_bf16(av[0], av[1]); wa.y = cvt_pk_bf16(av[2], av[3]); wa.z = cvt_pk_bf16(av[4], av[5]); wa.w = cvt_pk_bf16(av[6], av[7]);
                *(u32x4*)(aout + off) = wa;
                u32x4 w; w.x = cvt_pk_bf16(uv[0], uv[1]); w.y = cvt_pk_bf16(uv[2], uv[3]); w.z = cvt_pk_bf16(uv[4], uv[5]); w.w = cvt_pk_bf16(uv[6], uv[7]);
                *(u32x4*)(uout + off) = w;
            }
    } };

__device__ __forceinline__ void epi_headnorm(const Acc& acc, int pm, int pnh, int wr, int wc, int fr, int fq, const float* ss, const float* gain, float oscale, bf16_t* out) {
    const int head = 4 * pnh + wc;
    float sc[2][4]; rstd8(ss, pm * BM + wr * 64 + fr, sc);
#pragma unroll
    for (int ai = 0; ai < 2; ++ai)
#pragma unroll
        for (int m = 0; m < 4; ++m) {
            const float rs = sc[ai][m];
            float sq = 0.f;
#pragma unroll
            for (int bj = 0; bj < 2; ++bj)
#pragma unroll
                for (int n = 0; n < 2; ++n) { const f32x4 v = acc[ai][bj][m][n]; sq += (v[0] * v[0] + v[1] * v[1]) + (v[2] * v[2] + v[3] * v[3]); }
            sq += __shfl_xor(sq, 16); sq += __shfl_xor(sq, 32);
            sc[ai][m] = rs * oscale * __builtin_amdgcn_rsqf(sq * rs * rs * (1.0f / HD) + EPS);
        }
#pragma unroll
    for (int bj = 0; bj < 2; ++bj) {
        const f32x4 g0 = *(const f32x4*)(gain + 32 * bj + 8 * fq), g1 = *(const f32x4*)(gain + 32 * bj + 8 * fq + 4);
#pragma unroll
        for (int ai = 0; ai < 2; ++ai)
#pragma unroll
            for (int m = 0; m < 4; ++m) {
                const int row = pm * BM + ai * HALF + wr * 64 + m * 16 + fr;
                const f32x4 v0 = acc[ai][bj][m][0] * g0 * sc[ai][m], v1 = acc[ai][bj][m][1] * g1 * sc[ai][m];
                u32x4 w; w.x = cvt_pk_bf16(v0[0], v0[1]); w.y = cvt_pk_bf16(v0[2], v0[3]); w.z = cvt_pk_bf16(v1[0], v1[1]); w.w = cvt_pk_bf16(v1[2], v1[3]);
                *(u32x4*)(out + (size_t)row * D + head * HD + 32 * bj + 8 * fq) = w;
                asm volatile("" ::: "memory");
            }
    }
}
struct EpiQ { const float* ss; const float* gain; bf16_t* q;
    __device__ __forceinline__ void operator()(const Acc& acc, const Unit& u, int wr, int wc, int fr, int fq) const { epi_headnorm(acc, u.pm, u.pn, wr, wc, fr, fq, ss, gain, 0.125f * LOG2E, q); } };
struct EpiKvSwiglu { const float* ss; const float* kgain; bf16_t* kout; bf16_t* vt; bf16_t* act;
    __device__ __forceinline__ void operator()(const Acc& acc, const Unit& u, int wr, int wc, int fr, int fq) const {
        if (u.pn >= 8) { epi_swiglu(acc, u.pm, u.pn - 8, wr, wc, fr, fq, ss, act); return; }
        if (u.pn < 4) { epi_headnorm(acc, u.pm, u.pn, wr, wc, fr, fq, ss, kgain, 1.0f, kout); return; }
        const int head = 4 * (u.pn - 4) + wc;
        float rs8[2][4]; rstd8(ss, u.pm * BM + wr * 64 + fr, rs8);
        const int row0 = u.pm * BM + wr * 64 + fr, b = row0 / SEQ, s0 = row0 % SEQ;
        bf16_t* base = vt + ((size_t)(b * NH + head) * HD + 8 * fq) * SEQ + s0;
#pragma unroll
        for (int bj = 0; bj < 2; ++bj)
#pragma unroll
            for (int j = 0; j < 8; ++j) {
                bf16_t* p = base + (size_t)(32 * bj + j) * SEQ;
#pragma unroll
                for (int ai = 0; ai < 2; ++ai)
#pragma unroll
                    for (int m = 0; m < 4; ++m) p[ai * HALF + m * 16] = (bf16_t)(cvt_pk_bf16(acc[ai][bj][m][j >> 2][j & 3] * rs8[ai][m], 0.f) & 0xffffu);
                asm volatile("" ::: "memory");
            }
    } };
}


#define XB_TMO      128
#define XB_XCNT(j)  (256  + 64 * (j))
#define XB_XSUB(j)  (1280 + 64 * (j))
#define XB_XGEN(j)  (2304 + 64 * (j))
#define XB_TOP      3328
#define XB_TOPGEN   3392
#define XCD_BAR_WORDS 3456
#define XB_SPIN_CAP (1u << 18)
__device__ __forceinline__ unsigned xb_ld(unsigned* p)              { return __hip_atomic_load(p, __ATOMIC_RELAXED, __HIP_MEMORY_SCOPE_AGENT); }
__device__ __forceinline__ unsigned xb_add(unsigned* p, unsigned v) { return __hip_atomic_fetch_add(p, v, __ATOMIC_RELAXED, __HIP_MEMORY_SCOPE_AGENT); }
__device__ __forceinline__ unsigned xb_xcc_id() { return (unsigned)__builtin_amdgcn_s_getreg((3 << 11) | 20) & 0xFu; }
#define XB_SPIN(cond, bar) do { unsigned _sp = 0; while (cond) { __builtin_amdgcn_s_sleep(1); \
    if ((++_sp & 255u) == 0u) { if (xb_ld(&(bar)[XB_TMO])) break; if (_sp > XB_SPIN_CAP) { atomicAdd(&(bar)[XB_TMO], 1u); break; } } } } while (0)
struct XcdBarrier { unsigned* bar; unsigned x; volatile LAS unsigned* st; };
__device__ __forceinline__ XcdBarrier xcd_barrier_post(unsigned* bar, volatile LAS unsigned* st) {
    XcdBarrier b; b.bar = bar; b.x = xb_xcc_id(); b.st = st;
    if (threadIdx.x == 0) (void)xb_add(&bar[XB_XCNT(b.x)], 1u);
    return b;
}
__device__ __forceinline__ void xcd_barrier_complete(unsigned* bar, unsigned x, unsigned& nloc, unsigned& nx) {
    const unsigned G = gridDim.x * gridDim.y * gridDim.z;
    unsigned sum, cnt, mine, sp = 0u;
    for (;;) {
        sum = 0u; cnt = 0u; mine = 0u;
#pragma unroll
        for (unsigned j = 0; j < 16; ++j) { const unsigned c = xb_ld(&bar[XB_XCNT(j)]); sum += c; cnt += (c > 0u) ? 1u : 0u; mine = (j == x) ? c : mine; }
        if (sum == G) break;
        __builtin_amdgcn_s_sleep(1);
        if ((++sp & 255u) == 0u) { if (xb_ld(&bar[XB_TMO])) break; if (sp > XB_SPIN_CAP) { atomicAdd(&bar[XB_TMO], 1u); break; } }
    }
    nloc = mine > 0u ? mine : 1u; nx = cnt > 0u ? cnt : 1u;
}
__device__ __forceinline__ void xcd_barrier(const XcdBarrier& b) {
    asm volatile("s_waitcnt vmcnt(0)" ::: "memory");
    __syncthreads();
    if (threadIdx.x == 0) {
        unsigned* bar = b.bar;
        __builtin_amdgcn_s_waitcnt(0);
        unsigned nloc = b.st[0], nx = b.st[1];
        if (nloc == 0u) { xcd_barrier_complete(bar, b.x, nloc, nx); b.st[0] = nloc; b.st[1] = nx; }
        const unsigned old = xb_add(&bar[XB_XSUB(b.x)], 1u);
        const unsigned gen = old / nloc;
        if (old + 1u == (gen + 1u) * nloc) {
            __builtin_amdgcn_fence(__ATOMIC_RELEASE, "agent");
            asm volatile("s_waitcnt vmcnt(0)" ::: "memory");
            const unsigned og = xb_add(&bar[XB_TOP], 1u);
            const unsigned tg = og / nx;
            if (og + 1u == (tg + 1u) * nx) xb_add(&bar[XB_TOPGEN], 1u);
            else XB_SPIN(xb_ld(&bar[XB_TOPGEN]) == tg, bar);
            __builtin_amdgcn_fence(__ATOMIC_ACQUIRE, "agent");
            xb_add(&bar[XB_XGEN(b.x)], 1u);
            asm volatile("s_waitcnt vmcnt(0)" ::: "memory");
        } else {
            XB_SPIN(xb_ld(&bar[XB_XGEN(b.x)]) == gen, bar);
            __builtin_amdgcn_fence(__ATOMIC_ACQUIRE, "agent");
            asm volatile("s_waitcnt vmcnt(0)" ::: "memory");
        }
    }
    __syncthreads();
}

constexpr int N_PHASES = 18;
constexpr int NWAVES = 8, NTHR = NWAVES * 64;
constexpr int MISC_OFF = 8 * 16896, LDS_BYTES = MISC_OFF + 256;

struct Args { const float* in[23]; float* out; unsigned char* ws; int ph_lo, ph_hi; };

struct Frame { LAS unsigned char* lds; int tid, lane, wave, G, gw, NGW; };

struct CvtDesc { const float* W; const float* W2; bf16_t* dst; const float* gain; int ldw, K, nb, mode; };
constexpr int SCR_STRIDE = 64 * 65 * 4;
__device__ __forceinline__ void cvt_item(const CvtDesc& d, int local, LAS float* scr, int lane) {
    const int kb = local / d.nb, gI = local % d.nb, k0 = 64 * kb, n0 = 64 * gI;
    const int l16 = lane & 15, l4 = lane >> 4, n = n0 + 4 * l16;
    const float* W = d.W; int c0;
    if (d.mode == 0) c0 = n;
    else if (d.mode == 1) { const int tile = n >> 8, bj = (n >> 7) & 1, j0 = n & 127; c0 = bj * FF + tile * 128 + j0; }
    else if (d.mode == 2) { const int pn = n >> 8, bj = (n >> 7) & 1, wc = (n >> 5) & 3, j0 = n & 31; c0 = 256 * pn + 64 * wc + 32 * bj + j0; }
    else { const int t = n >> 8, blk = t >> 1, half = t & 1, which = (n >> 7) & 1, j0 = n & 127; W = (which ? d.W2 : d.W) + (size_t)blk * 65536; c0 = half * 128 + j0; }
    const float* wp = W + (size_t)(k0 + l4) * d.ldw + c0;
    f32x4 v[16];
#pragma unroll
    for (int i = 0; i < 16; ++i) v[i] = *(const f32x4*)(wp + (size_t)(4 * i) * d.ldw);
    if (d.gain) {
#pragma unroll
        for (int i = 0; i < 16; ++i) v[i] *= d.gain[k0 + 4 * i + l4];
    }
#pragma unroll
    for (int i = 0; i < 16; ++i) { LAS float* s = scr + (4 * i + l4) * 65 + 4 * l16; s[0] = v[i][0]; s[1] = v[i][1]; s[2] = v[i][2]; s[3] = v[i][3]; }
    LDS_WAIT(); asm volatile("" ::: "memory");
    const int c = lane & 7;
#pragma unroll
    for (int j = 0; j < 8; ++j) { const int nn = (lane >> 3) + 8 * j; const LAS float* s = scr + (8 * c) * 65 + nn;
        u32x4 o; o.x = cvt_pk_bf16(s[0 * 65], s[1 * 65]); o.y = cvt_pk_bf16(s[2 * 65], s[3 * 65]); o.z = cvt_pk_bf16(s[4 * 65], s[5 * 65]); o.w = cvt_pk_bf16(s[6 * 65], s[7 * 65]);
        *(u32x4*)(d.dst + (size_t)(n0 + nn) * d.K + k0 + 8 * c) = o; }
    LDS_WAIT(); asm volatile("" ::: "memory");
}
enum { I_X = 0, I_F1N, I_F1W13, I_F1W2, I_MIXN, I_AWIN, I_ACW, I_ACB, I_AWR, I_ABR, I_AWI, I_ABI, I_ALAM, I_AWOUT, I_KVN, I_WKV, I_KN, I_BWQ, I_QN, I_BWO, I_F2N, I_F2W13, I_F2W2 };
constexpr int IT_W13 = (D / 64) * (2 * FF / 64), IT_W2 = (FF / 64) * (D / 64), IT_2048 = (D / 64) * (2048 / 64), IT_1024 = (D / 64) * (D / 64), IT_RI = (256 / 64) * (2048 / 64);
__device__ __forceinline__ CvtDesc cvt_desc(const Args& a, int id) {
    unsigned char* ws = a.ws; CvtDesc d; d.W2 = nullptr; d.gain = nullptr;
    switch (id) {
    case 0: d = {a.in[I_F1W13], nullptr, (bf16_t*)(ws + WS_WA13), a.in[I_F1N], 2 * FF, D, 2 * FF / 64, 1}; break;
    case 1: d = {a.in[I_F1W2], nullptr, (bf16_t*)(ws + WS_WA2), nullptr, D, FF, D / 64, 0}; break;
    case 2: d = {a.in[I_F2W13], nullptr, (bf16_t*)(ws + WS_WB13), a.in[I_F2N], 2 * FF, D, 2 * FF / 64, 1}; break;
    case 3: d = {a.in[I_F2W2], nullptr, (bf16_t*)(ws + WS_WB2), nullptr, D, FF, D / 64, 0}; break;
    case 4: d = {a.in[I_WKV], nullptr, (bf16_t*)(ws + WS_WKV), a.in[I_KVN], 2048, D, 2048 / 64, 2}; break;
    case 5: d = {a.in[I_F1W13] + (size_t)D * 2 * FF, nullptr, (bf16_t*)(ws + WS_WC13), a.in[I_F1N] + D, 2 * FF, D, 2 * FF / 64, 1}; break;
    case 6: d = {a.in[I_F1W2] + (size_t)FF * D, nullptr, (bf16_t*)(ws + WS_WC2), nullptr, D, FF, D / 64, 0}; break;
    case 7: d = {a.in[I_AWIN], nullptr, (bf16_t*)(ws + WS_WIN), a.in[I_MIXN], 2048, D, 2048 / 64, 0}; break;
    case 8: d = {a.in[I_AWR], a.in[I_AWI], (bf16_t*)(ws + WS_WRI), nullptr, 256, 256, 2048 / 64, 3}; break;
    case 9: d = {a.in[I_AWOUT], nullptr, (bf16_t*)(ws + WS_WOUT), nullptr, D, D, D / 64, 0}; break;
    case 10: d = {a.in[I_BWQ], nullptr, (bf16_t*)(ws + WS_WQ), a.in[I_MIXN] + D, D, D, D / 64, 2}; break;
    case 11: d = {a.in[I_BWO], nullptr, (bf16_t*)(ws + WS_WO), nullptr, D, D, D / 64, 0}; break;
    case 12: d = {a.in[I_F2W13] + (size_t)D * 2 * FF, nullptr, (bf16_t*)(ws + WS_WA13), a.in[I_F2N] + D, 2 * FF, D, 2 * FF / 64, 1}; break;
    default: d = {a.in[I_F2W2] + (size_t)FF * D, nullptr, (bf16_t*)(ws + WS_WA2), nullptr, D, FF, D / 64, 0}; break;
    }
    return d;
}
__device__ __forceinline__ int cvt_items(int id) {
    switch (id) { case 0: case 2: case 5: case 12: return IT_W13; case 1: case 3: case 6: case 13: return IT_W2; case 4: case 7: return IT_2048; case 8: return IT_RI; default: return IT_1024; }
}
__device__ __forceinline__ void cvt_range(const Args& a, const Frame& F, int id_lo, int id_hi, int wg_lo, int wg_n) {
    LAS float* scr = (LAS float*)(F.lds + F.wave * 16896);
    int total = 0; for (int id = id_lo; id < id_hi; ++id) total += cvt_items(id);
    const int rank = (int)blockIdx.x - wg_lo; if (rank < 0 || rank >= wg_n) return;
    for (int it = rank * NWAVES + F.wave; it < total; it += wg_n * NWAVES) {
        int r = it, id = id_lo; while (r >= cvt_items(id)) { r -= cvt_items(id); ++id; }
        const CvtDesc d = cvt_desc(a, id); cvt_item(d, r, scr, F.lane);
    }
}

__device__ __forceinline__ void p0_rows(const Args& a, const Frame& F) {
    const float* x = a.in[I_X]; bf16_t* xb = (bf16_t*)(a.ws + WS_XB); float* ss = (float*)(a.ws + WS_SS);
    for (int m = F.gw; m < M; m += 2 * F.NGW) {
        const int m2 = m + F.NGW;
        const bool has2 = m2 < M;
        const f32x4* xr = (const f32x4*)(x + (size_t)m * D) + F.lane; const f32x4* xr2 = (const f32x4*)(x + (size_t)(has2 ? m2 : m) * D) + F.lane;
        f32x4 v[4], v2[4]; float s = 0.f, s2 = 0.f;
#pragma unroll
        for (int j = 0; j < 4; ++j) { v[j] = xr[64 * j]; v2[j] = xr2[64 * j]; }
#pragma unroll
        for (int j = 0; j < 4; ++j) { s += (v[j][0] * v[j][0] + v[j][1] * v[j][1]) + (v[j][2] * v[j][2] + v[j][3] * v[j][3]); s2 += (v2[j][0] * v2[j][0] + v2[j][1] * v2[j][1]) + (v2[j][2] * v2[j][2] + v2[j][3] * v2[j][3]); }
        s = wave_sum(s); s2 = wave_sum(s2);
        u32x2* o = (u32x2*)(xb + (size_t)m * D) + F.lane; u32x2* o2 = (u32x2*)(xb + (size_t)m2 * D) + F.lane;
#pragma unroll
        for (int j = 0; j < 4; ++j) { u32x2 w; w.x = cvt_pk_bf16(v[j][0], v[j][1]); w.y = cvt_pk_bf16(v[j][2], v[j][3]); o[64 * j] = w;
            if (has2) { u32x2 w2; w2.x = cvt_pk_bf16(v2[j][0], v2[j][1]); w2.y = cvt_pk_bf16(v2[j][2], v2[j][3]); o2[64 * j] = w2; } }
        if (F.lane == 0) { ss[m] = s; if (has2) ss[m2] = s2; }
    }
    for (int i = blockIdx.x * NTHR + F.tid; i < 5 * M; i += F.G * NTHR) ss[M + i] = 0.f;
    if (blockIdx.x == 0) for (int c = F.tid; c < D; c += NTHR) { const float l = a.in[I_ALAM][c]; ((float*)(a.ws + WS_SP8))[c] = -8.0f * LOG2E * (fmaxf(-l, 0.f) + log1pf(expf(-fabsf(l)))); }
}

__device__ __forceinline__ void conv_phase(const Args& a, const Frame& F) {
    const bf16_t* rec = (const bf16_t*)(a.ws + WS_REC); bf16_t* xc = (bf16_t*)(a.ws + WS_Y);
    constexpr int CR = 16, NITEM = (M / CR) * 4;
    for (int it = F.gw; it < NITEM; it += F.NGW) {
        const int cq = it & 3, m0 = (it >> 2) * CR, t0 = m0 & (SEQ - 1), ch = cq * 256 + 4 * F.lane;
        f32x4 w[4];
#pragma unroll
        for (int k = 0; k < 4; ++k) w[k] = *(const f32x4*)(a.in[I_ACW] + k * D + ch);
        const f32x4 bv = *(const f32x4*)(a.in[I_ACB] + ch);
        u32x2 rw[CR + 3];
#pragma unroll
        for (int i = 0; i < CR + 3; ++i) { const int r = m0 - 3 + i; rw[i] = (i >= 3 || t0 > 0) ? *(const u32x2*)(rec + (size_t)r * D + ch) : (u32x2){0u, 0u}; }
#pragma unroll
        for (int i = 0; i < CR; ++i) {
            f32x4 y = bv;
#pragma unroll
            for (int k = 0; k < 4; ++k) { const u32x2 q = rw[i + k]; y += w[k] * (f32x4){bf_lo(q.x), bf_hi(q.x), bf_lo(q.y), bf_hi(q.y)}; }
            u32x2 o; o.x = cvt_pk_bf16(y[0], y[1]); o.y = cvt_pk_bf16(y[2], y[3]); *(u32x2*)(xc + (size_t)(m0 + i) * D + ch) = o;
        }
    }
}

constexpr int SC_L = 64, SC_C = SEQ / SC_L;
__device__ __forceinline__ void scan_a(const Args& a, const Frame& F) {
    const bf16_t* av = (const bf16_t*)(a.ws + WS_REC); const bf16_t* uv = (const bf16_t*)(a.ws + WS_U);
    f32x4* hl = (f32x4*)(a.ws + WS_HL); f32x4* pc = (f32x4*)(a.ws + WS_PC);
    if (F.tid >= 256) return;
    for (int item = blockIdx.x * 256 + F.tid; item < BATCH * SC_C * 256; item += F.G * 256) {
        const int cgp = item & 255, bc = item >> 8; const size_t row0 = (size_t)bc * SC_L;
        f32x4 h = {0.f, 0.f, 0.f, 0.f}, p = {1.f, 1.f, 1.f, 1.f};
#pragma unroll 8
        for (int t = 0; t < SC_L; ++t) { const u32x2 aw = *(const u32x2*)(av + (row0 + t) * D + 4 * cgp); const f32x4 aa = {__builtin_amdgcn_exp2f(bf_lo(aw.x)), __builtin_amdgcn_exp2f(bf_hi(aw.x)), __builtin_amdgcn_exp2f(bf_lo(aw.y)), __builtin_amdgcn_exp2f(bf_hi(aw.y))}; const u32x2 uw = *(const u32x2*)(uv + (row0 + t) * D + 4 * cgp);
            const f32x4 uu = {bf_lo(uw.x), bf_hi(uw.x), bf_lo(uw.y), bf_hi(uw.y)}; h = aa * h + uu; p = p * aa; }
        hl[item] = h; pc[item] = p;
    }
}
__device__ __forceinline__ void scan_b(const Args& a, const Frame& F) {
    const bf16_t* av = (const bf16_t*)(a.ws + WS_REC); const bf16_t* uv = (const bf16_t*)(a.ws + WS_U); const bf16_t* gb = (const bf16_t*)(a.ws + WS_GB); bf16_t* yb = (bf16_t*)(a.ws + WS_Y);
    const f32x4* hl = (const f32x4*)(a.ws + WS_HL); const f32x4* pc = (const f32x4*)(a.ws + WS_PC);
    if (F.tid >= 256) return;
    for (int item = blockIdx.x * 256 + F.tid; item < BATCH * SC_C * 256; item += F.G * 256) {
        const int cgp = item & 255, bc = item >> 8, ck = bc & (SC_C - 1), b0 = bc - ck; const size_t row0 = (size_t)bc * SC_L;
        f32x4 h = {0.f, 0.f, 0.f, 0.f};
        int j = 0;
        for (; j + 8 <= ck; j += 8) {
            f32x4 pp[8], hh[8];
#pragma unroll
            for (int e = 0; e < 8; ++e) { pp[e] = pc[(b0 + j + e) * 256 + cgp]; hh[e] = hl[(b0 + j + e) * 256 + cgp]; }
#pragma unroll
            for (int e = 0; e < 8; ++e) h = pp[e] * h + hh[e];
        }
        for (; j < ck; ++j) h = pc[(b0 + j) * 256 + cgp] * h + hl[(b0 + j) * 256 + cgp];
#pragma unroll 8
        for (int t = 0; t < SC_L; ++t) { const size_t off = (row0 + t) * D + 4 * cgp; const u32x2 aw = *(const u32x2*)(av + off); const f32x4 aa = {__builtin_amdgcn_exp2f(bf_lo(aw.x)), __builtin_amdgcn_exp2f(bf_hi(aw.x)), __builtin_amdgcn_exp2f(bf_lo(aw.y)), __builtin_amdgcn_exp2f(bf_hi(aw.y))}; const u32x2 uw = *(const u32x2*)(uv + off);
            const f32x4 uu = {bf_lo(uw.x), bf_hi(uw.x), bf_lo(uw.y), bf_hi(uw.y)}; h = aa * h + uu;
            const u32x2 gw = *(const u32x2*)(gb + off); u32x2 o; o.x = cvt_pk_bf16(h[0] * bf_lo(gw.x), h[1] * bf_hi(gw.x)); o.y = cvt_pk_bf16(h[2] * bf_lo(gw.y), h[3] * bf_hi(gw.y));
            *(u32x2*)(yb + off) = o; }
    }
}

constexpr float SB_TINY = 5.42e-20f;
struct SbFrag { bf16x8 kf[4]; bf16x8 vf[2][2]; };
constexpr int ATT_KSTR = 1088, ATT_VOFF = 4 * ATT_KSTR, ATT_SLOT = ATT_VOFF + 4096, WAVE_LDS = 2 * ATT_SLOT;
__device__ __forceinline__ void sb_dma(LAS unsigned char* slot, const bf16_t* kg, const bf16_t* vg, int k0) {
    const bf16_t* k = kg + (size_t)k0 * D; const bf16_t* v = vg + k0;
#define SB_GLDS(g, o) __builtin_amdgcn_global_load_lds((const unsigned*)(g), (LAS unsigned*)(slot + (o)), 16, 0, 0)
    SB_GLDS(k, 0); SB_GLDS(k + 8 * D, ATT_KSTR); SB_GLDS(k + 16 * D, 2 * ATT_KSTR); SB_GLDS(k + 24 * D, 3 * ATT_KSTR);
    SB_GLDS(v, ATT_VOFF); SB_GLDS(v + (size_t)16 * SEQ, ATT_VOFF + 1024); SB_GLDS(v + (size_t)32 * SEQ, ATT_VOFF + 2048); SB_GLDS(v + (size_t)48 * SEQ, ATT_VOFF + 3072);
#undef SB_GLDS
}
template <int N> __device__ __forceinline__ void sb_wait() { asm volatile("s_waitcnt vmcnt(%0)" :: "n"(N) : "memory"); }
struct SbAddr { int k[4]; int v[4]; };
__device__ __forceinline__ void sb_read(SbFrag& f, const LAS unsigned char* slot, const SbAddr& ad) {
#pragma unroll
    for (int d0 = 0; d0 < 4; ++d0) f.kf[d0] = *(const LAS bf16x8*)(slot + ad.k[d0]);
#pragma unroll
    for (int dh = 0; dh < 2; ++dh)
#pragma unroll
        for (int mm = 0; mm < 2; ++mm) f.vf[dh][mm] = *(const LAS bf16x8*)(slot + ad.v[dh * 2 + mm]);
}
template <bool DIAG> __device__ __forceinline__ void sb_tile(const SbFrag& f, const bf16x8 (&qf)[4], f32x16& o0, f32x16& o1, float& carry, int lim, int hi) {
    f32x16 s;
#pragma unroll
    for (int r = 0; r < 16; ++r) s[r] = 0.f;
#pragma unroll
    for (int d0 = 0; d0 < 4; ++d0) s = __builtin_amdgcn_mfma_f32_32x32x16_bf16(f.kf[d0], qf[d0], s, 0, 0, 0);
    float wv[16]; float run = 1.f;
#pragma unroll
    for (int r = 15; r >= 0; --r) {
        float stay = __builtin_amdgcn_rcpf(1.0f + __builtin_amdgcn_exp2f(s[r]));
        float beta = 1.0f - stay;
        if (DIAG) { const bool ok = r < lim; stay = ok ? stay : 1.0f; beta = ok ? beta : 0.f; }
        wv[r] = beta * run; run *= stay;
    }
    const float other = __shfl_xor(run, 32);
    const float base = carry * (hi == 0 ? other : 1.0f);
    carry *= run * other;
    u32x4 p0, p1;
    p0.x = cvt_pk_bf16(wv[0] * base, wv[1] * base); p0.y = cvt_pk_bf16(wv[2] * base, wv[3] * base); p0.z = cvt_pk_bf16(wv[4] * base, wv[5] * base); p0.w = cvt_pk_bf16(wv[6] * base, wv[7] * base);
    p1.x = cvt_pk_bf16(wv[8] * base, wv[9] * base); p1.y = cvt_pk_bf16(wv[10] * base, wv[11] * base); p1.z = cvt_pk_bf16(wv[12] * base, wv[13] * base); p1.w = cvt_pk_bf16(wv[14] * base, wv[15] * base);
    const bf16x8 pa0 = __builtin_bit_cast(bf16x8, p0), pa1 = __builtin_bit_cast(bf16x8, p1);
    o0 = __builtin_amdgcn_mfma_f32_32x32x16_bf16(pa0, f.vf[0][0], o0, 0, 0, 0); o0 = __builtin_amdgcn_mfma_f32_32x32x16_bf16(pa1, f.vf[0][1], o0, 0, 0, 0);
    o1 = __builtin_amdgcn_mfma_f32_32x32x16_bf16(pa0, f.vf[1][0], o1, 0, 0, 0); o1 = __builtin_amdgcn_mfma_f32_32x32x16_bf16(pa1, f.vf[1][1], o1, 0, 0, 0);
}
__device__ __forceinline__ void sb_unit(const bf16_t* Q, const bf16_t* K, const bf16_t* VT, bf16_t* O, int b, int h, int qb, int lane, LAS unsigned char* slotA, LAS unsigned char* slotB, const SbAddr& ad) {
    const int j = lane & 31, hi = lane >> 5, q0 = qb * 32; const size_t rowbase = (size_t)b * SEQ;
    const bf16_t* qp = Q + (rowbase + q0 + j) * D + h * HD + 8 * hi;
    bf16x8 qf[4];
#pragma unroll
    for (int d0 = 0; d0 < 4; ++d0) qf[d0] = *(const bf16x8*)(qp + 16 * d0);
    const int k8w = lane >> 3, cw = (lane & 7) ^ k8w, aw = lane >> 4, d16w = 4 * ((lane >> 2) & 3) + aw, pw = (lane & 3) ^ aw;
    const bf16_t* kg = K + (rowbase + k8w) * D + h * HD + 8 * cw;
    const bf16_t* vg = VT + ((size_t)(b * NH + h) * HD + d16w) * SEQ + 8 * pw;
    f32x16 o0, o1;
#pragma unroll
    for (int r = 0; r < 16; ++r) { o0[r] = 0.f; o1[r] = 0.f; }
    float carry = 1.f;
    SbFrag f;
    sb_dma(slotA, kg, vg, q0);
    sb_dma(slotB, kg, vg, qb > 0 ? q0 - 32 : 0);
    sb_wait<8>(); sb_read(f, slotA, ad);
    sb_tile<true>(f, qf, o0, o1, carry, j - 16 * hi, hi);
    for (int kt = qb - 1; kt >= 0; kt -= 2) {
        sb_dma(slotA, kg, vg, (kt > 0 ? kt - 1 : 0) * 32);
        sb_wait<8>(); sb_read(f, slotB, ad);
        sb_tile<false>(f, qf, o0, o1, carry, 64, hi);
        if (kt == 0 || __all(carry < SB_TINY)) break;
        sb_dma(slotB, kg, vg, (kt > 1 ? kt - 2 : 0) * 32);
        sb_wait<8>(); sb_read(f, slotA, ad);
        sb_tile<false>(f, qf, o0, o1, carry, 64, hi);
        if (__all(carry < SB_TINY)) break;
    }
    sb_wait<0>();
    bf16_t* op = O + (rowbase + q0) * D + h * HD + j;
#pragma unroll
    for (int r = 0; r < 16; ++r) { const int qr = (r & 3) + 8 * (r >> 2) + 4 * hi;
        op[(size_t)qr * D] = (bf16_t)(cvt_pk_bf16(o0[r], 0.f) & 0xffffu); op[(size_t)qr * D + 32] = (bf16_t)(cvt_pk_bf16(o1[r], 0.f) & 0xffffu); }
}
__device__ __forceinline__ void attn_phase(const Args& a, const Frame& F) {
    const bf16_t* Q = (const bf16_t*)(a.ws + WS_Q); const bf16_t* K = (const bf16_t*)(a.ws + WS_K); const bf16_t* VT = (const bf16_t*)(a.ws + WS_VT); bf16_t* O = (bf16_t*)(a.ws + WS_O);
    constexpr int NQB = SEQ / 32, NU = BATCH * NH * NQB;
    LAS unsigned char* slotA = F.lds + F.wave * WAVE_LDS;
    SbAddr ad;
    { const int j = F.lane & 31, hi = F.lane >> 5, key = 16 * ((j >> 2) & 1) + (j & 3) + 4 * (j >> 3), ki = key >> 3, k8 = key & 7;
#pragma unroll
      for (int d0 = 0; d0 < 4; ++d0) ad.k[d0] = ki * ATT_KSTR + (8 * k8 + ((2 * d0 + hi) ^ k8)) * 16;
#pragma unroll
      for (int dh = 0; dh < 2; ++dh)
#pragma unroll
          for (int mm = 0; mm < 2; ++mm) { const int dd = 32 * dh + j, vi = dd >> 4, d16 = dd & 15, a_ = d16 & 3, b_ = d16 >> 2, p = 2 * hi + mm; ad.v[dh * 2 + mm] = ATT_VOFF + vi * 1024 + (16 * a_ + 4 * b_ + (p ^ a_)) * 16; } }
    for (int u = F.gw; u < NU; u += F.NGW) { const int bh = u / NQB, qb = u % NQB; sb_unit(Q, K, VT, O, bh / NH, bh % NH, qb, F.lane, slotA, slotA + ATT_SLOT, ad); }
}

__global__ void __launch_bounds__(NTHR) fwd_kernel(Args args) {
    extern __shared__ __attribute__((aligned(16))) unsigned char lds_raw[];
    Frame F; F.lds = (LAS unsigned char*)lds_raw; F.tid = threadIdx.x; F.lane = F.tid & 63; F.wave = __builtin_amdgcn_readfirstlane(F.tid >> 6);
    F.G = gridDim.x; F.gw = blockIdx.x * NWAVES + F.wave; F.NGW = F.G * NWAVES;
    unsigned char* ws = args.ws;
    float* ss = (float*)(ws + WS_SS); LAS float* RED = (LAS float*)(F.lds + 131072);
    const int lo = args.ph_lo, hi = args.ph_hi;
#if MK_COOP
    cg::grid_group grid = cg::this_grid();
    volatile LAS unsigned* MISC = (volatile LAS unsigned*)(F.lds + MISC_OFF);
    if (F.tid < 16) MISC[F.tid] = 0u;
    __syncthreads();
    const XcdBarrier xbar = xcd_barrier_post((unsigned*)ws, MISC + 8);
    if (hi > N_PHASES) grid.sync();
#define SEAM(k) do { if (lo <= (k) && (k) + 1 < hi) xcd_barrier(xbar); } while (0)
#else
#define SEAM(k) do { } while (0)
#endif
#ifndef PH_MASK
#define PH_MASK 0x3ffff
#endif
#define IN(k) (((PH_MASK >> (k)) & 1) && lo <= (k) && (k) < hi)
    using namespace pg8;
    bf16_t* XB = (bf16_t*)(ws + WS_XB); bf16_t* ACT = (bf16_t*)(ws + WS_ACT);
    const int bx = blockIdx.x;
#define RUN_GEMM(EPI, ALIGN, Aptr, Bptr, N_, K_, lda_, adiv_, ...) do { Gemm g{(const bf16_t*)(Aptr), (const bf16_t*)(Bptr), M, (N_), (K_), (lda_), (adiv_)}; StaticOrder S; S.init(M, (N_), F.G, bx); \
        EPI E{__VA_ARGS__}; gemm_phase<EPI, ALIGN>(F.lds, g, S, E); } while (0)

#ifndef DUP_MASK
#define DUP_MASK 0
#endif
#if MK_COOP
#define REDO_BAR() xcd_barrier(xbar)
#else
#define REDO_BAR() do { } while (0)
#endif
#define PHASE(k, ...) do { if (IN(k)) { __VA_ARGS__; if ((DUP_MASK >> (k)) & 1) { REDO_BAR(); __VA_ARGS__; } } SEAM(k); } while (0)
    PHASE(0, cvt_range(args, F, 0, 1, 0, F.G); p0_rows(args, F));
    const int T22 = (64 * 22) % F.G, T30 = (64 * 30) % F.G;
    PHASE(1, RUN_GEMM(EpiSwiglu, true, XB, ws + WS_WA13, 2 * FF, D, D, 0, ss, ACT); cvt_range(args, F, 1, 4, T22, F.G - T22); cvt_range(args, F, 7, 10, T22, F.G - T22));
    PHASE(2, RUN_GEMM(EpiResidIn, true, ACT, ws + WS_WA2, D, FF, FF, 0, args.in[I_X], nullptr, XB, ss + M, 0.5f, RED));
    PHASE(3, RUN_GEMM(EpiWin, true, XB, ws + WS_WIN, 2048, D, D, 0, ss + M, (bf16_t*)(ws + WS_GB), (bf16_t*)(ws + WS_REC)));
    PHASE(4, conv_phase(args, F));
    PHASE(5, RUN_GEMM(EpiGate, true, ws + WS_Y, ws + WS_WRI, 2048, 256, D, 2, (const bf16_t*)(ws + WS_Y), args.in[I_ABR], args.in[I_ABI], (const float*)(ws + WS_SP8), (bf16_t*)(ws + WS_REC), (bf16_t*)(ws + WS_U)));
    PHASE(6, scan_a(args, F));
    PHASE(7, scan_b(args, F));
    PHASE(8, RUN_GEMM(EpiResidMid, true, ws + WS_Y, ws + WS_WOUT, D, D, D, 0, nullptr, nullptr, XB, ss + 2 * M, 1.0f, RED));
    PHASE(9, RUN_GEMM(EpiSwiglu, true, XB, ws + WS_WB13, 2 * FF, D, D, 0, ss + 2 * M, ACT); cvt_range(args, F, 4, 7, T22, F.G - T22));
    PHASE(10, RUN_GEMM(EpiResidMid, true, ACT, ws + WS_WB2, D, FF, FF, 0, nullptr, nullptr, XB, ss + 3 * M, 0.5f, RED));
    PHASE(11, RUN_GEMM(EpiKvSwiglu, true, XB, ws + WS_WKV, 2048 + 2 * FF, D, D, 0, ss + 3 * M, args.in[I_KN], (bf16_t*)(ws + WS_K), (bf16_t*)(ws + WS_VT), ACT); cvt_range(args, F, 10, 14, T30, F.G - T30));
    PHASE(12, RUN_GEMM(EpiResidMid, true, ACT, ws + WS_WC2, D, FF, FF, 0, nullptr, nullptr, XB, ss + 4 * M, 0.5f, RED));
    PHASE(13, RUN_GEMM(EpiQ, true, XB, ws + WS_WQ, D, D, D, 0, ss + 4 * M, args.in[I_QN], (bf16_t*)(ws + WS_Q)));
    PHASE(14, attn_phase(args, F));
    PHASE(15, RUN_GEMM(EpiResidMid, true, ws + WS_O, ws + WS_WO, D, D, D, 0, nullptr, nullptr, XB, ss + 5 * M, 1.0f, RED));
    PHASE(16, RUN_GEMM(EpiSwiglu, true, XB, ws + WS_WA13, 2 * FF, D, D, 0, ss + 5 * M, ACT));
    PHASE(17, RUN_GEMM(EpiResidOut, true, ACT, ws + WS_WA2, D, FF, FF, 0, nullptr, args.out, XB, nullptr, 0.5f, RED));
}

extern "C" void kernel_launch(void* const* d_in, const int* in_sizes, int n_in, void* d_out, int out_size, void* d_ws, size_t ws_size, hipStream_t stream) {
    static int grid = 0;
    if (grid == 0) {
        if (n_in != 23 || out_size != M * D || ws_size < WS_END) { fprintf(stderr, "kernel_launch: unexpected problem (n_in %d out %d ws %zu)\n", n_in, out_size, ws_size); grid = -1; return; }
        int dev = 0, cus = 0, per_cu = 0;
        (void)hipGetDevice(&dev); (void)hipDeviceGetAttribute(&cus, hipDeviceAttributeMultiprocessorCount, dev);
        if (hipFuncSetAttribute((const void*)fwd_kernel, hipFuncAttributeMaxDynamicSharedMemorySize, LDS_BYTES) != hipSuccess) { fprintf(stderr, "kernel_launch: hipFuncSetAttribute failed\n"); grid = -1; return; }
        if (hipOccupancyMaxActiveBlocksPerMultiprocessor(&per_cu, (const void*)fwd_kernel, NTHR, LDS_BYTES) != hipSuccess || per_cu < 1) { fprintf(stderr, "kernel_launch: occupancy query says %d\n", per_cu); per_cu = 1; }
        (void)hipGetLastError();
        grid = cus * 1;
        if (grid <= 0) grid = 256;
    }
    if (grid < 0) return;
    Args a{};
    for (int i = 0; i < 23; ++i) a.in[i] = (const float*)d_in[i];
    a.out = (float*)d_out; a.ws = (unsigned char*)d_ws;
#if MK_COOP
    a.ph_lo = 0; a.ph_hi = N_PHASES;
    if (hipMemsetAsync(d_ws, 0, 16 * KiB, stream) != hipSuccess) { fprintf(stderr, "kernel_launch: memset of the barrier words failed\n"); return; }
    void* kargs[] = {&a};
    hipError_t e = hipLaunchCooperativeKernel((const void*)fwd_kernel, dim3(grid), dim3(NTHR), kargs, LDS_BYTES, stream);
    if (e != hipSuccess) fprintf(stderr, "kernel_launch: cooperative launch failed: %s (grid %d)\n", hipGetErrorString(e), grid);
#else
    for (int p = 0; p < N_PHASES; ++p) { a.ph_lo = p; a.ph_hi = p + 1; hipLaunchKernelGGL(fwd_kernel, dim3(grid), dim3(NTHR), LDS_BYTES, stream, a); }
#endif
}
```

```cpp
#include <hip/hip_runtime.h>
#include <hip/hip_cooperative_groups.h>
#include <cstdio>
#include <cstdint>
#include <cmath>
namespace cg = cooperative_groups;

#ifndef MK_COOP
#define MK_COOP 1
#endif

#define LAS __attribute__((address_space(3)))
typedef unsigned short bf16_t;
typedef short bf16x8 __attribute__((ext_vector_type(8)));
typedef float f32x4 __attribute__((ext_vector_type(4)));
typedef float f32x2 __attribute__((ext_vector_type(2)));
typedef float f32x16 __attribute__((ext_vector_type(16)));
typedef unsigned u32x4 __attribute__((ext_vector_type(4)));
typedef unsigned u32x2 __attribute__((ext_vector_type(2)));

constexpr int BATCH = 4, SEQ = 4096, D = 1024, FF = 2816, NH = 16, HD = 64;
constexpr int M = BATCH * SEQ;
constexpr float EPS = 1e-6f;
constexpr float LOG2E = 1.4426950408889634f, LN2 = 0.6931471805599453f;

constexpr size_t MiB = 1u << 20, KiB = 1u << 10;
constexpr size_t WS_SS = 64 * KiB;
constexpr size_t WS_SP8 = 32 * KiB;
constexpr size_t WS_HL = 1 * MiB, WS_PC = 2 * MiB;
constexpr size_t SZ_W13 = (size_t)2 * FF * D * 2, SZ_W2 = (size_t)D * FF * 2;
constexpr size_t WS_WA13 = 4 * MiB, WS_WA2 = WS_WA13 + SZ_W13;
constexpr size_t WS_WB13 = WS_WA2 + SZ_W2, WS_WB2 = WS_WB13 + SZ_W13;
constexpr size_t WS_WKV = WS_WB2 + SZ_W2, WS_WC13 = WS_WKV + 4 * MiB, WS_WC2 = WS_WC13 + SZ_W13;
constexpr size_t WS_WIN = WS_WC2 + SZ_W2, WS_WRI = WS_WIN + 4 * MiB, WS_WOUT = WS_WRI + 1 * MiB, WS_WQ = WS_WOUT + 2 * MiB, WS_WO = WS_WQ + 2 * MiB;
constexpr size_t WS_XB = 69 * MiB;
constexpr size_t WS_ACT = 101 * MiB;
constexpr size_t WS_K = 189 * MiB, WS_VT = 221 * MiB, WS_END = 253 * MiB;
constexpr size_t WS_GB = WS_ACT, WS_U = WS_ACT + 32 * MiB, WS_REC = WS_ACT + 64 * MiB;
constexpr size_t WS_Y = WS_ACT + 96 * MiB;
constexpr size_t WS_Q = WS_ACT, WS_O = WS_ACT + 32 * MiB;
static_assert(WS_WO + 2 * MiB <= WS_XB && WS_REC + 64 * MiB <= WS_END, "ws map");

__device__ __forceinline__ unsigned cvt_pk_bf16(float lo, float hi) {
    typedef __bf16 bf16x2_t __attribute__((ext_vector_type(2)));
    f32x2 v = {lo, hi}; bf16x2_t b = __builtin_convertvector(v, bf16x2_t); return __builtin_bit_cast(unsigned, b);
}
__device__ __forceinline__ float bf_lo(unsigned w) { return __uint_as_float(w << 16); }
__device__ __forceinline__ float bf_hi(unsigned w) { return __uint_as_float(w & 0xffff0000u); }
__device__ __forceinline__ float sigm(float x) { return __builtin_amdgcn_rcpf(1.0f + __builtin_amdgcn_exp2f(-x * LOG2E)); }
__device__ __forceinline__ float gelu_tanh(float x) { return x * sigm(1.5957691216057308f * (x + 0.044715f * x * x * x)); }
__device__ __forceinline__ float wave_sum(float v) {
#pragma unroll
    for (int o = 1; o < 64; o <<= 1) v += __shfl_xor(v, o);
    return v;
}
#define LDS_WAIT() asm volatile("s_waitcnt lgkmcnt(0)" ::: "memory")

namespace pg8 {
constexpr int BM = 256, BK = 64, HALF = 128, HTB = HALF * BK * 2, STAGE_BYTES = 8 * HTB, NXCD = 8, WGM = 4;
__host__ __device__ __forceinline__ int lds_byte(int r, int c) { const int st = (r >> 4) * 2 + (c >> 5), rr = r & 15, cc = c & 31, ob = rr * 64 + cc * 2; return st * 1024 + (ob ^ (((ob >> 9) & 1) << 5)); }
__host__ __device__ __forceinline__ void stage_rc(int b, int& R, int& C) { const int st = b / 1024, sb = b % 1024, swz = sb ^ (((sb >> 9) & 1) << 5); R = (st >> 1) * 16 + swz / 64; C = (st & 1) * 32 + (swz % 64) / 2; }
__host__ __device__ __forceinline__ int perm32(int rho) { const int n = rho >> 4, i = rho & 15; return 8 * (i >> 2) + 4 * n + (i & 3); }

struct Unit { int pm, pn; };
struct Gemm { const bf16_t* A; const bf16_t* Bt; int M, N, K, lda, adiv; };

struct StaticOrder {
    int nM, nN, nwg, G, c;
    __device__ void init(int M_, int N_, int G_, int c_) { nM = M_ / BM; nN = N_ / BM; nwg = nM * nN; G = G_; c = c_; }
    __device__ bool next(int i, Unit& u) const {
        const long L = (long)i * G + c; if (L >= nwg) return false;
        int wgid = (int)L; { const int q = nwg / NXCD, r = nwg % NXCD, xcd = wgid % NXCD, off = wgid / NXCD; wgid = (xcd < r ? xcd * (q + 1) : r * (q + 1) + (xcd - r) * q) + off; }
        const int nig = WGM * nN, gid = wgid / nig, fm = gid * WGM, gsz = (nM - fm) < WGM ? (nM - fm) : WGM;
        u.pm = fm + ((wgid % nig) % gsz); u.pn = (wgid % nig) / gsz; return true;
    }
};

template <class Epi, bool ALIGN_EPI>
__device__ __forceinline__ void gemm_phase(LAS unsigned char* lds, const Gemm g, const StaticOrder& S, const Epi& E) {
    const int tid = threadIdx.x, wid = __builtin_amdgcn_readfirstlane(tid >> 6), lane = tid & 63, wr = wid >> 2, wc = wid & 3, fr = lane & 15, fq = lane >> 4;
    const int K = g.K, nt = K / BK, lda = g.lda;
    unsigned voffA[2], voffB[2];
#pragma unroll
    for (int i = 0; i < 2; ++i) { int R, C; stage_rc(tid * 16 + i * 8192, R, C); const int Rb = (R & ~31) + perm32(R & 31);
        voffA[i] = (unsigned)(R * lda + C) * 2u; voffB[i] = (unsigned)(Rb * K + C) * 2u; }
    const size_t kstep = (size_t)(BK * 2);
    const size_t hA = (size_t)HALF * lda * 2, hB = (size_t)HALF * K * 2;
    const size_t tA = 2 * hA, tB = 2 * hB;
    const unsigned ldsw = (unsigned)wid * 1024u;
    const int aoff = lds_byte(wr * 64 + fr, fq * 8), boff = lds_byte(wc * 32 + fr, fq * 8);
#define PG8_SA(b, h) (((b) * 2 + (h)) * HTB)
#define PG8_SB(b, h) ((4 + (b) * 2 + (h)) * HTB)
#define PG8_STAGE(bufoff, gbase, voff) do { _Pragma("unroll") for (int _i = 0; _i < 2; ++_i) \
        __builtin_amdgcn_global_load_lds((const unsigned*)((const char*)(gbase) + (voff)[_i]), (LAS unsigned*)(lds + (bufoff) + ldsw + _i * 8192), 16, 0, 0); } while (0)
#define PG8_LDA(dst, b, h) do { _Pragma("unroll") for (int m = 0; m < 4; ++m) _Pragma("unroll") for (int k = 0; k < 2; ++k) dst[m][k] = *(const LAS bf16x8*)(lds + PG8_SA(b, h) + aoff + m * 2048 + k * 1024); } while (0)
#define PG8_LDB(dst, b, h) do { _Pragma("unroll") for (int n = 0; n < 2; ++n) _Pragma("unroll") for (int k = 0; k < 2; ++k) dst[n][k] = *(const LAS bf16x8*)(lds + PG8_SB(b, h) + boff + n * 2048 + k * 1024); } while (0)
#define PG8_MMA(ai, bj, At, Bt) do { __builtin_amdgcn_s_setprio(1); _Pragma("unroll") for (int m = 0; m < 4; ++m) _Pragma("unroll") for (int n = 0; n < 2; ++n) _Pragma("unroll") for (int k = 0; k < 2; ++k) \
        acc[ai][bj][m][n] = __builtin_amdgcn_mfma_f32_16x16x32_bf16(Bt[n][k], At[m][k], acc[ai][bj][m][n], 0, 0, 0); __builtin_amdgcn_s_setprio(0); } while (0)
#define PG8_WAIT_V(n) asm volatile("s_waitcnt vmcnt(" #n ")" ::: "memory")
#define PG8_WAIT_L(n) asm volatile("s_waitcnt lgkmcnt(" #n ")" ::: "memory")
#define PG8_BAR __builtin_amdgcn_s_barrier()
#define PG8_SCHED __builtin_amdgcn_sched_barrier(0)
#define PG8_ABASE(u) ((const char*)g.A + (size_t)(u).pm * tA + (g.adiv ? (size_t)((u).pn / g.adiv) * K * 2 : (size_t)0))
#define PG8_BBASE(u) ((const char*)g.Bt + (size_t)(u).pn * tB)
    Unit cur, nxt; int ui = 0;
    if (!S.next(0, cur)) return;
    f32x4 acc[2][2][4][2];
#pragma unroll
    for (int a = 0; a < 2; ++a)
#pragma unroll
        for (int b = 0; b < 2; ++b)
#pragma unroll
            for (int m = 0; m < 4; ++m)
#pragma unroll
                for (int n = 0; n < 2; ++n) acc[a][b][m][n] = (f32x4){0.f, 0.f, 0.f, 0.f};
    bf16x8 At[4][2], B0[2][2], B1[2][2];
    const char* cA = PG8_ABASE(cur); const char* cB = PG8_BBASE(cur);
    PG8_STAGE(PG8_SB(0, 0), cB, voffB); PG8_STAGE(PG8_SB(0, 1), cB + hB, voffB); PG8_STAGE(PG8_SA(0, 0), cA, voffA); PG8_STAGE(PG8_SA(0, 1), cA + hA, voffA);
    if (wr == 1) PG8_BAR;
    PG8_WAIT_V(2); PG8_BAR;
    PG8_STAGE(PG8_SB(1, 0), cB + kstep, voffB); PG8_STAGE(PG8_SA(1, 0), cA + kstep, voffA); PG8_STAGE(PG8_SB(1, 1), cB + hB + kstep, voffB);
    PG8_WAIT_V(6); PG8_BAR;
    for (;;) {
        const bool has_next = S.next(ui + 1, nxt);
        const char* nA = has_next ? PG8_ABASE(nxt) : cA; const char* nB = has_next ? PG8_BBASE(nxt) : cB;
#pragma unroll 1
        for (int t = 0; t < nt; t += 2) {
            const bool last = (t == nt - 2);
            const char* a1 = cA + (size_t)(t + 1) * kstep;
            const char* a2 = last ? nA : cA + (size_t)(t + 2) * kstep; const char* b2 = last ? nB : cB + (size_t)(t + 2) * kstep;
            const char* a3 = a2 + kstep; const char* b3 = b2 + kstep;
            PG8_LDB(B0, 0, 0); PG8_LDB(B1, 0, 1); PG8_SCHED; PG8_LDA(At, 0, 0); PG8_STAGE(PG8_SA(1, 1), a1 + hA, voffA);
            PG8_WAIT_V(8); PG8_WAIT_L(0); PG8_BAR; PG8_MMA(0, 0, At, B0); PG8_MMA(0, 1, At, B1); PG8_BAR; PG8_SCHED;
            PG8_LDA(At, 0, 1); PG8_STAGE(PG8_SB(0, 0), b2, voffB); PG8_STAGE(PG8_SB(0, 1), b2 + hB, voffB); PG8_STAGE(PG8_SA(0, 0), a2, voffA);
            PG8_WAIT_V(8); PG8_WAIT_L(0); PG8_BAR; PG8_MMA(1, 0, At, B0); PG8_MMA(1, 1, At, B1); PG8_BAR; PG8_SCHED;
            PG8_LDB(B0, 1, 0); PG8_LDB(B1, 1, 1); PG8_SCHED; PG8_LDA(At, 1, 0); PG8_STAGE(PG8_SA(0, 1), a2 + hA, voffA);
            PG8_WAIT_V(8); PG8_WAIT_L(0); PG8_BAR; PG8_MMA(0, 0, At, B0); PG8_MMA(0, 1, At, B1); PG8_BAR; PG8_SCHED;
            PG8_LDA(At, 1, 1); PG8_STAGE(PG8_SB(1, 0), b3, voffB); PG8_STAGE(PG8_SB(1, 1), b3 + hB, voffB); PG8_STAGE(PG8_SA(1, 0), a3, voffA);
            PG8_WAIT_V(8); PG8_WAIT_L(0); PG8_BAR; PG8_MMA(1, 0, At, B0); PG8_MMA(1, 1, At, B1); PG8_BAR; PG8_SCHED;
        }
        if constexpr (ALIGN_EPI) { if (wr == 0) PG8_BAR; }
        E(acc, cur, wr, wc, fr, fq);
        if (!has_next) break;
#pragma unroll
        for (int a = 0; a < 2; ++a)
#pragma unroll
            for (int b = 0; b < 2; ++b)
#pragma unroll
                for (int m = 0; m < 4; ++m)
#pragma unroll
                    for (int n = 0; n < 2; ++n) acc[a][b][m][n] = (f32x4){0.f, 0.f, 0.f, 0.f};
        cur = nxt; cA = nA; cB = nB; ++ui;
        if constexpr (ALIGN_EPI) { if (wr == 1) PG8_BAR; }
    }
    PG8_WAIT_V(0);
    if constexpr (!ALIGN_EPI) { if (wr == 0) PG8_BAR; }
    PG8_BAR;
#undef PG8_SA
#undef PG8_SB
#undef PG8_STAGE
#undef PG8_LDA
#undef PG8_LDB
#undef PG8_MMA
#undef PG8_WAIT_V
#undef PG8_WAIT_L
#undef PG8_BAR
#undef PG8_SCHED
#undef PG8_ABASE
#undef PG8_BBASE
}

typedef f32x4 Acc[2][2][4][2];
__device__ __forceinline__ float rstd_of(const float* ss, int row) { return 1.0f / sqrtf(ss[row] * (1.0f / D) + EPS); }

__device__ __forceinline__ void rstd8(const float* ss, int rbase, float (&rs)[2][4]) {
    float t[2][4];
#pragma unroll
    for (int ai = 0; ai < 2; ++ai)
#pragma unroll
        for (int m = 0; m < 4; ++m) t[ai][m] = ss[rbase + ai * HALF + m * 16];
#pragma unroll
    for (int ai = 0; ai < 2; ++ai)
#pragma unroll
        for (int m = 0; m < 4; ++m) rs[ai][m] = __builtin_amdgcn_rsqf(t[ai][m] * (1.0f / D) + EPS);
}
__device__ __forceinline__ void epi_swiglu(const Acc& acc, int pm, int pnf, int wr, int wc, int fr, int fq, const float* ss, bf16_t* act) {
    const int col = pnf * 128 + wc * 32 + 8 * fq;
    float rs8[2][4]; rstd8(ss, pm * BM + wr * 64 + fr, rs8);
#pragma unroll
    for (int ai = 0; ai < 2; ++ai)
#pragma unroll
        for (int m = 0; m < 4; ++m) {
            const int row = pm * BM + ai * HALF + wr * 64 + m * 16 + fr; const float rs = rs8[ai][m];
            float o[8];
#pragma unroll
            for (int n = 0; n < 2; ++n)
#pragma unroll
                for (int j = 0; j < 4; ++j) { const float gt = acc[ai][0][m][n][j] * rs, up = acc[ai][1][m][n][j] * rs; o[n * 4 + j] = gt * sigm(gt) * up; }
            u32x4 w; w.x = cvt_pk_bf16(o[0], o[1]); w.y = cvt_pk_bf16(o[2], o[3]); w.z = cvt_pk_bf16(o[4], o[5]); w.w = cvt_pk_bf16(o[6], o[7]);
            __builtin_nontemporal_store(w, (u32x4*)(act + (size_t)row * FF + col));
        }
}
struct EpiSwiglu { const float* ss; bf16_t* act;
    __device__ __forceinline__ void operator()(const Acc& acc, const Unit& u, int wr, int wc, int fr, int fq) const { epi_swiglu(acc, u.pm, u.pn, wr, wc, fr, fq, ss, act); } };

template <bool IN_F32, bool FINAL> struct EpiResid { const float* xin; float* xout; bf16_t* xb; float* ssn; float alpha; LAS float* red;
    __device__ __forceinline__ void operator()(const Acc& acc, const Unit& u, int wr, int wc, int fr, int fq) const {
        const size_t cbase = (size_t)u.pn * BM + wc * 32 + 8 * fq;
#pragma unroll
        for (int ai = 0; ai < 2; ++ai) {
            f32x4 xr[4][2][2];
#pragma unroll
            for (int m = 0; m < 4; ++m)
#pragma unroll
                for (int bj = 0; bj < 2; ++bj) {
                    const size_t off = (size_t)(u.pm * BM + ai * HALF + wr * 64 + m * 16 + fr) * D + cbase + bj * HALF;
                    if (IN_F32) { xr[m][bj][0] = *(const f32x4*)(xin + off); xr[m][bj][1] = *(const f32x4*)(xin + off + 4); }
                    else { const u32x4 xw = *(const u32x4*)(xb + off); xr[m][bj][0] = __builtin_bit_cast(f32x4, xw); }
                }
#pragma unroll
            for (int m = 0; m < 4; ++m) {
                const int row = u.pm * BM + ai * HALF + wr * 64 + m * 16 + fr; float sq = 0.f;
#pragma unroll
                for (int bj = 0; bj < 2; ++bj) {
                    const size_t off = (size_t)row * D + cbase + bj * HALF;
                    f32x4 x0, x1;
                    if (IN_F32) { x0 = xr[m][bj][0]; x1 = xr[m][bj][1]; }
                    else { const u32x4 xw = __builtin_bit_cast(u32x4, xr[m][bj][0]); x0 = (f32x4){bf_lo(xw.x), bf_hi(xw.x), bf_lo(xw.y), bf_hi(xw.y)}; x1 = (f32x4){bf_lo(xw.z), bf_hi(xw.z), bf_lo(xw.w), bf_hi(xw.w)}; }
                    const f32x4 y0 = x0 + acc[ai][bj][m][0] * alpha, y1 = x1 + acc[ai][bj][m][1] * alpha;
                    if (FINAL) { *(f32x4*)(xout + off) = y0; *(f32x4*)(xout + off + 4) = y1; }
                    else {
                        sq += (y0[0] * y0[0] + y0[1] * y0[1]) + (y0[2] * y0[2] + y0[3] * y0[3]) + (y1[0] * y1[0] + y1[1] * y1[1]) + (y1[2] * y1[2] + y1[3] * y1[3]);
                        u32x4 w; w.x = cvt_pk_bf16(y0[0], y0[1]); w.y = cvt_pk_bf16(y0[2], y0[3]); w.z = cvt_pk_bf16(y1[0], y1[1]); w.w = cvt_pk_bf16(y1[2], y1[3]);
                        *(u32x4*)(xb + off) = w;
                    }
                }
                if (!FINAL) { sq += __shfl_xor(sq, 16); sq += __shfl_xor(sq, 32); if (fq == 0) red[(ai * HALF + wr * 64 + m * 16 + fr) * 4 + wc] = sq; }
            }
        }
        if (!FINAL) {
            asm volatile("s_waitcnt lgkmcnt(0)" ::: "memory"); __builtin_amdgcn_s_barrier(); asm volatile("" ::: "memory");
            const int t = threadIdx.x;
            if (t < BM) { const f32x4 v = ((const LAS f32x4*)red)[t]; atomicAdd(ssn + u.pm * BM + t, (v[0] + v[1]) + (v[2] + v[3])); }
        }
    } };
typedef EpiResid<true, false> EpiResidIn; typedef EpiResid<false, false> EpiResidMid; typedef EpiResid<false, true> EpiResidOut;

struct EpiWin { const float* ss; bf16_t* gb; bf16_t* rec;
    __device__ __forceinline__ void operator()(const Acc& acc, const Unit& u, int wr, int wc, int fr, int fq) const {
        const bool isg = u.pn < 4; const int ct = (u.pn & 3) * BM;
        float rs8[2][4]; rstd8(ss, u.pm * BM + wr * 64 + fr, rs8);
#pragma unroll
        for (int ai = 0; ai < 2; ++ai)
#pragma unroll
            for (int m = 0; m < 4; ++m) {
                const int row = u.pm * BM + ai * HALF + wr * 64 + m * 16 + fr; const float rs = rs8[ai][m];
#pragma unroll
                for (int bj = 0; bj < 2; ++bj) {
                    const size_t off = (size_t)row * D + ct + bj * HALF + wc * 32 + 8 * fq;
                    const f32x4 v0 = acc[ai][bj][m][0] * rs, v1 = acc[ai][bj][m][1] * rs;
                    if (isg) { u32x4 w; w.x = cvt_pk_bf16(gelu_tanh(v0[0]), gelu_tanh(v0[1])); w.y = cvt_pk_bf16(gelu_tanh(v0[2]), gelu_tanh(v0[3]));
                        w.z = cvt_pk_bf16(gelu_tanh(v1[0]), gelu_tanh(v1[1])); w.w = cvt_pk_bf16(gelu_tanh(v1[2]), gelu_tanh(v1[3])); *(u32x4*)(gb + off) = w; }
                    else { u32x4 w; w.x = cvt_pk_bf16(v0[0], v0[1]); w.y = cvt_pk_bf16(v0[2], v0[3]); w.z = cvt_pk_bf16(v1[0], v1[1]); w.w = cvt_pk_bf16(v1[2], v1[3]); *(u32x4*)(rec + off) = w; }
                }
            }
    } };

struct EpiGate { const bf16_t* xc; const float* b_r; const float* b_i; const float* sp8; bf16_t* aout; bf16_t* uout;
    __device__ __forceinline__ void operator()(const Acc& acc, const Unit& u, int wr, int wc, int fr, int fq) const {
        const int ch = u.pn * 128 + wc * 32 + 8 * fq;
        float br[8], bi[8], sp[8];
#pragma unroll
        for (int n = 0; n < 2; ++n) { const f32x4 a_ = *(const f32x4*)(b_r + ch + 4 * n), b_ = *(const f32x4*)(b_i + ch + 4 * n), c_ = *(const f32x4*)(sp8 + ch + 4 * n);
#pragma unroll
            for (int j = 0; j < 4; ++j) { br[4 * n + j] = a_[j]; bi[4 * n + j] = b_[j]; sp[4 * n + j] = c_[j]; } }
        u32x4 xcw[2][4];
#pragma unroll
        for (int ai = 0; ai < 2; ++ai)
#pragma unroll
            for (int m = 0; m < 4; ++m) xcw[ai][m] = *(const u32x4*)(xc + (size_t)(u.pm * BM + ai * HALF + wr * 64 + m * 16 + fr) * D + ch);
#pragma unroll
        for (int ai = 0; ai < 2; ++ai)
#pragma unroll
            for (int m = 0; m < 4; ++m) {
                const int row = u.pm * BM + ai * HALF + wr * 64 + m * 16 + fr; const size_t off = (size_t)row * D + ch;
                const u32x4 xw = xcw[ai][m];
                const float xv[8] = {bf_lo(xw.x), bf_hi(xw.x), bf_lo(xw.y), bf_hi(xw.y), bf_lo(xw.z), bf_hi(xw.z), bf_lo(xw.w), bf_hi(xw.w)};
                float av[8], uv[8];
#pragma unroll
                for (int j = 0; j < 8; ++j) {
                    const float r = sigm(acc[ai][0][m][j >> 2][j & 3] + br[j]), ig = sigm(acc[ai][1][m][j >> 2][j & 3] + bi[j]);
                    const float la2 = r * sp[j];
                    const float a = __builtin_amdgcn_exp2f(la2);
                    av[j] = la2; uv[j] = __builtin_amdgcn_sqrtf(fmaxf(1.0f - a * a, 0.f)) * ig * xv[j];
                }
                u32x4 wa; wa.x = cvt_pk_bf16(av[0], av[1]); wa.y = cvt_pk_bf16(av[2], av[3]); wa.z = cvt_pk_bf16(av[4], av[5]); wa.w = cvt_pk_bf16(av[6], av[7]);
                *(u32x4*)(aout + off) = wa;
                u32x4 w; w.x = cvt_pk_bf16(uv[0], uv[1]); w.y = cvt_pk_bf16(uv[2], uv[3]); w.z = cvt_pk_bf16(uv[4], uv[5]); w.w = cvt_pk_bf16(uv[6], uv[7]);
                *(u32x4*)(uout + off) = w;
            }
    } };

__device__ __forceinline__ void epi_headnorm(const Acc& acc, int pm, int pnh, int wr, int wc, int fr, int fq, const float* ss, const float* gain, float oscale, bf16_t* out) {
    const int head = 4 * pnh + wc;
    float sc[2][4]; rstd8(ss, pm * BM + wr * 64 + fr, sc);
#pragma unroll
    for (int ai = 0; ai < 2; ++ai)
#pragma unroll
        for (int m = 0; m < 4; ++m) {
            const float rs = sc[ai][m];
            float sq = 0.f;
#pragma unroll
            for (int bj = 0; bj < 2; ++bj)
#pragma unroll
                for (int n = 0; n < 2; ++n) { const f32x4 v = acc[ai][bj][m][n]; sq += (v[0] * v[0] + v[1] * v[1]) + (v[2] * v[2] + v[3] * v[3]); }
            sq += __shfl_xor(sq, 16); sq += __shfl_xor(sq, 32);
            sc[ai][m] = rs * oscale * __builtin_amdgcn_rsqf(sq * rs * rs * (1.0f / HD) + EPS);
        }
#pragma unroll
    for (int bj = 0; bj < 2; ++bj) {
        const f32x4 g0 = *(const f32x4*)(gain + 32 * bj + 8 * fq), g1 = *(const f32x4*)(gain + 32 * bj + 8 * fq + 4);
#pragma unroll
        for (int ai = 0; ai < 2; ++ai)
#pragma unroll
            for (int m = 0; m < 4; ++m) {
                const int row = pm * BM + ai * HALF + wr * 64 + m * 16 + fr;
                const f32x4 v0 = acc[ai][bj][m][0] * g0 * sc[ai][m], v1 = acc[ai][bj][m][1] * g1 * sc[ai][m];
                u32x4 w; w.x = cvt_pk_bf16(v0[0], v0[1]); w.y = cvt_pk_bf16(v0[2], v0[3]); w.z = cvt_pk_bf16(v1[0], v1[1]); w.w = cvt_pk_bf16(v1[2], v1[3]);
                *(u32x4*)(out + (size_t)row * D + head * HD + 32 * bj + 8 * fq) = w;
                asm volatile("" ::: "memory");
            }
    }
}
struct EpiQ { const float* ss; const float* gain; bf16_t* q;
    __device__ __forceinline__ void operator()(const Acc& acc, const Unit& u, int wr, int wc, int fr, int fq) const { epi_headnorm(acc, u.pm, u.pn, wr, wc, fr, fq, ss, gain, 0.125f * LOG2E, q); } };
struct EpiKvSwiglu { const float* ss; const float* kgain; bf16_t* kout; bf16_t* vt; bf16_t* act;
    __device__ __forceinline__ void operator()(const Acc& acc, const Unit& u, int wr, int wc, int fr, int fq) const {
        if (u.pn >= 8) { epi_swiglu(acc, u.pm, u.pn - 8, wr, wc, fr, fq, ss, act); return; }
        if (u.pn < 4) { epi_headnorm(acc, u.pm, u.pn, wr, wc, fr, fq, ss, kgain, 1.0f, kout); return; }
        const int head = 4 * (u.pn - 4) + wc;
        float rs8[2][4]; rstd8(ss, u.pm * BM + wr * 64 + fr, rs8);
        const int row0 = u.pm * BM + wr * 64 + fr, b = row0 / SEQ, s0 = row0 % SEQ;
        bf16_t* base = vt + ((size_t)(b * NH + head) * HD + 8 * fq) * SEQ + s0;
#pragma unroll
        for (int bj = 0; bj < 2; ++bj)
#pragma unroll
            for (int j = 0; j < 8; ++j) {
                bf16_t* p = base + (size_t)(32 * bj + j) * SEQ;
#pragma unroll
                for (int ai = 0; ai < 2; ++ai)
#pragma unroll
                    for (int m = 0; m < 4; ++m) p[ai * HALF + m * 16] = (bf16_t)(cvt_pk_bf16(acc[ai][bj][m][j >> 2][j & 3] * rs8[ai][m], 0.f) & 0xffffu);
                asm volatile("" ::: "memory");
            }
    } };
}


#define XB_TMO      128
#define XB_XCNT(j)  (256  + 64 * (j))
#define XB_XSUB(j)  (1280 + 64 * (j))
#define XB_XGEN(j)  (2304 + 64 * (j))
#define XB_TOP      3328
#define XB_TOPGEN   3392
#define XCD_BAR_WORDS 3456
#define XB_SPIN_CAP (1u << 18)
__device__ __forceinline__ unsigned xb_ld(unsigned* p)              { return __hip_atomic_load(p, __ATOMIC_RELAXED, __HIP_MEMORY_SCOPE_AGENT); }
__device__ __forceinline__ unsigned xb_add(unsigned* p, unsigned v) { return __hip_atomic_fetch_add(p, v, __ATOMIC_RELAXED, __HIP_MEMORY_SCOPE_AGENT); }
__device__ __forceinline__ unsigned xb_xcc_id() { return (unsigned)__builtin_amdgcn_s_getreg((3 << 11) | 20) & 0xFu; }
#define XB_SPIN(cond, bar) do { unsigned _sp = 0; while (cond) { __builtin_amdgcn_s_sleep(1); \
    if ((++_sp & 255u) == 0u) { if (xb_ld(&(bar)[XB_TMO])) break; if (_sp > XB_SPIN_CAP) { atomicAdd(&(bar)[XB_TMO], 1u); break; } } } } while (0)
struct XcdBarrier { unsigned* bar; unsigned x; volatile LAS unsigned* st; };
__device__ __forceinline__ XcdBarrier xcd_barrier_post(unsigned* bar, volatile LAS unsigned* st) {
    XcdBarrier b; b.bar = bar; b.x = xb_xcc_id(); b.st = st;
    if (threadIdx.x == 0) (void)xb_add(&bar[XB_XCNT(b.x)], 1u);
    return b;
}
__device__ __forceinline__ void xcd_barrier_complete(unsigned* bar, unsigned x, unsigned& nloc, unsigned& nx) {
    const unsigned G = gridDim.x * gridDim.y * gridDim.z;
    unsigned sum, cnt, mine, sp = 0u;
    for (;;) {
        sum = 0u; cnt = 0u; mine = 0u;
#pragma unroll
        for (unsigned j = 0; j < 16; ++j) { const unsigned c = xb_ld(&bar[XB_XCNT(j)]); sum += c; cnt += (c > 0u) ? 1u : 0u; mine = (j == x) ? c : mine; }
        if (sum == G) break;
        __builtin_amdgcn_s_sleep(1);
        if ((++sp & 255u) == 0u) { if (xb_ld(&bar[XB_TMO])) break; if (sp > XB_SPIN_CAP) { atomicAdd(&bar[XB_TMO], 1u); break; } }
    }
    nloc = mine > 0u ? mine : 1u; nx = cnt > 0u ? cnt : 1u;
}
__device__ __forceinline__ void xcd_barrier(const XcdBarrier& b) {
    asm volatile("s_waitcnt vmcnt(0)" ::: "memory");
    __syncthreads();
    if (threadIdx.x == 0) {
        unsigned* bar = b.bar;
        __builtin_amdgcn_s_waitcnt(0);
        unsigned nloc = b.st[0], nx = b.st[1];
        if (nloc == 0u) { xcd_barrier_complete(bar, b.x, nloc, nx); b.st[0] = nloc; b.st[1] = nx; }
        const unsigned old = xb_add(&bar[XB_XSUB(b.x)], 1u);
        const unsigned gen = old / nloc;
        if (old + 1u == (gen + 1u) * nloc) {
            __builtin_amdgcn_fence(__ATOMIC_RELEASE, "agent");
            asm volatile("s_waitcnt vmcnt(0)" ::: "memory");
            const unsigned og = xb_add(&bar[XB_TOP], 1u);
            const unsigned tg = og / nx;
            if (og + 1u == (tg + 1u) * nx) xb_add(&bar[XB_TOPGEN], 1u);
            else XB_SPIN(xb_ld(&bar[XB_TOPGEN]) == tg, bar);
            __builtin_amdgcn_fence(__ATOMIC_ACQUIRE, "agent");
            xb_add(&bar[XB_XGEN(b.x)], 1u);
            asm volatile("s_waitcnt vmcnt(0)" ::: "memory");
        } else {
            XB_SPIN(xb_ld(&bar[XB_XGEN(b.x)]) == gen, bar);
            __builtin_amdgcn_fence(__ATOMIC_ACQUIRE, "agent");
            asm volatile("s_waitcnt vmcnt(0)" ::: "memory");
        }
    }
    __syncthreads();
}

constexpr int N_PHASES = 18;
constexpr int NWAVES = 8, NTHR = NWAVES * 64;
constexpr int MISC_OFF = 8 * 16896, LDS_BYTES = MISC_OFF + 256;

struct Args { const float* in[23]; float* out; unsigned char* ws; int ph_lo, ph_hi; };

struct Frame { LAS unsigned char* lds; int tid, lane, wave, G, gw, NGW; };

struct CvtDesc { const float* W; const float* W2; bf16_t* dst; const float* gain; int ldw, K, nb, mode; };
constexpr int SCR_STRIDE = 64 * 65 * 4;
__device__ __forceinline__ void cvt_item(const CvtDesc& d, int local, LAS float* scr, int lane) {
    const int kb = local / d.nb, gI = local % d.nb, k0 = 64 * kb, n0 = 64 * gI;
    const int l16 = lane & 15, l4 = lane >> 4, n = n0 + 4 * l16;
    const float* W = d.W; int c0;
    if (d.mode == 0) c0 = n;
    else if (d.mode == 1) { const int tile = n >> 8, bj = (n >> 7) & 1, j0 = n & 127; c0 = bj * FF + tile * 128 + j0; }
    else if (d.mode == 2) { const int pn = n >> 8, bj = (n >> 7) & 1, wc = (n >> 5) & 3, j0 = n & 31; c0 = 256 * pn + 64 * wc + 32 * bj + j0; }
    else { const int t = n >> 8, blk = t >> 1, half = t & 1, which = (n >> 7) & 1, j0 = n & 127; W = (which ? d.W2 : d.W) + (size_t)blk * 65536; c0 = half * 128 + j0; }
    const float* wp = W + (size_t)(k0 + l4) * d.ldw + c0;
    f32x4 v[16];
#pragma unroll
    for (int i = 0; i < 16; ++i) v[i] = *(const f32x4*)(wp + (size_t)(4 * i) * d.ldw);
    if (d.gain) {
#pragma unroll
        for (int i = 0; i < 16; ++i) v[i] *= d.gain[k0 + 4 * i + l4];
    }
#pragma unroll
    for (int i = 0; i < 16; ++i) { LAS float* s = scr + (4 * i + l4) * 65 + 4 * l16; s[0] = v[i][0]; s[1] = v[i][1]; s[2] = v[i][2]; s[3] = v[i][3]; }
    LDS_WAIT(); asm volatile("" ::: "memory");
    const int c = lane & 7;
#pragma unroll
    for (int j = 0; j < 8; ++j) { const int nn = (lane >> 3) + 8 * j; const LAS float* s = scr + (8 * c) * 65 + nn;
        u32x4 o; o.x = cvt_pk_bf16(s[0 * 65], s[1 * 65]); o.y = cvt_pk_bf16(s[2 * 65], s[3 * 65]); o.z = cvt_pk_bf16(s[4 * 65], s[5 * 65]); o.w = cvt_pk_bf16(s[6 * 65], s[7 * 65]);
        *(u32x4*)(d.dst + (size_t)(n0 + nn) * d.K + k0 + 8 * c) = o; }
    LDS_WAIT(); asm volatile("" ::: "memory");
}
enum { I_X = 0, I_F1N, I_F1W13, I_F1W2, I_MIXN, I_AWIN, I_ACW, I_ACB, I_AWR, I_ABR, I_AWI, I_ABI, I_ALAM, I_AWOUT, I_KVN, I_WKV, I_KN, I_BWQ, I_QN, I_BWO, I_F2N, I_F2W13, I_F2W2 };
constexpr int IT_W13 = (D / 64) * (2 * FF / 64), IT_W2 = (FF / 64) * (D / 64), IT_2048 = (D / 64) * (2048 / 64), IT_1024 = (D / 64) * (D / 64), IT_RI = (256 / 64) * (2048 / 64);
__device__ __forceinline__ CvtDesc cvt_desc(const Args& a, int id) {
    unsigned char* ws = a.ws; CvtDesc d; d.W2 = nullptr; d.gain = nullptr;
    switch (id) {
    case 0: d = {a.in[I_F1W13], nullptr, (bf16_t*)(ws + WS_WA13), a.in[I_F1N], 2 * FF, D, 2 * FF / 64, 1}; break;
    case 1: d = {a.in[I_F1W2], nullptr, (bf16_t*)(ws + WS_WA2), nullptr, D, FF, D / 64, 0}; break;
    case 2: d = {a.in[I_F2W13], nullptr, (bf16_t*)(ws + WS_WB13), a.in[I_F2N], 2 * FF, D, 2 * FF / 64, 1}; break;
    case 3: d = {a.in[I_F2W2], nullptr, (bf16_t*)(ws + WS_WB2), nullptr, D, FF, D / 64, 0}; break;
    case 4: d = {a.in[I_WKV], nullptr, (bf16_t*)(ws + WS_WKV), a.in[I_KVN], 2048, D, 2048 / 64, 2}; break;
    case 5: d = {a.in[I_F1W13] + (size_t)D * 2 * FF, nullptr, (bf16_t*)(ws + WS_WC13), a.in[I_F1N] + D, 2 * FF, D, 2 * FF / 64, 1}; break;
    case 6: d = {a.in[I_F1W2] + (size_t)FF * D, nullptr, (bf16_t*)(ws + WS_WC2), nullptr, D, FF, D / 64, 0}; break;
    case 7: d = {a.in[I_AWIN], nullptr, (bf16_t*)(ws + WS_WIN), a.in[I_MIXN], 2048, D, 2048 / 64, 0}; break;
    case 8: d = {a.in[I_AWR], a.in[I_AWI], (bf16_t*)(ws + WS_WRI), nullptr, 256, 256, 2048 / 64, 3}; break;
    case 9: d = {a.in[I_AWOUT], nullptr, (bf16_t*)(ws + WS_WOUT), nullptr, D, D, D / 64, 0}; break;
    case 10: d = {a.in[I_BWQ], nullptr, (bf16_t*)(ws + WS_WQ), a.in[I_MIXN] + D, D, D, D / 64, 2}; break;
    case 11: d = {a.in[I_BWO], nullptr, (bf16_t*)(ws + WS_WO), nullptr, D, D, D / 64, 0}; break;
    case 12: d = {a.in[I_F2W13] + (size_t)D * 2 * FF, nullptr, (bf16_t*)(ws + WS_WA13), a.in[I_F2N] + D, 2 * FF, D, 2 * FF / 64, 1}; break;
    default: d = {a.in[I_F2W2] + (size_t)FF * D, nullptr, (bf16_t*)(ws + WS_WA2), nullptr, D, FF, D / 64, 0}; break;
    }
    return d;
}
__device__ __forceinline__ int cvt_items(int id) {
    switch (id) { case 0: case 2: case 5: case 12: return IT_W13; case 1: case 3: case 6: case 13: return IT_W2; case 4: case 7: return IT_2048; case 8: return IT_RI; default: return IT_1024; }
}
__device__ __forceinline__ void cvt_range(const Args& a, const Frame& F, int id_lo, int id_hi, int wg_lo, int wg_n) {
    LAS float* scr = (LAS float*)(F.lds + F.wave * 16896);
    int total = 0; for (int id = id_lo; id < id_hi; ++id) total += cvt_items(id);
    const int rank = (int)blockIdx.x - wg_lo; if (rank < 0 || rank >= wg_n) return;
    for (int it = rank * NWAVES + F.wave; it < total; it += wg_n * NWAVES) {
        int r = it, id = id_lo; while (r >= cvt_items(id)) { r -= cvt_items(id); ++id; }
        const CvtDesc d = cvt_desc(a, id); cvt_item(d, r, scr, F.lane);
    }
}

__device__ __forceinline__ void p0_rows(const Args& a, const Frame& F) {
    const float* x = a.in[I_X]; bf16_t* xb = (bf16_t*)(a.ws + WS_XB); float* ss = (float*)(a.ws + WS_SS);
    for (int m = F.gw; m < M; m += 2 * F.NGW) {
        const int m2 = m + F.NGW;
        const bool has2 = m2 < M;
        const f32x4* xr = (const f32x4*)(x + (size_t)m * D) + F.lane; const f32x4* xr2 = (const f32x4*)(x + (size_t)(has2 ? m2 : m) * D) + F.lane;
        f32x4 v[4], v2[4]; float s = 0.f, s2 = 0.f;
#pragma unroll
        for (int j = 0; j < 4; ++j) { v[j] = xr[64 * j]; v2[j] = xr2[64 * j]; }
#pragma unroll
        for (int j = 0; j < 4; ++j) { s += (v[j][0] * v[j][0] + v[j][1] * v[j][1]) + (v[j][2] * v[j][2] + v[j][3] * v[j][3]); s2 += (v2[j][0] * v2[j][0] + v2[j][1] * v2[j][1]) + (v2[j][2] * v2[j][2] + v2[j][3] * v2[j][3]); }
        s = wave_sum(s); s2 = wave_sum(s2);
        u32x2* o = (u32x2*)(xb + (size_t)m * D) + F.lane; u32x2* o2 = (u32x2*)(xb + (size_t)m2 * D) + F.lane;
#pragma unroll
        for (int j = 0; j < 4; ++j) { u32x2 w; w.x = cvt_pk_bf16(v[j][0], v[j][1]); w.y = cvt_pk_bf16(v[j][2], v[j][3]); o[64 * j] = w;
            if (has2) { u32x2 w2; w2.x = cvt_pk_bf16(v2[j][0], v2[j][1]); w2.y = cvt_pk_bf16(v2[j][2], v2[j][3]); o2[64 * j] = w2; } }
        if (F.lane == 0) { ss[m] = s; if (has2) ss[m2] = s2; }
    }
    for (int i = blockIdx.x * NTHR + F.tid; i < 5 * M; i += F.G * NTHR) ss[M + i] = 0.f;
    if (blockIdx.x == 0) for (int c = F.tid; c < D; c += NTHR) { const float l = a.in[I_ALAM][c]; ((float*)(a.ws + WS_SP8))[c] = -8.0f * LOG2E * (fmaxf(-l, 0.f) + log1pf(expf(-fabsf(l)))); }
}

__device__ __forceinline__ void conv_phase(const Args& a, const Frame& F) {
    const bf16_t* rec = (const bf16_t*)(a.ws + WS_REC); bf16_t* xc = (bf16_t*)(a.ws + WS_Y);
    constexpr int CR = 16, NITEM = (M / CR) * 4;
    for (int it = F.gw; it < NITEM; it += F.NGW) {
        const int cq = it & 3, m0 = (it >> 2) * CR, t0 = m0 & (SEQ - 1), ch = cq * 256 + 4 * F.lane;
        f32x4 w[4];
#pragma unroll
        for (int k = 0; k < 4; ++k) w[k] = *(const f32x4*)(a.in[I_ACW] + k * D + ch);
        const f32x4 bv = *(const f32x4*)(a.in[I_ACB] + ch);
        u32x2 rw[CR + 3];
#pragma unroll
        for (int i = 0; i < CR + 3; ++i) { const int r = m0 - 3 + i; rw[i] = (i >= 3 || t0 > 0) ? *(const u32x2*)(rec + (size_t)r * D + ch) : (u32x2){0u, 0u}; }
#pragma unroll
        for (int i = 0; i < CR; ++i) {
            f32x4 y = bv;
#pragma unroll
            for (int k = 0; k < 4; ++k) { const u32x2 q = rw[i + k]; y += w[k] * (f32x4){bf_lo(q.x), bf_hi(q.x), bf_lo(q.y), bf_hi(q.y)}; }
            u32x2 o; o.x = cvt_pk_bf16(y[0], y[1]); o.y = cvt_pk_bf16(y[2], y[3]); *(u32x2*)(xc + (size_t)(m0 + i) * D + ch) = o;
        }
    }
}

constexpr int SC_L = 64, SC_C = SEQ / SC_L;
__device__ __forceinline__ void scan_a(const Args& a, const Frame& F) {
    const bf16_t* av = (const bf16_t*)(a.ws + WS_REC); const bf16_t* uv = (const bf16_t*)(a.ws + WS_U);
    f32x4* hl = (f32x4*)(a.ws + WS_HL); f32x4* pc = (f32x4*)(a.ws + WS_PC);
    if (F.tid >= 256) return;
    for (int item = blockIdx.x * 256 + F.tid; item < BATCH * SC_C * 256; item += F.G * 256) {
        const int cgp = item & 255, bc = item >> 8; const size_t row0 = (size_t)bc * SC_L;
        f32x4 h = {0.f, 0.f, 0.f, 0.f}, p = {1.f, 1.f, 1.f, 1.f};
#pragma unroll 8
        for (int t = 0; t < SC_L; ++t) { const u32x2 aw = *(const u32x2*)(av + (row0 + t) * D + 4 * cgp); const f32x4 aa = {__builtin_amdgcn_exp2f(bf_lo(aw.x)), __builtin_amdgcn_exp2f(bf_hi(aw.x)), __builtin_amdgcn_exp2f(bf_lo(aw.y)), __builtin_amdgcn_exp2f(bf_hi(aw.y))}; const u32x2 uw = *(const u32x2*)(uv + (row0 + t) * D + 4 * cgp);
            const f32x4 uu = {bf_lo(uw.x), bf_hi(uw.x), bf_lo(uw.y), bf_hi(uw.y)}; h = aa * h + uu; p = p * aa; }
        hl[item] = h; pc[item] = p;
    }
}
__device__ __forceinline__ void scan_b(const Args& a, const Frame& F) {
    const bf16_t* av = (const bf16_t*)(a.ws + WS_REC); const bf16_t* uv = (const bf16_t*)(a.ws + WS_U); const bf16_t* gb = (const bf16_t*)(a.ws + WS_GB); bf16_t* yb = (bf16_t*)(a.ws + WS_Y);
    const f32x4* hl = (const f32x4*)(a.ws + WS_HL); const f32x4* pc = (const f32x4*)(a.ws + WS_PC);
    if (F.tid >= 256) return;
    for (int item = blockIdx.x * 256 + F.tid; item < BATCH * SC_C * 256; item += F.G * 256) {
        const int cgp = item & 255, bc = item >> 8, ck = bc & (SC_C - 1), b0 = bc - ck; const size_t row0 = (size_t)bc * SC_L;
        f32x4 h = {0.f, 0.f, 0.f, 0.f};
        int j = 0;
        for (; j + 8 <= ck; j += 8) {
            f32x4 pp[8], hh[8];
#pragma unroll
            for (int e = 0; e < 8; ++e) { pp[e] = pc[(b0 + j + e) * 256 + cgp]; hh[e] = hl[(b0 + j + e) * 256 + cgp]; }
#pragma unroll
            for (int e = 0; e < 8; ++e) h = pp[e] * h + hh[e];
        }
        for (; j < ck; ++j) h = pc[(b0 + j) * 256 + cgp] * h + hl[(b0 + j) * 256 + cgp];
#pragma unroll 8
        for (int t = 0; t < SC_L; ++t) { const size_t off = (row0 + t) * D + 4 * cgp; const u32x2 aw = *(const u32x2*)(av + off); const f32x4 aa = {__builtin_amdgcn_exp2f(bf_lo(aw.x)), __builtin_amdgcn_exp2f(bf_hi(aw.x)), __builtin_amdgcn_exp2f(bf_lo(aw.y)), __builtin_amdgcn_exp2f(bf_hi(aw.y))}; const u32x2 uw = *(const u32x2*)(uv + off);
            const f32x4 uu = {bf_lo(uw.x), bf_hi(uw.x), bf_lo(uw.y), bf_hi(uw.y)}; h = aa * h + uu;
            const u32x2 gw = *(const u32x2*)(gb + off); u32x2 o; o.x = cvt_pk_bf16(h[0] * bf_lo(gw.x), h[1] * bf_hi(gw.x)); o.y = cvt_pk_bf16(h[2] * bf_lo(gw.y), h[3] * bf_hi(gw.y));
            *(u32x2*)(yb + off) = o; }
    }
}

constexpr float SB_TINY = 5.42e-20f;
struct SbFrag { bf16x8 kf[4]; bf16x8 vf[2][2]; };
constexpr int ATT_KSTR = 1088, ATT_VOFF = 4 * ATT_KSTR, ATT_SLOT = ATT_VOFF + 4096, WAVE_LDS = 2 * ATT_SLOT;
__device__ __forceinline__ void sb_dma(LAS unsigned char* slot, const bf16_t* kg, const bf16_t* vg, int k0) {
    const bf16_t* k = kg + (size_t)k0 * D; const bf16_t* v = vg + k0;
#define SB_GLDS(g, o) __builtin_amdgcn_global_load_lds((const unsigned*)(g), (LAS unsigned*)(slot + (o)), 16, 0, 0)
    SB_GLDS(k, 0); SB_GLDS(k + 8 * D, ATT_KSTR); SB_GLDS(k + 16 * D, 2 * ATT_KSTR); SB_GLDS(k + 24 * D, 3 * ATT_KSTR);
    SB_GLDS(v, ATT_VOFF); SB_GLDS(v + (size_t)16 * SEQ, ATT_VOFF + 1024); SB_GLDS(v + (size_t)32 * SEQ, ATT_VOFF + 2048); SB_GLDS(v + (size_t)48 * SEQ, ATT_VOFF + 3072);
#undef SB_GLDS
}
template <int N> __device__ __forceinline__ void sb_wait() { asm volatile("s_waitcnt vmcnt(%0)" :: "n"(N) : "memory"); }
struct SbAddr { int k[4]; int v[4]; };
__device__ __forceinline__ void sb_read(SbFrag& f, const LAS unsigned char* slot, const SbAddr& ad) {
#pragma unroll
    for (int d0 = 0; d0 < 4; ++d0) f.kf[d0] = *(const LAS bf16x8*)(slot + ad.k[d0]);
#pragma unroll
    for (int dh = 0; dh < 2; ++dh)
#pragma unroll
        for (int mm = 0; mm < 2; ++mm) f.vf[dh][mm] = *(const LAS bf16x8*)(slot + ad.v[dh * 2 + mm]);
}
template <bool DIAG> __device__ __forceinline__ void sb_tile(const SbFrag& f, const bf16x8 (&qf)[4], f32x16& o0, f32x16& o1, float& carry, int lim, int hi) {
    f32x16 s;
#pragma unroll
    for (int r = 0; r < 16; ++r) s[r] = 0.f;
#pragma unroll
    for (int d0 = 0; d0 < 4; ++d0) s = __builtin_amdgcn_mfma_f32_32x32x16_bf16(f.kf[d0], qf[d0], s, 0, 0, 0);
    float wv[16], t[16]; float run, zmax = -3.0e38f;
#pragma unroll
    for (int r = 0; r < 16; ++r) { zmax = fmaxf(zmax, s[r]); t[r] = __builtin_amdgcn_exp2f(s[r]); if (DIAG) t[r] = (r < lim) ? t[r] : 0.f; }
    if (!__any(zmax > 7.2f)) {
        float G = 1.f;
#pragma unroll
        for (int r = 0; r < 16; ++r) { wv[r] = t[r] * G; G *= 1.0f + t[r]; }
        run = __builtin_amdgcn_rcpf(G);
#pragma unroll
        for (int r = 0; r < 16; ++r) wv[r] *= run;
    } else {
        run = 1.f;
#pragma unroll
        for (int r = 15; r >= 0; --r) {
            float stay = __builtin_amdgcn_rcpf(1.0f + t[r]);
            float beta = 1.0f - stay;
            if (DIAG) { const bool ok = r < lim; stay = ok ? stay : 1.0f; beta = ok ? beta : 0.f; }
            wv[r] = beta * run; run *= stay;
        }
    }
    const float other = __shfl_xor(run, 32);
    const float base = carry * (hi == 0 ? other : 1.0f);
    carry *= run * other;
    u32x4 p0, p1;
    p0.x = cvt_pk_bf16(wv[0] * base, wv[1] * base); p0.y = cvt_pk_bf16(wv[2] * base, wv[3] * base); p0.z = cvt_pk_bf16(wv[4] * base, wv[5] * base); p0.w = cvt_pk_bf16(wv[6] * base, wv[7] * base);
    p1.x = cvt_pk_bf16(wv[8] * base, wv[9] * base); p1.y = cvt_pk_bf16(wv[10] * base, wv[11] * base); p1.z = cvt_pk_bf16(wv[12] * base, wv[13] * base); p1.w = cvt_pk_bf16(wv[14] * base, wv[15] * base);
    const bf16x8 pa0 = __builtin_bit_cast(bf16x8, p0), pa1 = __builtin_bit_cast(bf16x8, p1);
    o0 = __builtin_amdgcn_mfma_f32_32x32x16_bf16(pa0, f.vf[0][0], o0, 0, 0, 0); o0 = __builtin_amdgcn_mfma_f32_32x32x16_bf16(pa1, f.vf[0][1], o0, 0, 0, 0);
    o1 = __builtin_amdgcn_mfma_f32_32x32x16_bf16(pa0, f.vf[1][0], o1, 0, 0, 0); o1 = __builtin_amdgcn_mfma_f32_32x32x16_bf16(pa1, f.vf[1][1], o1, 0, 0, 0);
}
__device__ __forceinline__ void sb_unit(const bf16_t* Q, const bf16_t* K, const bf16_t* VT, bf16_t* O, int b, int h, int qb, int lane, LAS unsigned char* slotA, LAS unsigned char* slotB, const SbAddr& ad) {
    const int j = lane & 31, hi = lane >> 5, q0 = qb * 32; const size_t rowbase = (size_t)b * SEQ;
    const bf16_t* qp = Q + (rowbase + q0 + j) * D + h * HD + 8 * hi;
    bf16x8 qf[4];
#pragma unroll
    for (int d0 = 0; d0 < 4; ++d0) qf[d0] = *(const bf16x8*)(qp + 16 * d0);
    const int k8w = lane >> 3, cw = (lane & 7) ^ k8w, aw = lane >> 4, d16w = 4 * ((lane >> 2) & 3) + aw, pw = (lane & 3) ^ aw;
    const bf16_t* kg = K + (rowbase + k8w) * D + h * HD + 8 * cw;
    const bf16_t* vg = VT + ((size_t)(b * NH + h) * HD + d16w) * SEQ + 8 * pw;
    f32x16 o0, o1;
#pragma unroll
    for (int r = 0; r < 16; ++r) { o0[r] = 0.f; o1[r] = 0.f; }
    float carry = 1.f;
    SbFrag f;
    sb_dma(slotA, kg, vg, q0);
    sb_dma(slotB, kg, vg, qb > 0 ? q0 - 32 : 0);
    sb_wait<8>(); sb_read(f, slotA, ad);
    sb_tile<true>(f, qf, o0, o1, carry, j - 16 * hi, hi);
    for (int kt = qb - 1; kt >= 0; kt -= 2) {
        sb_dma(slotA, kg, vg, (kt > 0 ? kt - 1 : 0) * 32);
        sb_wait<8>(); sb_read(f, slotB, ad);
        sb_tile<false>(f, qf, o0, o1, carry, 64, hi);
        if (kt == 0 || __all(carry < SB_TINY)) break;
        sb_dma(slotB, kg, vg, (kt > 1 ? kt - 2 : 0) * 32);
        sb_wait<8>(); sb_read(f, slotA, ad);
        sb_tile<false>(f, qf, o0, o1, carry, 64, hi);
        if (__all(carry < SB_TINY)) break;
    }
    sb_wait<0>();
    bf16_t* op = O + (rowbase + q0) * D + h * HD + j;
#pragma unroll
    for (int r = 0; r < 16; ++r) { const int qr = (r & 3) + 8 * (r >> 2) + 4 * hi;
        op[(size_t)qr * D] = (bf16_t)(cvt_pk_bf16(o0[r], 0.f) & 0xffffu); op[(size_t)qr * D + 32] = (bf16_t)(cvt_pk_bf16(o1[r], 0.f) & 0xffffu); }
}
__device__ __forceinline__ void attn_phase(const Args& a, const Frame& F) {
    const bf16_t* Q = (const bf16_t*)(a.ws + WS_Q); const bf16_t* K = (const bf16_t*)(a.ws + WS_K); const bf16_t* VT = (const bf16_t*)(a.ws + WS_VT); bf16_t* O = (bf16_t*)(a.ws + WS_O);
    constexpr int NQB = SEQ / 32, NU = BATCH * NH * NQB;
    LAS unsigned char* slotA = F.lds + F.wave * WAVE_LDS;
    SbAddr ad;
    { const int j = F.lane & 31, hi = F.lane >> 5, key = 16 * ((j >> 2) & 1) + (j & 3) + 4 * (j >> 3), ki = key >> 3, k8 = key & 7;
#pragma unroll
      for (int d0 = 0; d0 < 4; ++d0) ad.k[d0] = ki * ATT_KSTR + (8 * k8 + ((2 * d0 + hi) ^ k8)) * 16;
#pragma unroll
      for (int dh = 0; dh < 2; ++dh)
#pragma unroll
          for (int mm = 0; mm < 2; ++mm) { const int dd = 32 * dh + j, vi = dd >> 4, d16 = dd & 15, a_ = d16 & 3, b_ = d16 >> 2, p = 2 * hi + mm; ad.v[dh * 2 + mm] = ATT_VOFF + vi * 1024 + (16 * a_ + 4 * b_ + (p ^ a_)) * 16; } }
    for (int u = F.gw; u < NU; u += F.NGW) { const int bh = u / NQB, qb = u % NQB; sb_unit(Q, K, VT, O, bh / NH, bh % NH, qb, F.lane, slotA, slotA + ATT_SLOT, ad); }
}

__global__ void __launch_bounds__(NTHR) fwd_kernel(Args args) {
    extern __shared__ __attribute__((aligned(16))) unsigned char lds_raw[];
    Frame F; F.lds = (LAS unsigned char*)lds_raw; F.tid = threadIdx.x; F.lane = F.tid & 63; F.wave = __builtin_amdgcn_readfirstlane(F.tid >> 6);
    F.G = gridDim.x; F.gw = blockIdx.x * NWAVES + F.wave; F.NGW = F.G * NWAVES;
    unsigned char* ws = args.ws;
    float* ss = (float*)(ws + WS_SS); LAS float* RED = (LAS float*)(F.lds + 131072);
    const int lo = args.ph_lo, hi = args.ph_hi;
#if MK_COOP
    cg::grid_group grid = cg::this_grid();
    volatile LAS unsigned* MISC = (volatile LAS unsigned*)(F.lds + MISC_OFF);
    if (F.tid < 16) MISC[F.tid] = 0u;
    __syncthreads();
    const XcdBarrier xbar = xcd_barrier_post((unsigned*)ws, MISC + 8);
    if (hi > N_PHASES) grid.sync();
#define SEAM(k) do { if (lo <= (k) && (k) + 1 < hi) xcd_barrier(xbar); } while (0)
#else
#define SEAM(k) do { } while (0)
#endif
#ifndef PH_MASK
#define PH_MASK 0x3ffff
#endif
#define IN(k) (((PH_MASK >> (k)) & 1) && lo <= (k) && (k) < hi)
    using namespace pg8;
    bf16_t* XB = (bf16_t*)(ws + WS_XB); bf16_t* ACT = (bf16_t*)(ws + WS_ACT);
    const int bx = blockIdx.x;
#define RUN_GEMM(EPI, ALIGN, Aptr, Bptr, N_, K_, lda_, adiv_, ...) do { Gemm g{(const bf16_t*)(Aptr), (const bf16_t*)(Bptr), M, (N_), (K_), (lda_), (adiv_)}; StaticOrder S; S.init(M, (N_), F.G, bx); \
        EPI E{__VA_ARGS__}; gemm_phase<EPI, ALIGN>(F.lds, g, S, E); } while (0)

#ifndef DUP_MASK
#define DUP_MASK 0
#endif
#if MK_COOP
#define REDO_BAR() xcd_barrier(xbar)
#else
#define REDO_BAR() do { } while (0)
#endif
#define PHASE(k, ...) do { if (IN(k)) { __VA_ARGS__; if ((DUP_MASK >> (k)) & 1) { REDO_BAR(); __VA_ARGS__; } } SEAM(k); } while (0)
    PHASE(0, cvt_range(args, F, 0, 1, 0, F.G); p0_rows(args, F));
    const int T22 = (64 * 22) % F.G, T30 = (64 * 30) % F.G;
    PHASE(1, RUN_GEMM(EpiSwiglu, true, XB, ws + WS_WA13, 2 * FF, D, D, 0, ss, ACT); cvt_range(args, F, 1, 4, T22, F.G - T22); cvt_range(args, F, 7, 10, T22, F.G - T22));
    PHASE(2, RUN_GEMM(EpiResidIn, true, ACT, ws + WS_WA2, D, FF, FF, 0, args.in[I_X], nullptr, XB, ss + M, 0.5f, RED));
    PHASE(3, RUN_GEMM(EpiWin, true, XB, ws + WS_WIN, 2048, D, D, 0, ss + M, (bf16_t*)(ws + WS_GB), (bf16_t*)(ws + WS_REC)));
    PHASE(4, conv_phase(args, F));
    PHASE(5, RUN_GEMM(EpiGate, true, ws + WS_Y, ws + WS_WRI, 2048, 256, D, 2, (const bf16_t*)(ws + WS_Y), args.in[I_ABR], args.in[I_ABI], (const float*)(ws + WS_SP8), (bf16_t*)(ws + WS_REC), (bf16_t*)(ws + WS_U)));
    PHASE(6, scan_a(args, F));
    PHASE(7, scan_b(args, F));
    PHASE(8, RUN_GEMM(EpiResidMid, true, ws + WS_Y, ws + WS_WOUT, D, D, D, 0, nullptr, nullptr, XB, ss + 2 * M, 1.0f, RED));
    PHASE(9, RUN_GEMM(EpiSwiglu, true, XB, ws + WS_WB13, 2 * FF, D, D, 0, ss + 2 * M, ACT); cvt_range(args, F, 4, 7, T22, F.G - T22));
    PHASE(10, RUN_GEMM(EpiResidMid, true, ACT, ws + WS_WB2, D, FF, FF, 0, nullptr, nullptr, XB, ss + 3 * M, 0.5f, RED));
    PHASE(11, RUN_GEMM(EpiKvSwiglu, true, XB, ws + WS_WKV, 2048 + 2 * FF, D, D, 0, ss + 3 * M, args.in[I_KN], (bf16_t*)(ws + WS_K), (bf16_t*)(ws + WS_VT), ACT); cvt_range(args, F, 10, 14, T30, F.G - T30));
    PHASE(12, RUN_GEMM(EpiResidMid, true, ACT, ws + WS_WC2, D, FF, FF, 0, nullptr, nullptr, XB, ss + 4 * M, 0.5f, RED));
    PHASE(13, RUN_GEMM(EpiQ, true, XB, ws + WS_WQ, D, D, D, 0, ss + 4 * M, args.in[I_QN], (bf16_t*)(ws + WS_Q)));
    PHASE(14, attn_phase(args, F));
    PHASE(15, RUN_GEMM(EpiResidMid, true, ws + WS_O, ws + WS_WO, D, D, D, 0, nullptr, nullptr, XB, ss + 5 * M, 1.0f, RED));
    PHASE(16, RUN_GEMM(EpiSwiglu, true, XB, ws + WS_WA13, 2 * FF, D, D, 0, ss + 5 * M, ACT));
    PHASE(17, RUN_GEMM(EpiResidOut, true, ACT, ws + WS_WA2, D, FF, FF, 0, nullptr, args.out, XB, nullptr, 0.5f, RED));
}

extern "C" void kernel_launch(void* const* d_in, const int* in_sizes, int n_in, void* d_out, int out_size, void* d_ws, size_t ws_size, hipStream_t stream) {
    static int grid = 0;
    if (grid == 0) {
        if (n_in != 23 || out_size != M * D || ws_size < WS_END) { fprintf(stderr, "kernel_launch: unexpected problem (n_in %d out %d ws %zu)\n", n_in, out_size, ws_size); grid = -1; return; }
        int dev = 0, cus = 0, per_cu = 0;
        (void)hipGetDevice(&dev); (void)hipDeviceGetAttribute(&cus, hipDeviceAttributeMultiprocessorCount, dev);
        if (hipFuncSetAttribute((const void*)fwd_kernel, hipFuncAttributeMaxDynamicSharedMemorySize, LDS_BYTES) != hipSuccess) { fprintf(stderr, "kernel_launch: hipFuncSetAttribute failed\n"); grid = -1; return; }
        if (hipOccupancyMaxActiveBlocksPerMultiprocessor(&per_cu, (const void*)fwd_kernel, NTHR, LDS_BYTES) != hipSuccess || per_cu < 1) { fprintf(stderr, "kernel_launch: occupancy query says %d\n", per_cu); per_cu = 1; }
        (void)hipGetLastError();
        grid = cus * 1;
        if (grid <= 0) grid = 256;
    }
    if (grid < 0) return;
    Args a{};
    for (int i = 0; i < 23; ++i) a.in[i] = (const float*)d_in[i];
    a.out = (float*)d_out; a.ws = (unsigned char*)d_ws;
#if MK_COOP
    a.ph_lo = 0; a.ph_hi = N_PHASES;
    if (hipMemsetAsync(d_ws, 0, 16 * KiB, stream) != hipSuccess) { fprintf(stderr, "kernel_launch: memset of the barrier words failed\n"); return; }
    void* kargs[] = {&a};
    hipError_t e = hipLaunchCooperativeKernel((const void*)fwd_kernel, dim3(grid), dim3(NTHR), kargs, LDS_BYTES, stream);
    if (e != hipSuccess) fprintf(stderr, "kernel_launch: cooperative launch failed: %s (grid %d)\n", hipGetErrorString(e), grid);
#else
    for (int p = 0; p < N_PHASES; ++p) { a.ph_lo = p; a.ph_hi = p + 1; hipLaunchKernelGGL(fwd_kernel, dim3(grid), dim3(NTHR), LDS_BYTES, stream, a); }
#endif
}
```

```cpp
#include <hip/hip_runtime.h>
#include <hip/hip_cooperative_groups.h>
#include <cstdio>
#include <cstdint>
#include <cmath>
namespace cg = cooperative_groups;

#ifndef MK_COOP
#define MK_COOP 1
#endif

#define LAS __attribute__((address_space(3)))
typedef unsigned short bf16_t;
typedef short bf16x8 __attribute__((ext_vector_type(8)));
typedef float f32x4 __attribute__((ext_vector_type(4)));
typedef float f32x2 __attribute__((ext_vector_type(2)));
typedef float f32x16 __attribute__((ext_vector_type(16)));
typedef unsigned u32x4 __attribute__((ext_vector_type(4)));
typedef unsigned u32x2 __attribute__((ext_vector_type(2)));

constexpr int BATCH = 4, SEQ = 4096, D = 1024, FF = 2816, NH = 16, HD = 64;
constexpr int M = BATCH * SEQ;
constexpr float EPS = 1e-6f;
constexpr float LOG2E = 1.4426950408889634f, LN2 = 0.6931471805599453f;

constexpr size_t MiB = 1u << 20, KiB = 1u << 10;
constexpr size_t WS_SS = 64 * KiB;
constexpr size_t WS_SP8 = 32 * KiB;
constexpr size_t WS_HL = 1 * MiB, WS_PC = 2 * MiB;
constexpr size_t SZ_W13 = (size_t)2 * FF * D * 2, SZ_W2 = (size_t)D * FF * 2;
constexpr size_t WS_WA13 = 4 * MiB, WS_WA2 = WS_WA13 + SZ_W13;
constexpr size_t WS_WB13 = WS_WA2 + SZ_W2, WS_WB2 = WS_WB13 + SZ_W13;
constexpr size_t WS_WKV = WS_WB2 + SZ_W2, WS_WC13 = WS_WKV + 4 * MiB, WS_WC2 = WS_WC13 + SZ_W13;
constexpr size_t WS_WIN = WS_WC2 + SZ_W2, WS_WRI = WS_WIN + 4 * MiB, WS_WOUT = WS_WRI + 1 * MiB, WS_WQ = WS_WOUT + 2 * MiB, WS_WO = WS_WQ + 2 * MiB;
constexpr size_t WS_XB = 69 * MiB;
constexpr size_t WS_ACT = 101 * MiB;
constexpr size_t WS_K = 189 * MiB, WS_VT = 221 * MiB, WS_END = 253 * MiB;
constexpr size_t WS_GB = WS_ACT, WS_U = WS_ACT + 32 * MiB, WS_REC = WS_ACT + 64 * MiB;
constexpr size_t WS_Y = WS_ACT + 96 * MiB;
constexpr size_t WS_Q = WS_ACT, WS_O = WS_ACT + 32 * MiB;
static_assert(WS_WO + 2 * MiB <= WS_XB && WS_REC + 64 * MiB <= WS_END, "ws map");

__device__ __forceinline__ unsigned cvt_pk_bf16(float lo, float hi) {
    typedef __bf16 bf16x2_t __attribute__((ext_vector_type(2)));
    f32x2 v = {lo, hi}; bf16x2_t b = __builtin_convertvector(v, bf16x2_t); return __builtin_bit_cast(unsigned, b);
}
__device__ __forceinline__ float bf_lo(unsigned w) { return __uint_as_float(w << 16); }
__device__ __forceinline__ float bf_hi(unsigned w) { return __uint_as_float(w & 0xffff0000u); }
__device__ __forceinline__ float sigm(float x) { return __builtin_amdgcn_rcpf(1.0f + __builtin_amdgcn_exp2f(-x * LOG2E)); }
__device__ __forceinline__ float gelu_tanh(float x) { return x * sigm(1.5957691216057308f * (x + 0.044715f * x * x * x)); }
__device__ __forceinline__ float wave_sum(float v) {
#pragma unroll
    for (int o = 1; o < 64; o <<= 1) v += __shfl_xor(v, o);
    return v;
}
#define LDS_WAIT() asm volatile("s_waitcnt lgkmcnt(0)" ::: "memory")

namespace pg8 {
constexpr int BM = 256, BK = 64, HALF = 128, HTB = HALF * BK * 2, STAGE_BYTES = 8 * HTB, NXCD = 8, WGM = 4;
__host__ __device__ __forceinline__ int lds_byte(int r, int c) { const int st = (r >> 4) * 2 + (c >> 5), rr = r & 15, cc = c & 31, ob = rr * 64 + cc * 2; return st * 1024 + (ob ^ (((ob >> 9) & 1) << 5)); }
__host__ __device__ __forceinline__ void stage_rc(int b, int& R, int& C) { const int st = b / 1024, sb = b % 1024, swz = sb ^ (((sb >> 9) & 1) << 5); R = (st >> 1) * 16 + swz / 64; C = (st & 1) * 32 + (swz % 64) / 2; }
__host__ __device__ __forceinline__ int perm32(int rho) { const int n = rho >> 4, i = rho & 15; return 8 * (i >> 2) + 4 * n + (i & 3); }

struct Unit { int pm, pn; };
struct Gemm { const bf16_t* A; const bf16_t* Bt; int M, N, K, lda, adiv; };

static_assert((16384 / BM) % WGM == 0, "row panels must fill whole groups");
struct StaticOrder {
    int nM, nN, nwg, G, c;
    __device__ void init(int M_, int N_, int G_, int c_) { nM = M_ / BM; nN = N_ / BM; nwg = nM * nN; G = G_; c = c_; }
    __device__ bool next(int i, Unit& u) const {
        const long L = (long)i * G + c; if (L >= nwg) return false;
        int wgid = (int)L; { const int q = nwg / NXCD, r = nwg % NXCD, xcd = wgid % NXCD, off = wgid / NXCD; wgid = (xcd < r ? xcd * (q + 1) : r * (q + 1) + (xcd - r) * q) + off; }
        const int nig = WGM * nN, gid = wgid / nig, fm = gid * WGM; constexpr int gsz = WGM;
        u.pm = fm + ((wgid % nig) % gsz); u.pn = (wgid % nig) / gsz; return true;
    }
};

template <class Epi, bool ALIGN_EPI>
__device__ __forceinline__ void gemm_phase(LAS unsigned char* lds, const Gemm g, const StaticOrder& S, const Epi& E) {
    const int tid = threadIdx.x, wid = __builtin_amdgcn_readfirstlane(tid >> 6), lane = tid & 63, wr = wid >> 2, wc = wid & 3, fr = lane & 15, fq = lane >> 4;
    const int K = g.K, nt = K / BK, lda = g.lda;
    unsigned voffA[2], voffB[2];
#pragma unroll
    for (int i = 0; i < 2; ++i) { int R, C; stage_rc(tid * 16 + i * 8192, R, C); const int Rb = (R & ~31) + perm32(R & 31);
        voffA[i] = (unsigned)(R * lda + C) * 2u; voffB[i] = (unsigned)(Rb * K + C) * 2u; }
    const size_t kstep = (size_t)(BK * 2);
    const size_t hA = (size_t)HALF * lda * 2, hB = (size_t)HALF * K * 2;
    const size_t tA = 2 * hA, tB = 2 * hB;
    const unsigned ldsw = (unsigned)wid * 1024u;
    const int aoff = lds_byte(wr * 64 + fr, fq * 8), boff = lds_byte(wc * 32 + fr, fq * 8);
#define PG8_SA(b, h) (((b) * 2 + (h)) * HTB)
#define PG8_SB(b, h) ((4 + (b) * 2 + (h)) * HTB)
#define PG8_STAGE(bufoff, gbase, voff) do { _Pragma("unroll") for (int _i = 0; _i < 2; ++_i) \
        __builtin_amdgcn_global_load_lds((const unsigned*)((const char*)(gbase) + (voff)[_i]), (LAS unsigned*)(lds + (bufoff) + ldsw + _i * 8192), 16, 0, 0); } while (0)
#define PG8_LDA(dst, b, h) do { _Pragma("unroll") for (int m = 0; m < 4; ++m) _Pragma("unroll") for (int k = 0; k < 2; ++k) dst[m][k] = *(const LAS bf16x8*)(lds + PG8_SA(b, h) + aoff + m * 2048 + k * 1024); } while (0)
#define PG8_LDB(dst, b, h) do { _Pragma("unroll") for (int n = 0; n < 2; ++n) _Pragma("unroll") for (int k = 0; k < 2; ++k) dst[n][k] = *(const LAS bf16x8*)(lds + PG8_SB(b, h) + boff + n * 2048 + k * 1024); } while (0)
#define PG8_MMA(ai, bj, At, Bt) do { __builtin_amdgcn_s_setprio(1); _Pragma("unroll") for (int m = 0; m < 4; ++m) _Pragma("unroll") for (int n = 0; n < 2; ++n) _Pragma("unroll") for (int k = 0; k < 2; ++k) \
        acc[ai][bj][m][n] = __builtin_amdgcn_mfma_f32_16x16x32_bf16(Bt[n][k], At[m][k], acc[ai][bj][m][n], 0, 0, 0); __builtin_amdgcn_s_setprio(0); } while (0)
#define PG8_WAIT_V(n) asm volatile("s_waitcnt vmcnt(" #n ")" ::: "memory")
#define PG8_WAIT_L(n) asm volatile("s_waitcnt lgkmcnt(" #n ")" ::: "memory")
#define PG8_BAR __builtin_amdgcn_s_barrier()
#define PG8_SCHED __builtin_amdgcn_sched_barrier(0)
#define PG8_ABASE(u) ((const char*)g.A + (size_t)(u).pm * tA + (g.adiv ? (size_t)((u).pn / g.adiv) * K * 2 : (size_t)0))
#define PG8_BBASE(u) ((const char*)g.Bt + (size_t)(u).pn * tB)
    Unit cur, nxt; int ui = 0;
    if (!S.next(0, cur)) return;
    f32x4 acc[2][2][4][2];
#pragma unroll
    for (int a = 0; a < 2; ++a)
#pragma unroll
        for (int b = 0; b < 2; ++b)
#pragma unroll
            for (int m = 0; m < 4; ++m)
#pragma unroll
                for (int n = 0; n < 2; ++n) acc[a][b][m][n] = (f32x4){0.f, 0.f, 0.f, 0.f};
    bf16x8 At[4][2], B0[2][2], B1[2][2];
    const char* cA = PG8_ABASE(cur); const char* cB = PG8_BBASE(cur);
    PG8_STAGE(PG8_SB(0, 0), cB, voffB); PG8_STAGE(PG8_SB(0, 1), cB + hB, voffB); PG8_STAGE(PG8_SA(0, 0), cA, voffA); PG8_STAGE(PG8_SA(0, 1), cA + hA, voffA);
    if (wr == 1) PG8_BAR;
    PG8_WAIT_V(2); PG8_BAR;
    PG8_STAGE(PG8_SB(1, 0), cB + kstep, voffB); PG8_STAGE(PG8_SA(1, 0), cA + kstep, voffA); PG8_STAGE(PG8_SB(1, 1), cB + hB + kstep, voffB);
    PG8_WAIT_V(6); PG8_BAR;
    for (;;) {
        const bool has_next = S.next(ui + 1, nxt);
        const char* nA = has_next ? PG8_ABASE(nxt) : cA; const char* nB = has_next ? PG8_BBASE(nxt) : cB;
#pragma unroll 1
        for (int t = 0; t < nt; t += 2) {
            const bool last = (t == nt - 2);
            const char* a1 = cA + (size_t)(t + 1) * kstep;
            const char* a2 = last ? nA : cA + (size_t)(t + 2) * kstep; const char* b2 = last ? nB : cB + (size_t)(t + 2) * kstep;
            const char* a3 = a2 + kstep; const char* b3 = b2 + kstep;
            PG8_LDB(B0, 0, 0); PG8_LDB(B1, 0, 1); PG8_SCHED; PG8_LDA(At, 0, 0); PG8_STAGE(PG8_SA(1, 1), a1 + hA, voffA);
            PG8_WAIT_V(8); PG8_WAIT_L(0); PG8_BAR; PG8_MMA(0, 0, At, B0); PG8_MMA(0, 1, At, B1); PG8_BAR; PG8_SCHED;
            PG8_LDA(At, 0, 1); PG8_STAGE(PG8_SB(0, 0), b2, voffB); PG8_STAGE(PG8_SB(0, 1), b2 + hB, voffB); PG8_STAGE(PG8_SA(0, 0), a2, voffA);
            PG8_WAIT_V(8); PG8_WAIT_L(0); PG8_BAR; PG8_MMA(1, 0, At, B0); PG8_MMA(1, 1, At, B1); PG8_BAR; PG8_SCHED;
            PG8_LDB(B0, 1, 0); PG8_LDB(B1, 1, 1); PG8_SCHED; PG8_LDA(At, 1, 0); PG8_STAGE(PG8_SA(0, 1), a2 + hA, voffA);
            PG8_WAIT_V(8); PG8_WAIT_L(0); PG8_BAR; PG8_MMA(0, 0, At, B0); PG8_MMA(0, 1, At, B1); PG8_BAR; PG8_SCHED;
            PG8_LDA(At, 1, 1); PG8_STAGE(PG8_SB(1, 0), b3, voffB); PG8_STAGE(PG8_SB(1, 1), b3 + hB, voffB); PG8_STAGE(PG8_SA(1, 0), a3, voffA);
            PG8_WAIT_V(8); PG8_WAIT_L(0); PG8_BAR; PG8_MMA(1, 0, At, B0); PG8_MMA(1, 1, At, B1); PG8_BAR; PG8_SCHED;
        }
        if constexpr (ALIGN_EPI) { if (wr == 0) PG8_BAR; }
        E(acc, cur, wr, wc, fr, fq);
        if (!has_next) break;
#pragma unroll
        for (int a = 0; a < 2; ++a)
#pragma unroll
            for (int b = 0; b < 2; ++b)
#pragma unroll
                for (int m = 0; m < 4; ++m)
#pragma unroll
                    for (int n = 0; n < 2; ++n) acc[a][b][m][n] = (f32x4){0.f, 0.f, 0.f, 0.f};
        cur = nxt; cA = nA; cB = nB; ++ui;
        if constexpr (ALIGN_EPI) { if (wr == 1) PG8_BAR; }
    }
    PG8_WAIT_V(0);
    if constexpr (!ALIGN_EPI) { if (wr == 0) PG8_BAR; }
    PG8_BAR;
#undef PG8_SA
#undef PG8_SB
#undef PG8_STAGE
#undef PG8_LDA
#undef PG8_LDB
#undef PG8_MMA
#undef PG8_WAIT_V
#undef PG8_WAIT_L
#undef PG8_BAR
#undef PG8_SCHED
#undef PG8_ABASE
#undef PG8_BBASE
}

typedef f32x4 Acc[2][2][4][2];
__device__ __forceinline__ float rstd_of(const float* ss, int row) { return 1.0f / sqrtf(ss[row] * (1.0f / D) + EPS); }

__device__ __forceinline__ void rstd8(const float* ss, int rbase, float (&rs)[2][4]) {
    float t[2][4];
#pragma unroll
    for (int ai = 0; ai < 2; ++ai)
#pragma unroll
        for (int m = 0; m < 4; ++m) t[ai][m] = ss[rbase + ai * HALF + m * 16];
#pragma unroll
    for (int ai = 0; ai < 2; ++ai)
#pragma unroll
        for (int m = 0; m < 4; ++m) rs[ai][m] = __builtin_amdgcn_rsqf(t[ai][m] * (1.0f / D) + EPS);
}
__device__ __forceinline__ void epi_swiglu(const Acc& acc, int pm, int pnf, int wr, int wc, int fr, int fq, const float* ss, bf16_t* act) {
    const int col = pnf * 128 + wc * 32 + 8 * fq;
    float rs8[2][4]; rstd8(ss, pm * BM + wr * 64 + fr, rs8);
#pragma unroll
    for (int ai = 0; ai < 2; ++ai)
#pragma unroll
        for (int m = 0; m < 4; ++m) {
            const int row = pm * BM + ai * HALF + wr * 64 + m * 16 + fr; const float rs = rs8[ai][m];
            float o[8];
#pragma unroll
            for (int n = 0; n < 2; ++n)
#pragma unroll
                for (int j = 0; j < 4; ++j) { const float gt = acc[ai][0][m][n][j] * rs, up = acc[ai][1][m][n][j] * rs; o[n * 4 + j] = gt * sigm(gt) * up; }
            u32x4 w; w.x = cvt_pk_bf16(o[0], o[1]); w.y = cvt_pk_bf16(o[2], o[3]); w.z = cvt_pk_bf16(o[4], o[5]); w.w = cvt_pk_bf16(o[6], o[7]);
            __builtin_nontemporal_store(w, (u32x4*)(act + (size_t)row * FF + col));
        }
}
struct EpiSwiglu { const float* ss; bf16_t* act;
    __device__ __forceinline__ void operator()(const Acc& acc, const Unit& u, int wr, int wc, int fr, int fq) const { epi_swiglu(acc, u.pm, u.pn, wr, wc, fr, fq, ss, act); } };

template <bool IN_F32, bool FINAL> struct EpiResid { const float* xin; float* xout; bf16_t* xb; float* ssn; float alpha; LAS float* red;
    __device__ __forceinline__ void operator()(const Acc& acc, const Unit& u, int wr, int wc, int fr, int fq) const {
        const size_t cbase = (size_t)u.pn * BM + wc * 32 + 8 * fq;
#pragma unroll
        for (int ai = 0; ai < 2; ++ai) {
            f32x4 xr[4][2][2];
#pragma unroll
            for (int m = 0; m < 4; ++m)
#pragma unroll
                for (int bj = 0; bj < 2; ++bj) {
                    const size_t off = (size_t)(u.pm * BM + ai * HALF + wr * 64 + m * 16 + fr) * D + cbase + bj * HALF;
                    if (IN_F32) { xr[m][bj][0] = *(const f32x4*)(xin + off); xr[m][bj][1] = *(const f32x4*)(xin + off + 4); }
                    else { const u32x4 xw = *(const u32x4*)(xb + off); xr[m][bj][0] = __builtin_bit_cast(f32x4, xw); }
                }
#pragma unroll
            for (int m = 0; m < 4; ++m) {
                const int row = u.pm * BM + ai * HALF + wr * 64 + m * 16 + fr; float sq = 0.f;
#pragma unroll
                for (int bj = 0; bj < 2; ++bj) {
                    const size_t off = (size_t)row * D + cbase + bj * HALF;
                    f32x4 x0, x1;
                    if (IN_F32) { x0 = xr[m][bj][0]; x1 = xr[m][bj][1]; }
                    else { const u32x4 xw = __builtin_bit_cast(u32x4, xr[m][bj][0]); x0 = (f32x4){bf_lo(xw.x), bf_hi(xw.x), bf_lo(xw.y), bf_hi(xw.y)}; x1 = (f32x4){bf_lo(xw.z), bf_hi(xw.z), bf_lo(xw.w), bf_hi(xw.w)}; }
                    const f32x4 y0 = x0 + acc[ai][bj][m][0] * alpha, y1 = x1 + acc[ai][bj][m][1] * alpha;
                    if (FINAL) { *(f32x4*)(xout + off) = y0; *(f32x4*)(xout + off + 4) = y1; }
                    else {
                        sq += (y0[0] * y0[0] + y0[1] * y0[1]) + (y0[2] * y0[2] + y0[3] * y0[3]) + (y1[0] * y1[0] + y1[1] * y1[1]) + (y1[2] * y1[2] + y1[3] * y1[3]);
                        u32x4 w; w.x = cvt_pk_bf16(y0[0], y0[1]); w.y = cvt_pk_bf16(y0[2], y0[3]); w.z = cvt_pk_bf16(y1[0], y1[1]); w.w = cvt_pk_bf16(y1[2], y1[3]);
                        *(u32x4*)(xb + off) = w;
                    }
                }
                if (!FINAL) { sq += __shfl_xor(sq, 16); sq += __shfl_xor(sq, 32); if (fq == 0) red[(ai * HALF + wr * 64 + m * 16 + fr) * 4 + wc] = sq; }
            }
        }
        if (!FINAL) {
            asm volatile("s_waitcnt lgkmcnt(0)" ::: "memory"); __builtin_amdgcn_s_barrier(); asm volatile("" ::: "memory");
            const int t = threadIdx.x;
            if (t < BM) { const f32x4 v = ((const LAS f32x4*)red)[t]; atomicAdd(ssn + u.pm * BM + t, (v[0] + v[1]) + (v[2] + v[3])); }
        }
    } };
typedef EpiResid<true, false> EpiResidIn; typedef EpiResid<false, false> EpiResidMid; typedef EpiResid<false, true> EpiResidOut;

struct EpiWin { const float* ss; bf16_t* gb; bf16_t* rec;
    __device__ __forceinline__ void operator()(const Acc& acc, const Unit& u, int wr, int wc, int fr, int fq) const {
        const bool isg = u.pn < 4; const int ct = (u.pn & 3) * BM;
        float rs8[2][4]; rstd8(ss, u.pm * BM + wr * 64 + fr, rs8);
#pragma unroll
        for (int ai = 0; ai < 2; ++ai)
#pragma unroll
            for (int m = 0; m < 4; ++m) {
                const int row = u.pm * BM + ai * HALF + wr * 64 + m * 16 + fr; const float rs = rs8[ai][m];
#pragma unroll
                for (int bj = 0; bj < 2; ++bj) {
                    const size_t off = (size_t)row * D + ct + bj * HALF + wc * 32 + 8 * fq;
                    const f32x4 v0 = acc[ai][bj][m][0] * rs, v1 = acc[ai][bj][m][1] * rs;
                    if (isg) { u32x4 w; w.x = cvt_pk_bf16(gelu_tanh(v0[0]), gelu_tanh(v0[1])); w.y = cvt_pk_bf16(gelu_tanh(v0[2]), gelu_tanh(v0[3]));
                        w.z = cvt_pk_bf16(gelu_tanh(v1[0]), gelu_tanh(v1[1])); w.w = cvt_pk_bf16(gelu_tanh(v1[2]), gelu_tanh(v1[3])); *(u32x4*)(gb + off) = w; }
                    else { u32x4 w; w.x = cvt_pk_bf16(v0[0], v0[1]); w.y = cvt_pk_bf16(v0[2], v0[3]); w.z = cvt_pk_bf16(v1[0], v1[1]); w.w = cvt_pk_bf16(v1[2], v1[3]); *(u32x4*)(rec + off) = w; }
                }
            }
    } };

struct EpiGate { const bf16_t* xc; const float* b_r; const float* b_i; const float* sp8; bf16_t* aout; bf16_t* uout;
    __device__ __forceinline__ void operator()(const Acc& acc, const Unit& u, int wr, int wc, int fr, int fq) const {
        const int ch = u.pn * 128 + wc * 32 + 8 * fq;
        float br[8], bi[8], sp[8];
#pragma unroll
        for (int n = 0; n < 2; ++n) { const f32x4 a_ = *(const f32x4*)(b_r + ch + 4 * n), b_ = *(const f32x4*)(b_i + ch + 4 * n), c_ = *(const f32x4*)(sp8 + ch + 4 * n);
#pragma unroll
            for (int j = 0; j < 4; ++j) { br[4 * n + j] = a_[j]; bi[4 * n + j] = b_[j]; sp[4 * n + j] = c_[j]; } }
        u32x4 xcw[2][4];
#pragma unroll
        for (int ai = 0; ai < 2; ++ai)
#pragma unroll
            for (int m = 0; m < 4; ++m) xcw[ai][m] = *(const u32x4*)(xc + (size_t)(u.pm * BM + ai * HALF + wr * 64 + m * 16 + fr) * D + ch);
#pragma unroll
        for (int ai = 0; ai < 2; ++ai)
#pragma unroll
            for (int m = 0; m < 4; ++m) {
                const int row = u.pm * BM + ai * HALF + wr * 64 + m * 16 + fr; const size_t off = (size_t)row * D + ch;
                const u32x4 xw = xcw[ai][m];
                const float xv[8] = {bf_lo(xw.x), bf_hi(xw.x), bf_lo(xw.y), bf_hi(xw.y), bf_lo(xw.z), bf_hi(xw.z), bf_lo(xw.w), bf_hi(xw.w)};
                float av[8], uv[8];
#pragma unroll
                for (int j = 0; j < 8; ++j) {
                    const float r = sigm(acc[ai][0][m][j >> 2][j & 3] + br[j]), ig = sigm(acc[ai][1][m][j >> 2][j & 3] + bi[j]);
                    const float la2 = r * sp[j];
                    const float a = __builtin_amdgcn_exp2f(la2);
                    av[j] = la2; uv[j] = __builtin_amdgcn_sqrtf(fmaxf(1.0f - a * a, 0.f)) * ig * xv[j];
                }
                u32x4 wa; wa.x = cvt_pk_bf16(av[0], av[1]); wa.y = cvt_pk_bf16(av[2], av[3]); wa.z = cvt_pk_bf16(av[4], av[5]); wa.w = cvt_pk_bf16(av[6], av[7]);
                *(u32x4*)(aout + off) = wa;
                u32x4 w; w.x = cvt_pk_bf16(uv[0], uv[1]); w.y = cvt_pk_bf16(uv[2], uv[3]); w.z = cvt_pk_bf16(uv[4], uv[5]); w.w = cvt_pk_bf16(uv[6], uv[7]);
                *(u32x4*)(uout + off) = w;
            }
    } };

__device__ __forceinline__ void epi_headnorm(const Acc& acc, int pm, int pnh, int wr, int wc, int fr, int fq, const float* ss, const float* gain, float oscale, bf16_t* out) {
    const int head = 4 * pnh + wc;
    float sc[2][4]; rstd8(ss, pm * BM + wr * 64 + fr, sc);
#pragma unroll
    for (int ai = 0; ai < 2; ++ai)
#pragma unroll
        for (int m = 0; m < 4; ++m) {
            const float rs = sc[ai][m];
            float sq = 0.f;
#pragma unroll
            for (int bj = 0; bj < 2; ++bj)
#pragma unroll
                for (int n = 0; n < 2; ++n) { const f32x4 v = acc[ai][bj][m][n]; sq += (v[0] * v[0] + v[1] * v[1]) + (v[2] * v[2] + v[3] * v[3]); }
            sq += __shfl_xor(sq, 16); sq += __shfl_xor(sq, 32);
            sc[ai][m] = rs * oscale * __builtin_amdgcn_rsqf(sq * rs * rs * (1.0f / HD) + EPS);
        }
#pragma unroll
    for (int bj = 0; bj < 2; ++bj) {
        const f32x4 g0 = *(const f32x4*)(gain + 32 * bj + 8 * fq), g1 = *(const f32x4*)(gain + 32 * bj + 8 * fq + 4);
#pragma unroll
        for (int ai = 0; ai < 2; ++ai)
#pragma unroll
            for (int m = 0; m < 4; ++m) {
                const int row = pm * BM + ai * HALF + wr * 64 + m * 16 + fr;
                const f32x4 v0 = acc[ai][bj][m][0] * g0 * sc[ai][m], v1 = acc[ai][bj][m][1] * g1 * sc[ai][m];
                u32x4 w; w.x = cvt_pk_bf16(v0[0], v0[1]); w.y = cvt_pk_bf16(v0[2], v0[3]); w.z = cvt_pk_bf16(v1[0], v1[1]); w.w = cvt_pk_bf16(v1[2], v1[3]);
                *(u32x4*)(out + (size_t)row * D + head * HD + 32 * bj + 8 * fq) = w;
                asm volatile("" ::: "memory");
            }
    }
}
struct EpiQ { const float* ss; const float* gain; bf16_t* q;
    __device__ __forceinline__ void operator()(const Acc& acc, const Unit& u, int wr, int wc, int fr, int fq) const { epi_headnorm(acc, u.pm, u.pn, wr, wc, fr, fq, ss, gain, 0.125f * LOG2E, q); } };
struct EpiKvSwiglu { const float* ss; const float* kgain; bf16_t* kout; bf16_t* vt; bf16_t* act;
    __device__ __forceinline__ void operator()(const Acc& acc, const Unit& u, int wr, int wc, int fr, int fq) const {
        if (u.pn >= 8) { epi_swiglu(acc, u.pm, u.pn - 8, wr, wc, fr, fq, ss, act); return; }
        if (u.pn < 4) { epi_headnorm(acc, u.pm, u.pn, wr, wc, fr, fq, ss, kgain, 1.0f, kout); return; }
        const int head = 4 * (u.pn - 4) + wc;
        float rs8[2][4]; rstd8(ss, u.pm * BM + wr * 64 + fr, rs8);
        const int row0 = u.pm * BM + wr * 64 + fr, b = row0 / SEQ, s0 = row0 % SEQ;
        bf16_t* base = vt + ((size_t)(b * NH + head) * HD + 8 * fq) * SEQ + s0;
#pragma unroll
        for (int bj = 0; bj < 2; ++bj)
#pragma unroll
            for (int j = 0; j < 8; ++j) {
                bf16_t* p = base + (size_t)(32 * bj + j) * SEQ;
#pragma unroll
                for (int ai = 0; ai < 2; ++ai)
#pragma unroll
                    for (int m = 0; m < 4; ++m) p[ai * HALF + m * 16] = (bf16_t)(cvt_pk_bf16(acc[ai][bj][m][j >> 2][j & 3] * rs8[ai][m], 0.f) & 0xffffu);
                asm volatile("" ::: "memory");
            }
    } };
}


#define XB_TMO      128
#define XB_XCNT(j)  (256  + 64 * (j))
#define XB_XSUB(j)  (1280 + 64 * (j))
#define XB_XGEN(j)  (2304 + 64 * (j))
#define XB_TOP      3328
#define XB_TOPGEN   3392
#define XCD_BAR_WORDS 3456
#define XB_SPIN_CAP (1u << 18)
__device__ __forceinline__ unsigned xb_ld(unsigned* p)              { return __hip_atomic_load(p, __ATOMIC_RELAXED, __HIP_MEMORY_SCOPE_AGENT); }
__device__ __forceinline__ unsigned xb_add(unsigned* p, unsigned v) { return __hip_atomic_fetch_add(p, v, __ATOMIC_RELAXED, __HIP_MEMORY_SCOPE_AGENT); }
__device__ __forceinline__ unsigned xb_xcc_id() { return (unsigned)__builtin_amdgcn_s_getreg((3 << 11) | 20) & 0xFu; }
#define XB_SPIN(cond, bar) do { unsigned _sp = 0; while (cond) { __builtin_amdgcn_s_sleep(1); \
    if ((++_sp & 255u) == 0u) { if (xb_ld(&(bar)[XB_TMO])) break; if (_sp > XB_SPIN_CAP) { atomicAdd(&(bar)[XB_TMO], 1u); break; } } } } while (0)
struct XcdBarrier { unsigned* bar; unsigned x; volatile LAS unsigned* st; };
__device__ __forceinline__ XcdBarrier xcd_barrier_post(unsigned* bar, volatile LAS unsigned* st) {
    XcdBarrier b; b.bar = bar; b.x = xb_xcc_id(); b.st = st;
    if (threadIdx.x == 0) (void)xb_add(&bar[XB_XCNT(b.x)], 1u);
    return b;
}
__device__ __forceinline__ void xcd_barrier_complete(unsigned* bar, unsigned x, unsigned& nloc, unsigned& nx) {
    const unsigned G = gridDim.x * gridDim.y * gridDim.z;
    unsigned sum, cnt, mine, sp = 0u;
    for (;;) {
        sum = 0u; cnt = 0u; mine = 0u;
#pragma unroll
        for (unsigned j = 0; j < 16; ++j) { const unsigned c = xb_ld(&bar[XB_XCNT(j)]); sum += c; cnt += (c > 0u) ? 1u : 0u; mine = (j == x) ? c : mine; }
        if (sum == G) break;
        __builtin_amdgcn_s_sleep(1);
        if ((++sp & 255u) == 0u) { if (xb_ld(&bar[XB_TMO])) break; if (sp > XB_SPIN_CAP) { atomicAdd(&bar[XB_TMO], 1u); break; } }
    }
    nloc = mine > 0u ? mine : 1u; nx = cnt > 0u ? cnt : 1u;
}
__device__ __forceinline__ void xcd_barrier(const XcdBarrier& b) {
    asm volatile("s_waitcnt vmcnt(0)" ::: "memory");
    __syncthreads();
    if (threadIdx.x == 0) {
        unsigned* bar = b.bar;
        __builtin_amdgcn_s_waitcnt(0);
        unsigned nloc = b.st[0], nx = b.st[1];
        if (nloc == 0u) { xcd_barrier_complete(bar, b.x, nloc, nx); b.st[0] = nloc; b.st[1] = nx; }
        const unsigned old = xb_add(&bar[XB_XSUB(b.x)], 1u);
        const unsigned gen = old / nloc;
        if (old + 1u == (gen + 1u) * nloc) {
            __builtin_amdgcn_fence(__ATOMIC_RELEASE, "agent");
            asm volatile("s_waitcnt vmcnt(0)" ::: "memory");
            const unsigned og = xb_add(&bar[XB_TOP], 1u);
            const unsigned tg = og / nx;
            if (og + 1u == (tg + 1u) * nx) xb_add(&bar[XB_TOPGEN], 1u);
            else XB_SPIN(xb_ld(&bar[XB_TOPGEN]) == tg, bar);
            __builtin_amdgcn_fence(__ATOMIC_ACQUIRE, "agent");
            xb_add(&bar[XB_XGEN(b.x)], 1u);
            asm volatile("s_waitcnt vmcnt(0)" ::: "memory");
        } else {
            XB_SPIN(xb_ld(&bar[XB_XGEN(b.x)]) == gen, bar);
            __builtin_amdgcn_fence(__ATOMIC_ACQUIRE, "agent");
            asm volatile("s_waitcnt vmcnt(0)" ::: "memory");
        }
    }
    __syncthreads();
}

constexpr int N_PHASES = 18;
constexpr int NWAVES = 8, NTHR = NWAVES * 64;
constexpr int MISC_OFF = 8 * 16896, LDS_BYTES = MISC_OFF + 256;

struct Args { const float* in[23]; float* out; unsigned char* ws; int ph_lo, ph_hi; };

struct Frame { LAS unsigned char* lds; int tid, lane, wave, G, gw, NGW; };

struct CvtDesc { const float* W; const float* W2; bf16_t* dst; const float* gain; int ldw, K, nb, mode; };
constexpr int SCR_STRIDE = 64 * 65 * 4;
__device__ __forceinline__ void cvt_item(const CvtDesc& d, int local, LAS float* scr, int lane) {
    const int kb = local / d.nb, gI = local % d.nb, k0 = 64 * kb, n0 = 64 * gI;
    const int l16 = lane & 15, l4 = lane >> 4, n = n0 + 4 * l16;
    const float* W = d.W; int c0;
    if (d.mode == 0) c0 = n;
    else if (d.mode == 1) { const int tile = n >> 8, bj = (n >> 7) & 1, j0 = n & 127; c0 = bj * FF + tile * 128 + j0; }
    else if (d.mode == 2) { const int pn = n >> 8, bj = (n >> 7) & 1, wc = (n >> 5) & 3, j0 = n & 31; c0 = 256 * pn + 64 * wc + 32 * bj + j0; }
    else { const int t = n >> 8, blk = t >> 1, half = t & 1, which = (n >> 7) & 1, j0 = n & 127; W = (which ? d.W2 : d.W) + (size_t)blk * 65536; c0 = half * 128 + j0; }
    const float* wp = W + (size_t)(k0 + l4) * d.ldw + c0;
    f32x4 v[16];
#pragma unroll
    for (int i = 0; i < 16; ++i) v[i] = *(const f32x4*)(wp + (size_t)(4 * i) * d.ldw);
    if (d.gain) {
#pragma unroll
        for (int i = 0; i < 16; ++i) v[i] *= d.gain[k0 + 4 * i + l4];
    }
#pragma unroll
    for (int i = 0; i < 16; ++i) { LAS float* s = scr + (4 * i + l4) * 65 + 4 * l16; s[0] = v[i][0]; s[1] = v[i][1]; s[2] = v[i][2]; s[3] = v[i][3]; }
    LDS_WAIT(); asm volatile("" ::: "memory");
    const int c = lane & 7;
#pragma unroll
    for (int j = 0; j < 8; ++j) { const int nn = (lane >> 3) + 8 * j; const LAS float* s = scr + (8 * c) * 65 + nn;
        u32x4 o; o.x = cvt_pk_bf16(s[0 * 65], s[1 * 65]); o.y = cvt_pk_bf16(s[2 * 65], s[3 * 65]); o.z = cvt_pk_bf16(s[4 * 65], s[5 * 65]); o.w = cvt_pk_bf16(s[6 * 65], s[7 * 65]);
        *(u32x4*)(d.dst + (size_t)(n0 + nn) * d.K + k0 + 8 * c) = o; }
    LDS_WAIT(); asm volatile("" ::: "memory");
}
enum { I_X = 0, I_F1N, I_F1W13, I_F1W2, I_MIXN, I_AWIN, I_ACW, I_ACB, I_AWR, I_ABR, I_AWI, I_ABI, I_ALAM, I_AWOUT, I_KVN, I_WKV, I_KN, I_BWQ, I_QN, I_BWO, I_F2N, I_F2W13, I_F2W2 };
constexpr int IT_W13 = (D / 64) * (2 * FF / 64), IT_W2 = (FF / 64) * (D / 64), IT_2048 = (D / 64) * (2048 / 64), IT_1024 = (D / 64) * (D / 64), IT_RI = (256 / 64) * (2048 / 64);
__device__ __forceinline__ CvtDesc cvt_desc(const Args& a, int id) {
    unsigned char* ws = a.ws; CvtDesc d; d.W2 = nullptr; d.gain = nullptr;
    switch (id) {
    case 0: d = {a.in[I_F1W13], nullptr, (bf16_t*)(ws + WS_WA13), a.in[I_F1N], 2 * FF, D, 2 * FF / 64, 1}; break;
    case 1: d = {a.in[I_F1W2], nullptr, (bf16_t*)(ws + WS_WA2), nullptr, D, FF, D / 64, 0}; break;
    case 2: d = {a.in[I_F2W13], nullptr, (bf16_t*)(ws + WS_WB13), a.in[I_F2N], 2 * FF, D, 2 * FF / 64, 1}; break;
    case 3: d = {a.in[I_F2W2], nullptr, (bf16_t*)(ws + WS_WB2), nullptr, D, FF, D / 64, 0}; break;
    case 4: d = {a.in[I_WKV], nullptr, (bf16_t*)(ws + WS_WKV), a.in[I_KVN], 2048, D, 2048 / 64, 2}; break;
    case 5: d = {a.in[I_F1W13] + (size_t)D * 2 * FF, nullptr, (bf16_t*)(ws + WS_WC13), a.in[I_F1N] + D, 2 * FF, D, 2 * FF / 64, 1}; break;
    case 6: d = {a.in[I_F1W2] + (size_t)FF * D, nullptr, (bf16_t*)(ws + WS_WC2), nullptr, D, FF, D / 64, 0}; break;
    case 7: d = {a.in[I_AWIN], nullptr, (bf16_t*)(ws + WS_WIN), a.in[I_MIXN], 2048, D, 2048 / 64, 0}; break;
    case 8: d = {a.in[I_AWR], a.in[I_AWI], (bf16_t*)(ws + WS_WRI), nullptr, 256, 256, 2048 / 64, 3}; break;
    case 9: d = {a.in[I_AWOUT], nullptr, (bf16_t*)(ws + WS_WOUT), nullptr, D, D, D / 64, 0}; break;
    case 10: d = {a.in[I_BWQ], nullptr, (bf16_t*)(ws + WS_WQ), a.in[I_MIXN] + D, D, D, D / 64, 2}; break;
    case 11: d = {a.in[I_BWO], nullptr, (bf16_t*)(ws + WS_WO), nullptr, D, D, D / 64, 0}; break;
    case 12: d = {a.in[I_F2W13] + (size_t)D * 2 * FF, nullptr, (bf16_t*)(ws + WS_WA13), a.in[I_F2N] + D, 2 * FF, D, 2 * FF / 64, 1}; break;
    default: d = {a.in[I_F2W2] + (size_t)FF * D, nullptr, (bf16_t*)(ws + WS_WA2), nullptr, D, FF, D / 64, 0}; break;
    }
    return d;
}
__device__ __forceinline__ int cvt_items(int id) {
    switch (id) { case 0: case 2: case 5: case 12: return IT_W13; case 1: case 3: case 6: case 13: return IT_W2; case 4: case 7: return IT_2048; case 8: return IT_RI; default: return IT_1024; }
}
__device__ __forceinline__ void cvt_range(const Args& a, const Frame& F, int id_lo, int id_hi, int wg_lo, int wg_n) {
    LAS float* scr = (LAS float*)(F.lds + F.wave * 16896);
    int total = 0; for (int id = id_lo; id < id_hi; ++id) total += cvt_items(id);
    const int rank = (int)blockIdx.x - wg_lo; if (rank < 0 || rank >= wg_n) return;
    for (int it = rank * NWAVES + F.wave; it < total; it += wg_n * NWAVES) {
        int r = it, id = id_lo; while (r >= cvt_items(id)) { r -= cvt_items(id); ++id; }
        const CvtDesc d = cvt_desc(a, id); cvt_item(d, r, scr, F.lane);
    }
}

__device__ __forceinline__ void p0_rows(const Args& a, const Frame& F) {
    const float* x = a.in[I_X]; bf16_t* xb = (bf16_t*)(a.ws + WS_XB); float* ss = (float*)(a.ws + WS_SS);
    for (int m = F.gw; m < M; m += 2 * F.NGW) {
        const int m2 = m + F.NGW;
        const bool has2 = m2 < M;
        const f32x4* xr = (const f32x4*)(x + (size_t)m * D) + F.lane; const f32x4* xr2 = (const f32x4*)(x + (size_t)(has2 ? m2 : m) * D) + F.lane;
        f32x4 v[4], v2[4]; float s = 0.f, s2 = 0.f;
#pragma unroll
        for (int j = 0; j < 4; ++j) { v[j] = xr[64 * j]; v2[j] = xr2[64 * j]; }
#pragma unroll
        for (int j = 0; j < 4; ++j) { s += (v[j][0] * v[j][0] + v[j][1] * v[j][1]) + (v[j][2] * v[j][2] + v[j][3] * v[j][3]); s2 += (v2[j][0] * v2[j][0] + v2[j][1] * v2[j][1]) + (v2[j][2] * v2[j][2] + v2[j][3] * v2[j][3]); }
        s = wave_sum(s); s2 = wave_sum(s2);
        u32x2* o = (u32x2*)(xb + (size_t)m * D) + F.lane; u32x2* o2 = (u32x2*)(xb + (size_t)m2 * D) + F.lane;
#pragma unroll
        for (int j = 0; j < 4; ++j) { u32x2 w; w.x = cvt_pk_bf16(v[j][0], v[j][1]); w.y = cvt_pk_bf16(v[j][2], v[j][3]); o[64 * j] = w;
            if (has2) { u32x2 w2; w2.x = cvt_pk_bf16(v2[j][0], v2[j][1]); w2.y = cvt_pk_bf16(v2[j][2], v2[j][3]); o2[64 * j] = w2; } }
        if (F.lane == 0) { ss[m] = s; if (has2) ss[m2] = s2; }
    }
    for (int i = blockIdx.x * NTHR + F.tid; i < 5 * M; i += F.G * NTHR) ss[M + i] = 0.f;
    if (blockIdx.x == 0) for (int c = F.tid; c < D; c += NTHR) { const float l = a.in[I_ALAM][c]; ((float*)(a.ws + WS_SP8))[c] = -8.0f * LOG2E * (fmaxf(-l, 0.f) + log1pf(expf(-fabsf(l)))); }
}

__device__ __forceinline__ void conv_phase(const Args& a, const Frame& F) {
    const bf16_t* rec = (const bf16_t*)(a.ws + WS_REC); bf16_t* xc = (bf16_t*)(a.ws + WS_Y);
    constexpr int CR = 16, NITEM = (M / CR) * 4;
    for (int it = F.gw; it < NITEM; it += F.NGW) {
        const int cq = it & 3, m0 = (it >> 2) * CR, t0 = m0 & (SEQ - 1), ch = cq * 256 + 4 * F.lane;
        f32x4 w[4];
#pragma unroll
        for (int k = 0; k < 4; ++k) w[k] = *(const f32x4*)(a.in[I_ACW] + k * D + ch);
        const f32x4 bv = *(const f32x4*)(a.in[I_ACB] + ch);
        u32x2 rw[CR + 3];
#pragma unroll
        for (int i = 0; i < CR + 3; ++i) { const int r = m0 - 3 + i; rw[i] = (i >= 3 || t0 > 0) ? *(const u32x2*)(rec + (size_t)r * D + ch) : (u32x2){0u, 0u}; }
#pragma unroll
        for (int i = 0; i < CR; ++i) {
            f32x4 y = bv;
#pragma unroll
            for (int k = 0; k < 4; ++k) { const u32x2 q = rw[i + k]; y += w[k] * (f32x4){bf_lo(q.x), bf_hi(q.x), bf_lo(q.y), bf_hi(q.y)}; }
            u32x2 o; o.x = cvt_pk_bf16(y[0], y[1]); o.y = cvt_pk_bf16(y[2], y[3]); *(u32x2*)(xc + (size_t)(m0 + i) * D + ch) = o;
        }
    }
}

constexpr int SC_L = 64, SC_C = SEQ / SC_L;
__device__ __forceinline__ void scan_a(const Args& a, const Frame& F) {
    const bf16_t* av = (const bf16_t*)(a.ws + WS_REC); const bf16_t* uv = (const bf16_t*)(a.ws + WS_U);
    f32x4* hl = (f32x4*)(a.ws + WS_HL); f32x4* pc = (f32x4*)(a.ws + WS_PC);
    if (F.tid >= 256) return;
    for (int item = blockIdx.x * 256 + F.tid; item < BATCH * SC_C * 256; item += F.G * 256) {
        const int cgp = item & 255, bc = item >> 8; const size_t row0 = (size_t)bc * SC_L;
        f32x4 h = {0.f, 0.f, 0.f, 0.f}, p = {1.f, 1.f, 1.f, 1.f};
#pragma unroll 8
        for (int t = 0; t < SC_L; ++t) { const u32x2 aw = *(const u32x2*)(av + (row0 + t) * D + 4 * cgp); const f32x4 aa = {__builtin_amdgcn_exp2f(bf_lo(aw.x)), __builtin_amdgcn_exp2f(bf_hi(aw.x)), __builtin_amdgcn_exp2f(bf_lo(aw.y)), __builtin_amdgcn_exp2f(bf_hi(aw.y))}; const u32x2 uw = *(const u32x2*)(uv + (row0 + t) * D + 4 * cgp);
            const f32x4 uu = {bf_lo(uw.x), bf_hi(uw.x), bf_lo(uw.y), bf_hi(uw.y)}; h = aa * h + uu; p = p * aa; }
        hl[item] = h; pc[item] = p;
    }
}
__device__ __forceinline__ void scan_b(const Args& a, const Frame& F) {
    const bf16_t* av = (const bf16_t*)(a.ws + WS_REC); const bf16_t* uv = (const bf16_t*)(a.ws + WS_U); const bf16_t* gb = (const bf16_t*)(a.ws + WS_GB); bf16_t* yb = (bf16_t*)(a.ws + WS_Y);
    const f32x4* hl = (const f32x4*)(a.ws + WS_HL); const f32x4* pc = (const f32x4*)(a.ws + WS_PC);
    if (F.tid >= 256) return;
    for (int item = blockIdx.x * 256 + F.tid; item < BATCH * SC_C * 256; item += F.G * 256) {
        const int cgp = item & 255, bc = item >> 8, ck = bc & (SC_C - 1), b0 = bc - ck; const size_t row0 = (size_t)bc * SC_L;
        f32x4 h = {0.f, 0.f, 0.f, 0.f};
        int j = 0;
        for (; j + 8 <= ck; j += 8) {
            f32x4 pp[8], hh[8];
#pragma unroll
            for (int e = 0; e < 8; ++e) { pp[e] = pc[(b0 + j + e) * 256 + cgp]; hh[e] = hl[(b0 + j + e) * 256 + cgp]; }
#pragma unroll
            for (int e = 0; e < 8; ++e) h = pp[e] * h + hh[e];
        }
        for (; j < ck; ++j) h = pc[(b0 + j) * 256 + cgp] * h + hl[(b0 + j) * 256 + cgp];
#pragma unroll 8
        for (int t = 0; t < SC_L; ++t) { const size_t off = (row0 + t) * D + 4 * cgp; const u32x2 aw = *(const u32x2*)(av + off); const f32x4 aa = {__builtin_amdgcn_exp2f(bf_lo(aw.x)), __builtin_amdgcn_exp2f(bf_hi(aw.x)), __builtin_amdgcn_exp2f(bf_lo(aw.y)), __builtin_amdgcn_exp2f(bf_hi(aw.y))}; const u32x2 uw = *(const u32x2*)(uv + off);
            const f32x4 uu = {bf_lo(uw.x), bf_hi(uw.x), bf_lo(uw.y), bf_hi(uw.y)}; h = aa * h + uu;
            const u32x2 gw = *(const u32x2*)(gb + off); u32x2 o; o.x = cvt_pk_bf16(h[0] * bf_lo(gw.x), h[1] * bf_hi(gw.x)); o.y = cvt_pk_bf16(h[2] * bf_lo(gw.y), h[3] * bf_hi(gw.y));
            *(u32x2*)(yb + off) = o; }
    }
}

constexpr float SB_TINY = 5.42e-20f;
struct SbFrag { bf16x8 kf[4]; bf16x8 vf[2][2]; };
constexpr int ATT_KSTR = 1088, ATT_VOFF = 4 * ATT_KSTR, ATT_SLOT = ATT_VOFF + 4096, WAVE_LDS = 2 * ATT_SLOT;
__device__ __forceinline__ void sb_dma(LAS unsigned char* slot, const bf16_t* kg, const bf16_t* vg, int k0) {
    const bf16_t* k = kg + (size_t)k0 * D; const bf16_t* v = vg + k0;
#define SB_GLDS(g, o) __builtin_amdgcn_global_load_lds((const unsigned*)(g), (LAS unsigned*)(slot + (o)), 16, 0, 0)
    SB_GLDS(k, 0); SB_GLDS(k + 8 * D, ATT_KSTR); SB_GLDS(k + 16 * D, 2 * ATT_KSTR); SB_GLDS(k + 24 * D, 3 * ATT_KSTR);
    SB_GLDS(v, ATT_VOFF); SB_GLDS(v + (size_t)16 * SEQ, ATT_VOFF + 1024); SB_GLDS(v + (size_t)32 * SEQ, ATT_VOFF + 2048); SB_GLDS(v + (size_t)48 * SEQ, ATT_VOFF + 3072);
#undef SB_GLDS
}
template <int N> __device__ __forceinline__ void sb_wait() { asm volatile("s_waitcnt vmcnt(%0)" :: "n"(N) : "memory"); }
struct SbAddr { int k[4]; int v[4]; };
__device__ __forceinline__ void sb_read(SbFrag& f, const LAS unsigned char* slot, const SbAddr& ad) {
#pragma unroll
    for (int d0 = 0; d0 < 4; ++d0) f.kf[d0] = *(const LAS bf16x8*)(slot + ad.k[d0]);
#pragma unroll
    for (int dh = 0; dh < 2; ++dh)
#pragma unroll
        for (int mm = 0; mm < 2; ++mm) f.vf[dh][mm] = *(const LAS bf16x8*)(slot + ad.v[dh * 2 + mm]);
}
template <bool DIAG> __device__ __forceinline__ void sb_tile(const SbFrag& f, const bf16x8 (&qf)[4], f32x16& o0, f32x16& o1, float& carry, int lim, int hi) {
    f32x16 s;
#pragma unroll
    for (int r = 0; r < 16; ++r) s[r] = 0.f;
#pragma unroll
    for (int d0 = 0; d0 < 4; ++d0) s = __builtin_amdgcn_mfma_f32_32x32x16_bf16(f.kf[d0], qf[d0], s, 0, 0, 0);
    float wv[16], t[16]; float run, zmax = -3.0e38f;
#pragma unroll
    for (int r = 0; r < 16; ++r) { zmax = fmaxf(zmax, s[r]); t[r] = __builtin_amdgcn_exp2f(s[r]); if (DIAG) t[r] = (r < lim) ? t[r] : 0.f; }
    if (!__any(zmax > 7.2f)) {
        float G = 1.f;
#pragma unroll
        for (int r = 0; r < 16; ++r) { wv[r] = t[r] * G; G *= 1.0f + t[r]; }
        run = __builtin_amdgcn_rcpf(G);
#pragma unroll
        for (int r = 0; r < 16; ++r) wv[r] *= run;
    } else {
        run = 1.f;
#pragma unroll
        for (int r = 15; r >= 0; --r) {
            float stay = __builtin_amdgcn_rcpf(1.0f + t[r]);
            float beta = 1.0f - stay;
            if (DIAG) { const bool ok = r < lim; stay = ok ? stay : 1.0f; beta = ok ? beta : 0.f; }
            wv[r] = beta * run; run *= stay;
        }
    }
    const float other = __shfl_xor(run, 32);
    const float base = carry * (hi == 0 ? other : 1.0f);
    carry *= run * other;
    u32x4 p0, p1;
    p0.x = cvt_pk_bf16(wv[0] * base, wv[1] * base); p0.y = cvt_pk_bf16(wv[2] * base, wv[3] * base); p0.z = cvt_pk_bf16(wv[4] * base, wv[5] * base); p0.w = cvt_pk_bf16(wv[6] * base, wv[7] * base);
    p1.x = cvt_pk_bf16(wv[8] * base, wv[9] * base); p1.y = cvt_pk_bf16(wv[10] * base, wv[11] * base); p1.z = cvt_pk_bf16(wv[12] * base, wv[13] * base); p1.w = cvt_pk_bf16(wv[14] * base, wv[15] * base);
    const bf16x8 pa0 = __builtin_bit_cast(bf16x8, p0), pa1 = __builtin_bit_cast(bf16x8, p1);
    o0 = __builtin_amdgcn_mfma_f32_32x32x16_bf16(pa0, f.vf[0][0], o0, 0, 0, 0); o0 = __builtin_amdgcn_mfma_f32_32x32x16_bf16(pa1, f.vf[0][1], o0, 0, 0, 0);
    o1 = __builtin_amdgcn_mfma_f32_32x32x16_bf16(pa0, f.vf[1][0], o1, 0, 0, 0); o1 = __builtin_amdgcn_mfma_f32_32x32x16_bf16(pa1, f.vf[1][1], o1, 0, 0, 0);
}
__device__ __forceinline__ void sb_unit(const bf16_t* Q, const bf16_t* K, const bf16_t* VT, bf16_t* O, int b, int h, int qb, int lane, LAS unsigned char* slotA, LAS unsigned char* slotB, const SbAddr& ad) {
    const int j = lane & 31, hi = lane >> 5, q0 = qb * 32; const size_t rowbase = (size_t)b * SEQ;
    const bf16_t* qp = Q + (rowbase + q0 + j) * D + h * HD + 8 * hi;
    bf16x8 qf[4];
#pragma unroll
    for (int d0 = 0; d0 < 4; ++d0) qf[d0] = *(const bf16x8*)(qp + 16 * d0);
    const int k8w = lane >> 3, cw = (lane & 7) ^ k8w, aw = lane >> 4, d16w = 4 * ((lane >> 2) & 3) + aw, pw = (lane & 3) ^ aw;
    const bf16_t* kg = K + (rowbase + k8w) * D + h * HD + 8 * cw;
    const bf16_t* vg = VT + ((size_t)(b * NH + h) * HD + d16w) * SEQ + 8 * pw;
    f32x16 o0, o1;
#pragma unroll
    for (int r = 0; r < 16; ++r) { o0[r] = 0.f; o1[r] = 0.f; }
    float carry = 1.f;
    SbFrag f;
    sb_dma(slotA, kg, vg, q0);
    sb_dma(slotB, kg, vg, qb > 0 ? q0 - 32 : 0);
    sb_wait<8>(); sb_read(f, slotA, ad);
    sb_tile<true>(f, qf, o0, o1, carry, j - 16 * hi, hi);
    for (int kt = qb - 1; kt >= 0; kt -= 2) {
        sb_dma(slotA, kg, vg, (kt > 0 ? kt - 1 : 0) * 32);
        sb_wait<8>(); sb_read(f, slotB, ad);
        sb_tile<false>(f, qf, o0, o1, carry, 64, hi);
        if (kt == 0 || __all(carry < SB_TINY)) break;
        sb_dma(slotB, kg, vg, (kt > 1 ? kt - 2 : 0) * 32);
        sb_wait<8>(); sb_read(f, slotA, ad);
        sb_tile<false>(f, qf, o0, o1, carry, 64, hi);
        if (__all(carry < SB_TINY)) break;
    }
    sb_wait<0>();
    bf16_t* op = O + (rowbase + q0) * D + h * HD + j;
#pragma unroll
    for (int r = 0; r < 16; ++r) { const int qr = (r & 3) + 8 * (r >> 2) + 4 * hi;
        op[(size_t)qr * D] = (bf16_t)(cvt_pk_bf16(o0[r], 0.f) & 0xffffu); op[(size_t)qr * D + 32] = (bf16_t)(cvt_pk_bf16(o1[r], 0.f) & 0xffffu); }
}
__device__ __forceinline__ void attn_phase(const Args& a, const Frame& F) {
    const bf16_t* Q = (const bf16_t*)(a.ws + WS_Q); const bf16_t* K = (const bf16_t*)(a.ws + WS_K); const bf16_t* VT = (const bf16_t*)(a.ws + WS_VT); bf16_t* O = (bf16_t*)(a.ws + WS_O);
    constexpr int NQB = SEQ / 32, NU = BATCH * NH * NQB;
    LAS unsigned char* slotA = F.lds + F.wave * WAVE_LDS;
    SbAddr ad;
    { const int j = F.lane & 31, hi = F.lane >> 5, key = 16 * ((j >> 2) & 1) + (j & 3) + 4 * (j >> 3), ki = key >> 3, k8 = key & 7;
#pragma unroll
      for (int d0 = 0; d0 < 4; ++d0) ad.k[d0] = ki * ATT_KSTR + (8 * k8 + ((2 * d0 + hi) ^ k8)) * 16;
#pragma unroll
      for (int dh = 0; dh < 2; ++dh)
#pragma unroll
          for (int mm = 0; mm < 2; ++mm) { const int dd = 32 * dh + j, vi = dd >> 4, d16 = dd & 15, a_ = d16 & 3, b_ = d16 >> 2, p = 2 * hi + mm; ad.v[dh * 2 + mm] = ATT_VOFF + vi * 1024 + (16 * a_ + 4 * b_ + (p ^ a_)) * 16; } }
    for (int u = F.gw; u < NU; u += F.NGW) { const int bh = u / NQB, qb = u % NQB; sb_unit(Q, K, VT, O, bh / NH, bh % NH, qb, F.lane, slotA, slotA + ATT_SLOT, ad); }
}

__global__ void __launch_bounds__(NTHR) fwd_kernel(Args args) {
    extern __shared__ __attribute__((aligned(16))) unsigned char lds_raw[];
    Frame F; F.lds = (LAS unsigned char*)lds_raw; F.tid = threadIdx.x; F.lane = F.tid & 63; F.wave = __builtin_amdgcn_readfirstlane(F.tid >> 6);
    F.G = gridDim.x; F.gw = blockIdx.x * NWAVES + F.wave; F.NGW = F.G * NWAVES;
    unsigned char* ws = args.ws;
    float* ss = (float*)(ws + WS_SS); LAS float* RED = (LAS float*)(F.lds + 131072);
    const int lo = args.ph_lo, hi = args.ph_hi;
#if MK_COOP
    cg::grid_group grid = cg::this_grid();
    volatile LAS unsigned* MISC = (volatile LAS unsigned*)(F.lds + MISC_OFF);
    if (F.tid < 16) MISC[F.tid] = 0u;
    __syncthreads();
    const XcdBarrier xbar = xcd_barrier_post((unsigned*)ws, MISC + 8);
    if (hi > N_PHASES) grid.sync();
#define SEAM(k) do { if (lo <= (k) && (k) + 1 < hi) xcd_barrier(xbar); } while (0)
#else
#define SEAM(k) do { } while (0)
#endif
#ifndef PH_MASK
#define PH_MASK 0x3ffff
#endif
#define IN(k) (((PH_MASK >> (k)) & 1) && lo <= (k) && (k) < hi)
    using namespace pg8;
    bf16_t* XB = (bf16_t*)(ws + WS_XB); bf16_t* ACT = (bf16_t*)(ws + WS_ACT);
    const int bx = blockIdx.x;
#define RUN_GEMM(EPI, ALIGN, Aptr, Bptr, N_, K_, lda_, adiv_, ...) do { Gemm g{(const bf16_t*)(Aptr), (const bf16_t*)(Bptr), M, (N_), (K_), (lda_), (adiv_)}; StaticOrder S; S.init(M, (N_), F.G, bx); \
        EPI E{__VA_ARGS__}; gemm_phase<EPI, ALIGN>(F.lds, g, S, E); } while (0)

#ifndef DUP_MASK
#define DUP_MASK 0
#endif
#if MK_COOP
#define REDO_BAR() xcd_barrier(xbar)
#else
#define REDO_BAR() do { } while (0)
#endif
#define PHASE(k, ...) do { if (IN(k)) { __VA_ARGS__; if ((DUP_MASK >> (k)) & 1) { REDO_BAR(); __VA_ARGS__; } } SEAM(k); } while (0)
    PHASE(0, cvt_range(args, F, 0, 1, 0, F.G); p0_rows(args, F));
    const int T22 = (64 * 22) % F.G, T30 = (64 * 30) % F.G;
    PHASE(1, RUN_GEMM(EpiSwiglu, true, XB, ws + WS_WA13, 2 * FF, D, D, 0, ss, ACT); cvt_range(args, F, 1, 4, T22, F.G - T22); cvt_range(args, F, 7, 10, T22, F.G - T22));
    PHASE(2, RUN_GEMM(EpiResidIn, true, ACT, ws + WS_WA2, D, FF, FF, 0, args.in[I_X], nullptr, XB, ss + M, 0.5f, RED));
    PHASE(3, RUN_GEMM(EpiWin, true, XB, ws + WS_WIN, 2048, D, D, 0, ss + M, (bf16_t*)(ws + WS_GB), (bf16_t*)(ws + WS_REC)));
    PHASE(4, conv_phase(args, F));
    PHASE(5, RUN_GEMM(EpiGate, true, ws + WS_Y, ws + WS_WRI, 2048, 256, D, 2, (const bf16_t*)(ws + WS_Y), args.in[I_ABR], args.in[I_ABI], (const float*)(ws + WS_SP8), (bf16_t*)(ws + WS_REC), (bf16_t*)(ws + WS_U)));
    PHASE(6, scan_a(args, F));
    PHASE(7, scan_b(args, F));
    PHASE(8, RUN_GEMM(EpiResidMid, true, ws + WS_Y, ws + WS_WOUT, D, D, D, 0, nullptr, nullptr, XB, ss + 2 * M, 1.0f, RED));
    PHASE(9, RUN_GEMM(EpiSwiglu, true, XB, ws + WS_WB13, 2 * FF, D, D, 0, ss + 2 * M, ACT); cvt_range(args, F, 4, 7, T22, F.G - T22));
    PHASE(10, RUN_GEMM(EpiResidMid, true, ACT, ws + WS_WB2, D, FF, FF, 0, nullptr, nullptr, XB, ss + 3 * M, 0.5f, RED));
    PHASE(11, RUN_GEMM(EpiKvSwiglu, true, XB, ws + WS_WKV, 2048 + 2 * FF, D, D, 0, ss + 3 * M, args.in[I_KN], (bf16_t*)(ws + WS_K), (bf16_t*)(ws + WS_VT), ACT); cvt_range(args, F, 10, 14, T30, F.G - T30));
    PHASE(12, RUN_GEMM(EpiResidMid, true, ACT, ws + WS_WC2, D, FF, FF, 0, nullptr, nullptr, XB, ss + 4 * M, 0.5f, RED));
    PHASE(13, RUN_GEMM(EpiQ, true, XB, ws + WS_WQ, D, D, D, 0, ss + 4 * M, args.in[I_QN], (bf16_t*)(ws + WS_Q)));
    PHASE(14, attn_phase(args, F));
    PHASE(15, RUN_GEMM(EpiResidMid, true, ws + WS_O, ws + WS_WO, D, D, D, 0, nullptr, nullptr, XB, ss + 5 * M, 1.0f, RED));
    PHASE(16, RUN_GEMM(EpiSwiglu, true, XB, ws + WS_WA13, 2 * FF, D, D, 0, ss + 5 * M, ACT));
    PHASE(17, RUN_GEMM(EpiResidOut, true, ACT, ws + WS_WA2, D, FF, FF, 0, nullptr, args.out, XB, nullptr, 0.5f, RED));
}

extern "C" void kernel_launch(void* const* d_in, const int* in_sizes, int n_in, void* d_out, int out_size, void* d_ws, size_t ws_size, hipStream_t stream) {
    static int grid = 0;
    if (grid == 0) {
        if (n_in != 23 || out_size != M * D || ws_size < WS_END) { fprintf(stderr, "kernel_launch: unexpected problem (n_in %d out %d ws %zu)\n", n_in, out_size, ws_size); grid = -1; return; }
        int dev = 0, cus = 0, per_cu = 0;
        (void)hipGetDevice(&dev); (void)hipDeviceGetAttribute(&cus, hipDeviceAttributeMultiprocessorCount, dev);
        if (hipFuncSetAttribute((const void*)fwd_kernel, hipFuncAttributeMaxDynamicSharedMemorySize, LDS_BYTES) != hipSuccess) { fprintf(stderr, "kernel_launch: hipFuncSetAttribute failed\n"); grid = -1; return; }
        if (hipOccupancyMaxActiveBlocksPerMultiprocessor(&per_cu, (const void*)fwd_kernel, NTHR, LDS_BYTES) != hipSuccess || per_cu < 1) { fprintf(stderr, "kernel_launch: occupancy query says %d\n", per_cu); per_cu = 1; }
        (void)hipGetLastError();
        grid = cus * 1;
        if (grid <= 0) grid = 256;
    }
    if (grid < 0) return;
    Args a{};
    for (int i = 0; i < 23; ++i) a.in[i] = (const float*)d_in[i];
    a.out = (float*)d_out; a.ws = (unsigned char*)d_ws;
#if MK_COOP
    a.ph_lo = 0; a.ph_hi = N_PHASES;
    if (hipMemsetAsync(d_ws, 0, 16 * KiB, stream) != hipSuccess) { fprintf(stderr, "kernel_launch: memset of the barrier words failed\n"); return; }
    void* kargs[] = {&a};
    hipError_t e = hipLaunchCooperativeKernel((const void*)fwd_kernel, dim3(grid), dim3(NTHR), kargs, LDS_BYTES, stream);
    if (e != hipSuccess) fprintf(stderr, "kernel_launch: cooperative launch failed: %s (grid %d)\n", hipGetErrorString(e), grid);
#else
    for (int p = 0; p < N_PHASES; ++p) { a.ph_lo = p; a.ph_hi = p + 1; hipLaunchKernelGGL(fwd_kernel, dim3(grid), dim3(NTHR), LDS_BYTES, stream, a); }
#endif
}
```

```cpp
#include <hip/hip_runtime.h>
#include <hip/hip_cooperative_groups.h>
#include <cstdio>
#include <cstdint>
#include <cmath>
namespace cg = cooperative_groups;

#ifndef MK_COOP
#define MK_COOP 1
#endif

#define LAS __attribute__((address_space(3)))
typedef unsigned short bf16_t;
typedef short bf16x8 __attribute__((ext_vector_type(8)));
typedef float f32x4 __attribute__((ext_vector_type(4)));
typedef float f32x2 __attribute__((ext_vector_type(2)));
typedef float f32x16 __attribute__((ext_vector_type(16)));
typedef unsigned u32x4 __attribute__((ext_vector_type(4)));
typedef unsigned u32x2 __attribute__((ext_vector_type(2)));

constexpr int BATCH = 4, SEQ = 4096, D = 1024, FF = 2816, NH = 16, HD = 64;
constexpr int M = BATCH * SEQ;
constexpr float EPS = 1e-6f;
constexpr float LOG2E = 1.4426950408889634f, LN2 = 0.6931471805599453f;

constexpr size_t MiB = 1u << 20, KiB = 1u << 10;
constexpr size_t WS_SS = 64 * KiB;
constexpr size_t WS_SP8 = 32 * KiB;
constexpr size_t WS_HL = 1 * MiB, WS_PC = 2 * MiB;
constexpr size_t SZ_W13 = (size_t)2 * FF * D * 2, SZ_W2 = (size_t)D * FF * 2;
constexpr size_t WS_WA13 = 4 * MiB, WS_WA2 = WS_WA13 + SZ_W13;
constexpr size_t WS_WB13 = WS_WA2 + SZ_W2, WS_WB2 = WS_WB13 + SZ_W13;
constexpr size_t WS_WKV = WS_WB2 + SZ_W2, WS_WC13 = WS_WKV + 4 * MiB, WS_WC2 = WS_WC13 + SZ_W13;
constexpr size_t WS_WIN = WS_WC2 + SZ_W2, WS_WRI = WS_WIN + 4 * MiB, WS_WOUT = WS_WRI + 1 * MiB, WS_WQ = WS_WOUT + 2 * MiB, WS_WO = WS_WQ + 2 * MiB;
constexpr size_t WS_XB = 69 * MiB;
constexpr size_t WS_ACT = 101 * MiB;
constexpr size_t WS_K = 189 * MiB, WS_VT = 221 * MiB, WS_END = 253 * MiB;
constexpr size_t WS_GB = WS_ACT, WS_U = WS_ACT + 32 * MiB, WS_REC = WS_ACT + 64 * MiB;
constexpr size_t WS_Y = WS_ACT + 96 * MiB;
constexpr size_t WS_Q = WS_ACT, WS_O = WS_ACT + 32 * MiB;
static_assert(WS_WO + 2 * MiB <= WS_XB && WS_REC + 64 * MiB <= WS_END, "ws map");

__device__ __forceinline__ unsigned cvt_pk_bf16(float lo, float hi) {
    typedef __bf16 bf16x2_t __attribute__((ext_vector_type(2)));
    f32x2 v = {lo, hi}; bf16x2_t b = __builtin_convertvector(v, bf16x2_t); return __builtin_bit_cast(unsigned, b);
}
__device__ __forceinline__ float bf_lo(unsigned w) { return __uint_as_float(w << 16); }
__device__ __forceinline__ float bf_hi(unsigned w) { return __uint_as_float(w & 0xffff0000u); }
__device__ __forceinline__ float sigm(float x) { return __builtin_amdgcn_rcpf(1.0f + __builtin_amdgcn_exp2f(-x * LOG2E)); }
__device__ __forceinline__ float gelu_tanh(float x) { return x * sigm(1.5957691216057308f * (x + 0.044715f * x * x * x)); }
__device__ __forceinline__ float wave_sum(float v) {
#pragma unroll
    for (int o = 1; o < 64; o <<= 1) v += __shfl_xor(v, o);
    return v;
}
#define LDS_WAIT() asm volatile("s_waitcnt lgkmcnt(0)" ::: "memory")

namespace pg8 {
constexpr int BM = 256, BK = 64, HALF = 128, HTB = HALF * BK * 2, STAGE_BYTES = 8 * HTB, NXCD = 8, WGM = 4;
__host__ __device__ __forceinline__ int lds_byte(int r, int c) { const int st = (r >> 4) * 2 + (c >> 5), rr = r & 15, cc = c & 31, ob = rr * 64 + cc * 2; return st * 1024 + (ob ^ (((ob >> 9) & 1) << 5)); }
__host__ __device__ __forceinline__ void stage_rc(int b, int& R, int& C) { const int st = b / 1024, sb = b % 1024, swz = sb ^ (((sb >> 9) & 1) << 5); R = (st >> 1) * 16 + swz / 64; C = (st & 1) * 32 + (swz % 64) / 2; }
__host__ __device__ __forceinline__ int perm32(int rho) { const int n = rho >> 4, i = rho & 15; return 8 * (i >> 2) + 4 * n + (i & 3); }

struct Unit { int pm, pn; };
struct Gemm { const bf16_t* A; const bf16_t* Bt; int M, N, K, lda, adiv; };

static_assert((16384 / BM) % WGM == 0, "row panels must fill whole groups");
struct StaticOrder {
    int nM, nN, nwg, G, c;
    __device__ void init(int M_, int N_, int G_, int c_) { nM = M_ / BM; nN = N_ / BM; nwg = nM * nN; G = G_; c = c_; }
    __device__ bool next(int i, Unit& u) const {
        const long L = (long)i * G + c; if (L >= nwg) return false;
        int wgid = (int)L; { const int q = nwg / NXCD, r = nwg % NXCD, xcd = wgid % NXCD, off = wgid / NXCD; wgid = (xcd < r ? xcd * (q + 1) : r * (q + 1) + (xcd - r) * q) + off; }
        const int nig = WGM * nN, gid = wgid / nig, fm = gid * WGM; constexpr int gsz = WGM;
        u.pm = fm + ((wgid % nig) % gsz); u.pn = (wgid % nig) / gsz; return true;
    }
};

template <class Epi, bool ALIGN_EPI>
__device__ __forceinline__ void gemm_phase(LAS unsigned char* lds, const Gemm g, const StaticOrder& S, const Epi& E) {
    const int tid = threadIdx.x, wid = __builtin_amdgcn_readfirstlane(tid >> 6), lane = tid & 63, wr = wid >> 2, wc = wid & 3, fr = lane & 15, fq = lane >> 4;
    const int K = g.K, nt = K / BK, lda = g.lda;
    unsigned voffA[2], voffB[2];
#pragma unroll
    for (int i = 0; i < 2; ++i) { int R, C; stage_rc(tid * 16 + i * 8192, R, C); const int Rb = (R & ~31) + perm32(R & 31);
        voffA[i] = (unsigned)(R * lda + C) * 2u; voffB[i] = (unsigned)(Rb * K + C) * 2u; }
    const size_t kstep = (size_t)(BK * 2);
    const size_t hA = (size_t)HALF * lda * 2, hB = (size_t)HALF * K * 2;
    const size_t tA = 2 * hA, tB = 2 * hB;
    const unsigned ldsw = (unsigned)wid * 1024u;
    const int aoff = lds_byte(wr * 64 + fr, fq * 8), boff = lds_byte(wc * 32 + fr, fq * 8);
#define PG8_SA(b, h) (((b) * 2 + (h)) * HTB)
#define PG8_SB(b, h) ((4 + (b) * 2 + (h)) * HTB)
#define PG8_STAGE(bufoff, gbase, voff) do { _Pragma("unroll") for (int _i = 0; _i < 2; ++_i) \
        __builtin_amdgcn_global_load_lds((const unsigned*)((const char*)(gbase) + (voff)[_i]), (LAS unsigned*)(lds + (bufoff) + ldsw + _i * 8192), 16, 0, 0); } while (0)
#define PG8_LDA(dst, b, h) do { _Pragma("unroll") for (int m = 0; m < 4; ++m) _Pragma("unroll") for (int k = 0; k < 2; ++k) dst[m][k] = *(const LAS bf16x8*)(lds + PG8_SA(b, h) + aoff + m * 2048 + k * 1024); } while (0)
#define PG8_LDB(dst, b, h) do { _Pragma("unroll") for (int n = 0; n < 2; ++n) _Pragma("unroll") for (int k = 0; k < 2; ++k) dst[n][k] = *(const LAS bf16x8*)(lds + PG8_SB(b, h) + boff + n * 2048 + k * 1024); } while (0)
#define PG8_MMA(ai, bj, At, Bt) do { __builtin_amdgcn_s_setprio(1); _Pragma("unroll") for (int m = 0; m < 4; ++m) _Pragma("unroll") for (int n = 0; n < 2; ++n) _Pragma("unroll") for (int k = 0; k < 2; ++k) \
        acc[ai][bj][m][n] = __builtin_amdgcn_mfma_f32_16x16x32_bf16(Bt[n][k], At[m][k], acc[ai][bj][m][n], 0, 0, 0); __builtin_amdgcn_s_setprio(0); } while (0)
#define PG8_WAIT_V(n) asm volatile("s_waitcnt vmcnt(" #n ")" ::: "memory")
#define PG8_WAIT_L(n) asm volatile("s_waitcnt lgkmcnt(" #n ")" ::: "memory")
#define PG8_BAR __builtin_amdgcn_s_barrier()
#define PG8_SCHED __builtin_amdgcn_sched_barrier(0)
#define PG8_ABASE(u) ((const char*)g.A + (size_t)(u).pm * tA + (g.adiv ? (size_t)((u).pn / g.adiv) * K * 2 : (size_t)0))
#define PG8_BBASE(u) ((const char*)g.Bt + (size_t)(u).pn * tB)
    Unit cur, nxt; int ui = 0;
    if (!S.next(0, cur)) return;
    f32x4 acc[2][2][4][2];
#pragma unroll
    for (int a = 0; a < 2; ++a)
#pragma unroll
        for (int b = 0; b < 2; ++b)
#pragma unroll
            for (int m = 0; m < 4; ++m)
#pragma unroll
                for (int n = 0; n < 2; ++n) acc[a][b][m][n] = (f32x4){0.f, 0.f, 0.f, 0.f};
    bf16x8 At[4][2], B0[2][2], B1[2][2];
    const char* cA = PG8_ABASE(cur); const char* cB = PG8_BBASE(cur);
    PG8_STAGE(PG8_SB(0, 0), cB, voffB); PG8_STAGE(PG8_SB(0, 1), cB + hB, voffB); PG8_STAGE(PG8_SA(0, 0), cA, voffA); PG8_STAGE(PG8_SA(0, 1), cA + hA, voffA);
    if (wr == 1) PG8_BAR;
    PG8_WAIT_V(2); PG8_BAR;
    PG8_STAGE(PG8_SB(1, 0), cB + kstep, voffB); PG8_STAGE(PG8_SA(1, 0), cA + kstep, voffA); PG8_STAGE(PG8_SB(1, 1), cB + hB + kstep, voffB);
    PG8_WAIT_V(6); PG8_BAR;
    for (;;) {
        const bool has_next = S.next(ui + 1, nxt);
        const char* nA = has_next ? PG8_ABASE(nxt) : cA; const char* nB = has_next ? PG8_BBASE(nxt) : cB;
#pragma unroll 1
        for (int t = 0; t < nt; t += 2) {
            const bool last = (t == nt - 2);
            const char* a1 = cA + (size_t)(t + 1) * kstep;
            const char* a2 = last ? nA : cA + (size_t)(t + 2) * kstep; const char* b2 = last ? nB : cB + (size_t)(t + 2) * kstep;
            const char* a3 = a2 + kstep; const char* b3 = b2 + kstep;
            PG8_LDB(B0, 0, 0); PG8_LDB(B1, 0, 1); PG8_SCHED; PG8_LDA(At, 0, 0); PG8_STAGE(PG8_SA(1, 1), a1 + hA, voffA);
            PG8_WAIT_V(8); PG8_WAIT_L(0); PG8_BAR; PG8_MMA(0, 0, At, B0); PG8_MMA(0, 1, At, B1); PG8_BAR; PG8_SCHED;
            PG8_LDA(At, 0, 1); PG8_STAGE(PG8_SB(0, 0), b2, voffB); PG8_STAGE(PG8_SB(0, 1), b2 + hB, voffB); PG8_STAGE(PG8_SA(0, 0), a2, voffA);
            PG8_WAIT_V(8); PG8_WAIT_L(0); PG8_BAR; PG8_MMA(1, 0, At, B0); PG8_MMA(1, 1, At, B1); PG8_BAR; PG8_SCHED;
            PG8_LDB(B0, 1, 0); PG8_LDB(B1, 1, 1); PG8_SCHED; PG8_LDA(At, 1, 0); PG8_STAGE(PG8_SA(0, 1), a2 + hA, voffA);
            PG8_WAIT_V(8); PG8_WAIT_L(0); PG8_BAR; PG8_MMA(0, 0, At, B0); PG8_MMA(0, 1, At, B1); PG8_BAR; PG8_SCHED;
            PG8_LDA(At, 1, 1); PG8_STAGE(PG8_SB(1, 0), b3, voffB); PG8_STAGE(PG8_SB(1, 1), b3 + hB, voffB); PG8_STAGE(PG8_SA(1, 0), a3, voffA);
            PG8_WAIT_V(8); PG8_WAIT_L(0); PG8_BAR; PG8_MMA(1, 0, At, B0); PG8_MMA(1, 1, At, B1); PG8_BAR; PG8_SCHED;
        }
        if constexpr (ALIGN_EPI) { if (wr == 0) PG8_BAR; }
        E(acc, cur, wr, wc, fr, fq);
        if (!has_next) break;
#pragma unroll
        for (int a = 0; a < 2; ++a)
#pragma unroll
            for (int b = 0; b < 2; ++b)
#pragma unroll
                for (int m = 0; m < 4; ++m)
#pragma unroll
                    for (int n = 0; n < 2; ++n) acc[a][b][m][n] = (f32x4){0.f, 0.f, 0.f, 0.f};
        cur = nxt; cA = nA; cB = nB; ++ui;
        if constexpr (ALIGN_EPI) { if (wr == 1) PG8_BAR; }
    }
    PG8_WAIT_V(0);
    if constexpr (!ALIGN_EPI) { if (wr == 0) PG8_BAR; }
    PG8_BAR;
#undef PG8_SA
#undef PG8_SB
#undef PG8_STAGE
#undef PG8_LDA
#undef PG8_LDB
#undef PG8_MMA
#undef PG8_WAIT_V
#undef PG8_WAIT_L
#undef PG8_BAR
#undef PG8_SCHED
#undef PG8_ABASE
#undef PG8_BBASE
}

typedef f32x4 Acc[2][2][4][2];
__device__ __forceinline__ float rstd_of(const float* ss, int row) { return 1.0f / sqrtf(ss[row] * (1.0f / D) + EPS); }

__device__ __forceinline__ void rstd8(const float* ss, int rbase, float (&rs)[2][4]) {
    float t[2][4];
#pragma unroll
    for (int ai = 0; ai < 2; ++ai)
#pragma unroll
        for (int m = 0; m < 4; ++m) t[ai][m] = ss[rbase + ai * HALF + m * 16];
#pragma unroll
    for (int ai = 0; ai < 2; ++ai)
#pragma unroll
        for (int m = 0; m < 4; ++m) rs[ai][m] = __builtin_amdgcn_rsqf(t[ai][m] * (1.0f / D) + EPS);
}
__device__ __forceinline__ void epi_swiglu(const Acc& acc, int pm, int pnf, int wr, int wc, int fr, int fq, const float* ss, bf16_t* act) {
    const int col = pnf * 128 + wc * 32 + 8 * fq;
    float rs8[2][4]; rstd8(ss, pm * BM + wr * 64 + fr, rs8);
#pragma unroll
    for (int ai = 0; ai < 2; ++ai)
#pragma unroll
        for (int m = 0; m < 4; ++m) {
            const int row = pm * BM + ai * HALF + wr * 64 + m * 16 + fr; const float rs = rs8[ai][m];
            float o[8];
#pragma unroll
            for (int n = 0; n < 2; ++n)
#pragma unroll
                for (int j = 0; j < 4; ++j) { const float gt = acc[ai][0][m][n][j] * rs, up = acc[ai][1][m][n][j] * rs; o[n * 4 + j] = gt * sigm(gt) * up; }
            u32x4 w; w.x = cvt_pk_bf16(o[0], o[1]); w.y = cvt_pk_bf16(o[2], o[3]); w.z = cvt_pk_bf16(o[4], o[5]); w.w = cvt_pk_bf16(o[6], o[7]);
            __builtin_nontemporal_store(w, (u32x4*)(act + (size_t)row * FF + col));
        }
}
struct EpiSwiglu { const float* ss; bf16_t* act;
    __device__ __forceinline__ void operator()(const Acc& acc, const Unit& u, int wr, int wc, int fr, int fq) const { epi_swiglu(acc, u.pm, u.pn, wr, wc, fr, fq, ss, act); } };

template <bool IN_F32, bool FINAL> struct EpiResid { const float* xin; float* xout; bf16_t* xb; float* ssn; float alpha; LAS float* red;
    __device__ __forceinline__ void operator()(const Acc& acc, const Unit& u, int wr, int wc, int fr, int fq) const {
        const size_t cbase = (size_t)u.pn * BM + wc * 32 + 8 * fq;
#pragma unroll
        for (int ai = 0; ai < 2; ++ai) {
            f32x4 xr[4][2][2];
#pragma unroll
            for (int m = 0; m < 4; ++m)
#pragma unroll
                for (int bj = 0; bj < 2; ++bj) {
                    const size_t off = (size_t)(u.pm * BM + ai * HALF + wr * 64 + m * 16 + fr) * D + cbase + bj * HALF;
                    if (IN_F32) { xr[m][bj][0] = *(const f32x4*)(xin + off); xr[m][bj][1] = *(const f32x4*)(xin + off + 4); }
                    else { const u32x4 xw = *(const u32x4*)(xb + off); xr[m][bj][0] = __builtin_bit_cast(f32x4, xw); }
                }
#pragma unroll
            for (int m = 0; m < 4; ++m) {
                const int row = u.pm * BM + ai * HALF + wr * 64 + m * 16 + fr; float sq = 0.f;
#pragma unroll
                for (int bj = 0; bj < 2; ++bj) {
                    const size_t off = (size_t)row * D + cbase + bj * HALF;
                    f32x4 x0, x1;
                    if (IN_F32) { x0 = xr[m][bj][0]; x1 = xr[m][bj][1]; }
                    else { const u32x4 xw = __builtin_bit_cast(u32x4, xr[m][bj][0]); x0 = (f32x4){bf_lo(xw.x), bf_hi(xw.x), bf_lo(xw.y), bf_hi(xw.y)}; x1 = (f32x4){bf_lo(xw.z), bf_hi(xw.z), bf_lo(xw.w), bf_hi(xw.w)}; }
                    const f32x4 y0 = x0 + acc[ai][bj][m][0] * alpha, y1 = x1 + acc[ai][bj][m][1] * alpha;
                    if (FINAL) { *(f32x4*)(xout + off) = y0; *(f32x4*)(xout + off + 4) = y1; }
                    else {
                        sq += (y0[0] * y0[0] + y0[1] * y0[1]) + (y0[2] * y0[2] + y0[3] * y0[3]) + (y1[0] * y1[0] + y1[1] * y1[1]) + (y1[2] * y1[2] + y1[3] * y1[3]);
                        u32x4 w; w.x = cvt_pk_bf16(y0[0], y0[1]); w.y = cvt_pk_bf16(y0[2], y0[3]); w.z = cvt_pk_bf16(y1[0], y1[1]); w.w = cvt_pk_bf16(y1[2], y1[3]);
                        *(u32x4*)(xb + off) = w;
                    }
                }
                if (!FINAL) { sq += __shfl_xor(sq, 16); sq += __shfl_xor(sq, 32); if (fq == 0) red[(ai * HALF + wr * 64 + m * 16 + fr) * 4 + wc] = sq; }
            }
        }
        if (!FINAL) {
            asm volatile("s_waitcnt lgkmcnt(0)" ::: "memory"); __builtin_amdgcn_s_barrier(); asm volatile("" ::: "memory");
            const int t = threadIdx.x;
            if (t < BM) { const f32x4 v = ((const LAS f32x4*)red)[t]; atomicAdd(ssn + u.pm * BM + t, (v[0] + v[1]) + (v[2] + v[3])); }
        }
    } };
typedef EpiResid<true, false> EpiResidIn; typedef EpiResid<false, false> EpiResidMid; typedef EpiResid<false, true> EpiResidOut;

struct EpiWin { const float* ss; bf16_t* gb; bf16_t* rec;
    __device__ __forceinline__ void operator()(const Acc& acc, const Unit& u, int wr, int wc, int fr, int fq) const {
        const bool isg = u.pn < 4; const int ct = (u.pn & 3) * BM;
        float rs8[2][4]; rstd8(ss, u.pm * BM + wr * 64 + fr, rs8);
#pragma unroll
        for (int ai = 0; ai < 2; ++ai)
#pragma unroll
            for (int m = 0; m < 4; ++m) {
                const int row = u.pm * BM + ai * HALF + wr * 64 + m * 16 + fr; const float rs = rs8[ai][m];
#pragma unroll
                for (int bj = 0; bj < 2; ++bj) {
                    const size_t off = (size_t)row * D + ct + bj * HALF + wc * 32 + 8 * fq;
                    const f32x4 v0 = acc[ai][bj][m][0] * rs, v1 = acc[ai][bj][m][1] * rs;
                    if (isg) { u32x4 w; w.x = cvt_pk_bf16(gelu_tanh(v0[0]), gelu_tanh(v0[1])); w.y = cvt_pk_bf16(gelu_tanh(v0[2]), gelu_tanh(v0[3]));
                        w.z = cvt_pk_bf16(gelu_tanh(v1[0]), gelu_tanh(v1[1])); w.w = cvt_pk_bf16(gelu_tanh(v1[2]), gelu_tanh(v1[3])); *(u32x4*)(gb + off) = w; }
                    else { u32x4 w; w.x = cvt_pk_bf16(v0[0], v0[1]); w.y = cvt_pk_bf16(v0[2], v0[3]); w.z = cvt_pk_bf16(v1[0], v1[1]); w.w = cvt_pk_bf16(v1[2], v1[3]); *(u32x4*)(rec + off) = w; }
                }
            }
    } };

struct EpiGate { const bf16_t* xc; const float* b_r; const float* b_i; const float* sp8; bf16_t* aout; bf16_t* uout;
    __device__ __forceinline__ void operator()(const Acc& acc, const Unit& u, int wr, int wc, int fr, int fq) const {
        const int ch = u.pn * 128 + wc * 32 + 8 * fq;
        float br[8], bi[8], sp[8];
#pragma unroll
        for (int n = 0; n < 2; ++n) { const f32x4 a_ = *(const f32x4*)(b_r + ch + 4 * n), b_ = *(const f32x4*)(b_i + ch + 4 * n), c_ = *(const f32x4*)(sp8 + ch + 4 * n);
#pragma unroll
            for (int j = 0; j < 4; ++j) { br[4 * n + j] = a_[j]; bi[4 * n + j] = b_[j]; sp[4 * n + j] = c_[j]; } }
        u32x4 xcw[2][4];
#pragma unroll
        for (int ai = 0; ai < 2; ++ai)
#pragma unroll
            for (int m = 0; m < 4; ++m) xcw[ai][m] = *(const u32x4*)(xc + (size_t)(u.pm * BM + ai * HALF + wr * 64 + m * 16 + fr) * D + ch);
#pragma unroll
        for (int ai = 0; ai < 2; ++ai)
#pragma unroll
            for (int m = 0; m < 4; ++m) {
                const int row = u.pm * BM + ai * HALF + wr * 64 + m * 16 + fr; const size_t off = (size_t)row * D + ch;
                const u32x4 xw = xcw[ai][m];
                const float xv[8] = {bf_lo(xw.x), bf_hi(xw.x), bf_lo(xw.y), bf_hi(xw.y), bf_lo(xw.z), bf_hi(xw.z), bf_lo(xw.w), bf_hi(xw.w)};
                float av[8], uv[8];
#pragma unroll
                for (int j = 0; j < 8; ++j) {
                    const float r = sigm(acc[ai][0][m][j >> 2][j & 3] + br[j]), ig = sigm(acc[ai][1][m][j >> 2][j & 3] + bi[j]);
                    const float la2 = r * sp[j];
                    const float a = __builtin_amdgcn_exp2f(la2);
                    av[j] = la2; uv[j] = __builtin_amdgcn_sqrtf(fmaxf(1.0f - a * a, 0.f)) * ig * xv[j];
                }
                u32x4 wa; wa.x = cvt_pk_bf16(av[0], av[1]); wa.y = cvt_pk_bf16(av[2], av[3]); wa.z = cvt_pk_bf16(av[4], av[5]); wa.w = cvt_pk_bf16(av[6], av[7]);
                *(u32x4*)(aout + off) = wa;
                u32x4 w; w.x = cvt_pk_bf16(uv[0], uv[1]); w.y = cvt_pk_bf16(uv[2], uv[3]); w.z = cvt_pk_bf16(uv[4], uv[5]); w.w = cvt_pk_bf16(uv[6], uv[7]);
                *(u32x4*)(uout + off) = w;
            }
    } };

__device__ __forceinline__ void epi_headnorm(const Acc& acc, int pm, int pnh, int wr, int wc, int fr, int fq, const float* ss, const float* gain, float oscale, bf16_t* out) {
    const int head = 4 * pnh + wc;
    float sc[2][4]; rstd8(ss, pm * BM + wr * 64 + fr, sc);
#pragma unroll
    for (int ai = 0; ai < 2; ++ai)
#pragma unroll
        for (int m = 0; m < 4; ++m) {
            const float rs = sc[ai][m];
            float sq = 0.f;
#pragma unroll
            for (int bj = 0; bj < 2; ++bj)
#pragma unroll
                for (int n = 0; n < 2; ++n) { const f32x4 v = acc[ai][bj][m][n]; sq += (v[0] * v[0] + v[1] * v[1]) + (v[2] * v[2] + v[3] * v[3]); }
            sq += __shfl_xor(sq, 16); sq += __shfl_xor(sq, 32);
            sc[ai][m] = rs * oscale * __builtin_amdgcn_rsqf(sq * rs * rs * (1.0f / HD) + EPS);
        }
#pragma unroll
    for (int bj = 0; bj < 2; ++bj) {
        const f32x4 g0 = *(const f32x4*)(gain + 32 * bj + 8 * fq), g1 = *(const f32x4*)(gain + 32 * bj + 8 * fq + 4);
#pragma unroll
        for (int ai = 0; ai < 2; ++ai)
#pragma unroll
            for (int m = 0; m < 4; ++m) {
                const int row = pm * BM + ai * HALF + wr * 64 + m * 16 + fr;
                const f32x4 v0 = acc[ai][bj][m][0] * g0 * sc[ai][m], v1 = acc[ai][bj][m][1] * g1 * sc[ai][m];
                u32x4 w; w.x = cvt_pk_bf16(v0[0], v0[1]); w.y = cvt_pk_bf16(v0[2], v0[3]); w.z = cvt_pk_bf16(v1[0], v1[1]); w.w = cvt_pk_bf16(v1[2], v1[3]);
                *(u32x4*)(out + (size_t)row * D + head * HD + 32 * bj + 8 * fq) = w;
                asm volatile("" ::: "memory");
            }
    }
}
struct EpiQ { const float* ss; const float* gain; bf16_t* q;
    __device__ __forceinline__ void operator()(const Acc& acc, const Unit& u, int wr, int wc, int fr, int fq) const { epi_headnorm(acc, u.pm, u.pn, wr, wc, fr, fq, ss, gain, 0.125f * LOG2E, q); } };
struct EpiKvSwiglu { const float* ss; const float* kgain; bf16_t* kout; bf16_t* vt; bf16_t* act;
    __device__ __forceinline__ void operator()(const Acc& acc, const Unit& u, int wr, int wc, int fr, int fq) const {
        if (u.pn >= 8) { epi_swiglu(acc, u.pm, u.pn - 8, wr, wc, fr, fq, ss, act); return; }
        if (u.pn < 4) { epi_headnorm(acc, u.pm, u.pn, wr, wc, fr, fq, ss, kgain, 1.0f, kout); return; }
        const int head = 4 * (u.pn - 4) + wc;
        float rs8[2][4]; rstd8(ss, u.pm * BM + wr * 64 + fr, rs8);
        const int row0 = u.pm * BM + wr * 64 + fr, b = row0 / SEQ, s0 = row0 % SEQ;
        bf16_t* base = vt + ((size_t)(b * NH + head) * HD + 8 * fq) * SEQ + s0;
#pragma unroll
        for (int bj = 0; bj < 2; ++bj)
#pragma unroll
            for (int j = 0; j < 8; ++j) {
                bf16_t* p = base + (size_t)(32 * bj + j) * SEQ;
#pragma unroll
                for (int ai = 0; ai < 2; ++ai)
#pragma unroll
                    for (int m = 0; m < 4; ++m) p[ai * HALF + m * 16] = (bf16_t)(cvt_pk_bf16(acc[ai][bj][m][j >> 2][j & 3] * rs8[ai][m], 0.f) & 0xffffu);
                asm volatile("" ::: "memory");
            }
    } };
}


#define XB_TMO      128
#define XB_XCNT(j)  (256  + 64 * (j))
#define XB_XSUB(j)  (1280 + 64 * (j))
#define XB_XGEN(j)  (2304 + 64 * (j))
#define XB_TOP      3328
#define XB_TOPGEN   3392
#define XCD_BAR_WORDS 3456
#define XB_SPIN_CAP (1u << 18)
__device__ __forceinline__ unsigned xb_ld(unsigned* p)              { return __hip_atomic_load(p, __ATOMIC_RELAXED, __HIP_MEMORY_SCOPE_AGENT); }
__device__ __forceinline__ unsigned xb_add(unsigned* p, unsigned v) { return __hip_atomic_fetch_add(p, v, __ATOMIC_RELAXED, __HIP_MEMORY_SCOPE_AGENT); }
__device__ __forceinline__ unsigned xb_xcc_id() { return (unsigned)__builtin_amdgcn_s_getreg((3 << 11) | 20) & 0xFu; }
#define XB_SPIN(cond, bar) do { unsigned _sp = 0; while (cond) { __builtin_amdgcn_s_sleep(1); \
    if ((++_sp & 255u) == 0u) { if (xb_ld(&(bar)[XB_TMO])) break; if (_sp > XB_SPIN_CAP) { atomicAdd(&(bar)[XB_TMO], 1u); break; } } } } while (0)
struct XcdBarrier { unsigned* bar; unsigned x; volatile LAS unsigned* st; };
__device__ __forceinline__ XcdBarrier xcd_barrier_post(unsigned* bar, volatile LAS unsigned* st) {
    XcdBarrier b; b.bar = bar; b.x = xb_xcc_id(); b.st = st;
    if (threadIdx.x == 0) (void)xb_add(&bar[XB_XCNT(b.x)], 1u);
    return b;
}
__device__ __forceinline__ void xcd_barrier_complete(unsigned* bar, unsigned x, unsigned& nloc, unsigned& nx) {
    const unsigned G = gridDim.x * gridDim.y * gridDim.z;
    unsigned sum, cnt, mine, sp = 0u;
    for (;;) {
        sum = 0u; cnt = 0u; mine = 0u;
#pragma unroll
        for (unsigned j = 0; j < 16; ++j) { const unsigned c = xb_ld(&bar[XB_XCNT(j)]); sum += c; cnt += (c > 0u) ? 1u : 0u; mine = (j == x) ? c : mine; }
        if (sum == G) break;
        __builtin_amdgcn_s_sleep(1);
        if ((++sp & 255u) == 0u) { if (xb_ld(&bar[XB_TMO])) break; if (sp > XB_SPIN_CAP) { atomicAdd(&bar[XB_TMO], 1u); break; } }
    }
    nloc = mine > 0u ? mine : 1u; nx = cnt > 0u ? cnt : 1u;
}
__device__ __forceinline__ void xcd_barrier(const XcdBarrier& b) {
    asm volatile("s_waitcnt vmcnt(0)" ::: "memory");
    __syncthreads();
    if (threadIdx.x == 0) {
        unsigned* bar = b.bar;
        __builtin_amdgcn_s_waitcnt(0);
        unsigned nloc = b.st[0], nx = b.st[1];
        if (nloc == 0u) { xcd_barrier_complete(bar, b.x, nloc, nx); b.st[0] = nloc; b.st[1] = nx; }
        const unsigned old = xb_add(&bar[XB_XSUB(b.x)], 1u);
        const unsigned gen = old / nloc;
        if (old + 1u == (gen + 1u) * nloc) {
            __builtin_amdgcn_fence(__ATOMIC_RELEASE, "agent");
            asm volatile("s_waitcnt vmcnt(0)" ::: "memory");
            const unsigned og = xb_add(&bar[XB_TOP], 1u);
            const unsigned tg = og / nx;
            if (og + 1u == (tg + 1u) * nx) xb_add(&bar[XB_TOPGEN], 1u);
            else XB_SPIN(xb_ld(&bar[XB_TOPGEN]) == tg, bar);
            __builtin_amdgcn_fence(__ATOMIC_ACQUIRE, "agent");
            xb_add(&bar[XB_XGEN(b.x)], 1u);
            asm volatile("s_waitcnt vmcnt(0)" ::: "memory");
        } else {
            XB_SPIN(xb_ld(&bar[XB_XGEN(b.x)]) == gen, bar);
            __builtin_amdgcn_fence(__ATOMIC_ACQUIRE, "agent");
            asm volatile("s_waitcnt vmcnt(0)" ::: "memory");
        }
    }
    __syncthreads();
}

constexpr int N_PHASES = 18;
constexpr int NWAVES = 8, NTHR = NWAVES * 64;
constexpr int MISC_OFF = 8 * 16896, LDS_BYTES = MISC_OFF + 256;

struct Args { const float* in[23]; float* out; unsigned char* ws; int ph_lo, ph_hi; };

struct Frame { LAS unsigned char* lds; int tid, lane, wave, G, gw, NGW; };

struct CvtDesc { const float* W; const float* W2; bf16_t* dst; const float* gain; int ldw, K, nb, mode; };
constexpr int SCR_STRIDE = 64 * 65 * 4;
__device__ __forceinline__ void cvt_item(const CvtDesc& d, int local, LAS float* scr, int lane) {
    const int kb = local / d.nb, gI = local % d.nb, k0 = 64 * kb, n0 = 64 * gI;
    const int l16 = lane & 15, l4 = lane >> 4, n = n0 + 4 * l16;
    const float* W = d.W; int c0;
    if (d.mode == 0) c0 = n;
    else if (d.mode == 1) { const int tile = n >> 8, bj = (n >> 7) & 1, j0 = n & 127; c0 = bj * FF + tile * 128 + j0; }
    else if (d.mode == 2) { const int pn = n >> 8, bj = (n >> 7) & 1, wc = (n >> 5) & 3, j0 = n & 31; c0 = 256 * pn + 64 * wc + 32 * bj + j0; }
    else { const int t = n >> 8, blk = t >> 1, half = t & 1, which = (n >> 7) & 1, j0 = n & 127; W = (which ? d.W2 : d.W) + (size_t)blk * 65536; c0 = half * 128 + j0; }
    const float* wp = W + (size_t)(k0 + l4) * d.ldw + c0;
    f32x4 v[16];
#pragma unroll
    for (int i = 0; i < 16; ++i) v[i] = *(const f32x4*)(wp + (size_t)(4 * i) * d.ldw);
    if (d.gain) {
#pragma unroll
        for (int i = 0; i < 16; ++i) v[i] *= d.gain[k0 + 4 * i + l4];
    }
#pragma unroll
    for (int i = 0; i < 16; ++i) { LAS float* s = scr + (4 * i + l4) * 65 + 4 * l16; s[0] = v[i][0]; s[1] = v[i][1]; s[2] = v[i][2]; s[3] = v[i][3]; }
    LDS_WAIT(); asm volatile("" ::: "memory");
    const int c = lane & 7;
#pragma unroll
    for (int j = 0; j < 8; ++j) { const int nn = (lane >> 3) + 8 * j; const LAS float* s = scr + (8 * c) * 65 + nn;
        u32x4 o; o.x = cvt_pk_bf16(s[0 * 65], s[1 * 65]); o.y = cvt_pk_bf16(s[2 * 65], s[3 * 65]); o.z = cvt_pk_bf16(s[4 * 65], s[5 * 65]); o.w = cvt_pk_bf16(s[6 * 65], s[7 * 65]);
        *(u32x4*)(d.dst + (size_t)(n0 + nn) * d.K + k0 + 8 * c) = o; }
    LDS_WAIT(); asm volatile("" ::: "memory");
}
enum { I_X = 0, I_F1N, I_F1W13, I_F1W2, I_MIXN, I_AWIN, I_ACW, I_ACB, I_AWR, I_ABR, I_AWI, I_ABI, I_ALAM, I_AWOUT, I_KVN, I_WKV, I_KN, I_BWQ, I_QN, I_BWO, I_F2N, I_F2W13, I_F2W2 };
constexpr int IT_W13 = (D / 64) * (2 * FF / 64), IT_W2 = (FF / 64) * (D / 64), IT_2048 = (D / 64) * (2048 / 64), IT_1024 = (D / 64) * (D / 64), IT_RI = (256 / 64) * (2048 / 64);
__device__ __forceinline__ CvtDesc cvt_desc(const Args& a, int id) {
    unsigned char* ws = a.ws; CvtDesc d; d.W2 = nullptr; d.gain = nullptr;
    switch (id) {
    case 0: d = {a.in[I_F1W13], nullptr, (bf16_t*)(ws + WS_WA13), a.in[I_F1N], 2 * FF, D, 2 * FF / 64, 1}; break;
    case 1: d = {a.in[I_F1W2], nullptr, (bf16_t*)(ws + WS_WA2), nullptr, D, FF, D / 64, 0}; break;
    case 2: d = {a.in[I_F2W13], nullptr, (bf16_t*)(ws + WS_WB13), a.in[I_F2N], 2 * FF, D, 2 * FF / 64, 1}; break;
    case 3: d = {a.in[I_F2W2], nullptr, (bf16_t*)(ws + WS_WB2), nullptr, D, FF, D / 64, 0}; break;
    case 4: d = {a.in[I_WKV], nullptr, (bf16_t*)(ws + WS_WKV), a.in[I_KVN], 2048, D, 2048 / 64, 2}; break;
    case 5: d = {a.in[I_F1W13] + (size_t)D * 2 * FF, nullptr, (bf16_t*)(ws + WS_WC13), a.in[I_F1N] + D, 2 * FF, D, 2 * FF / 64, 1}; break;
    case 6: d = {a.in[I_F1W2] + (size_t)FF * D, nullptr, (bf16_t*)(ws + WS_WC2), nullptr, D, FF, D / 64, 0}; break;
    case 7: d = {a.in[I_AWIN], nullptr, (bf16_t*)(ws + WS_WIN), a.in[I_MIXN], 2048, D, 2048 / 64, 0}; break;
    case 8: d = {a.in[I_AWR], a.in[I_AWI], (bf16_t*)(ws + WS_WRI), nullptr, 256, 256, 2048 / 64, 3}; break;
    case 9: d = {a.in[I_AWOUT], nullptr, (bf16_t*)(ws + WS_WOUT), nullptr, D, D, D / 64, 0}; break;
    case 10: d = {a.in[I_BWQ], nullptr, (bf16_t*)(ws + WS_WQ), a.in[I_MIXN] + D, D, D, D / 64, 2}; break;
    case 11: d = {a.in[I_BWO], nullptr, (bf16_t*)(ws + WS_WO), nullptr, D, D, D / 64, 0}; break;
    case 12: d = {a.in[I_F2W13] + (size_t)D * 2 * FF, nullptr, (bf16_t*)(ws + WS_WA13), a.in[I_F2N] + D, 2 * FF, D, 2 * FF / 64, 1}; break;
    default: d = {a.in[I_F2W2] + (size_t)FF * D, nullptr, (bf16_t*)(ws + WS_WA2), nullptr, D, FF, D / 64, 0}; break;
    }
    return d;
}
__device__ __forceinline__ int cvt_items(int id) {
    switch (id) { case 0: case 2: case 5: case 12: return IT_W13; case 1: case 3: case 6: case 13: return IT_W2; case 4: case 7: return IT_2048; case 8: return IT_RI; default: return IT_1024; }
}
__device__ __forceinline__ void cvt_range(const Args& a, const Frame& F, int id_lo, int id_hi, int wg_lo, int wg_n) {
    LAS float* scr = (LAS float*)(F.lds + F.wave * 16896);
    int total = 0; for (int id = id_lo; id < id_hi; ++id) total += cvt_items(id);
    const int rank = (int)blockIdx.x - wg_lo; if (rank < 0 || rank >= wg_n) return;
    for (int it = rank * NWAVES + F.wave; it < total; it += wg_n * NWAVES) {
        int r = it, id = id_lo; while (r >= cvt_items(id)) { r -= cvt_items(id); ++id; }
        const CvtDesc d = cvt_desc(a, id); cvt_item(d, r, scr, F.lane);
    }
}

__device__ __forceinline__ void p0_rows(const Args& a, const Frame& F) {
    const float* x = a.in[I_X]; bf16_t* xb = (bf16_t*)(a.ws + WS_XB); float* ss = (float*)(a.ws + WS_SS);
    for (int m = F.gw; m < M; m += 2 * F.NGW) {
        const int m2 = m + F.NGW;
        const bool has2 = m2 < M;
        const f32x4* xr = (const f32x4*)(x + (size_t)m * D) + F.lane; const f32x4* xr2 = (const f32x4*)(x + (size_t)(has2 ? m2 : m) * D) + F.lane;
        f32x4 v[4], v2[4]; float s = 0.f, s2 = 0.f;
#pragma unroll
        for (int j = 0; j < 4; ++j) { v[j] = xr[64 * j]; v2[j] = xr2[64 * j]; }
#pragma unroll
        for (int j = 0; j < 4; ++j) { s += (v[j][0] * v[j][0] + v[j][1] * v[j][1]) + (v[j][2] * v[j][2] + v[j][3] * v[j][3]); s2 += (v2[j][0] * v2[j][0] + v2[j][1] * v2[j][1]) + (v2[j][2] * v2[j][2] + v2[j][3] * v2[j][3]); }
        s = wave_sum(s); s2 = wave_sum(s2);
        u32x2* o = (u32x2*)(xb + (size_t)m * D) + F.lane; u32x2* o2 = (u32x2*)(xb + (size_t)m2 * D) + F.lane;
#pragma unroll
        for (int j = 0; j < 4; ++j) { u32x2 w; w.x = cvt_pk_bf16(v[j][0], v[j][1]); w.y = cvt_pk_bf16(v[j][2], v[j][3]); o[64 * j] = w;
            if (has2) { u32x2 w2; w2.x = cvt_pk_bf16(v2[j][0], v2[j][1]); w2.y = cvt_pk_bf16(v2[j][2], v2[j][3]); o2[64 * j] = w2; } }
        if (F.lane == 0) { ss[m] = s; if (has2) ss[m2] = s2; }
    }
    for (int i = blockIdx.x * NTHR + F.tid; i < 5 * M; i += F.G * NTHR) ss[M + i] = 0.f;
    if (blockIdx.x == 0) for (int c = F.tid; c < D; c += NTHR) { const float l = a.in[I_ALAM][c]; ((float*)(a.ws + WS_SP8))[c] = -8.0f * LOG2E * (fmaxf(-l, 0.f) + log1pf(expf(-fabsf(l)))); }
}

__device__ __forceinline__ void conv_phase(const Args& a, const Frame& F) {
    const bf16_t* rec = (const bf16_t*)(a.ws + WS_REC); bf16_t* xc = (bf16_t*)(a.ws + WS_Y);
    constexpr int CR = 16, NITEM = (M / CR) * 4;
    for (int it = F.gw; it < NITEM; it += F.NGW) {
        const int cq = it & 3, m0 = (it >> 2) * CR, t0 = m0 & (SEQ - 1), ch = cq * 256 + 4 * F.lane;
        f32x4 w[4];
#pragma unroll
        for (int k = 0; k < 4; ++k) w[k] = *(const f32x4*)(a.in[I_ACW] + k * D + ch);
        const f32x4 bv = *(const f32x4*)(a.in[I_ACB] + ch);
        u32x2 rw[CR + 3];
#pragma unroll
        for (int i = 0; i < CR + 3; ++i) { const int r = m0 - 3 + i; rw[i] = (i >= 3 || t0 > 0) ? *(const u32x2*)(rec + (size_t)r * D + ch) : (u32x2){0u, 0u}; }
#pragma unroll
        for (int i = 0; i < CR; ++i) {
            f32x4 y = bv;
#pragma unroll
            for (int k = 0; k < 4; ++k) { const u32x2 q = rw[i + k]; y += w[k] * (f32x4){bf_lo(q.x), bf_hi(q.x), bf_lo(q.y), bf_hi(q.y)}; }
            u32x2 o; o.x = cvt_pk_bf16(y[0], y[1]); o.y = cvt_pk_bf16(y[2], y[3]); *(u32x2*)(xc + (size_t)(m0 + i) * D + ch) = o;
        }
    }
}

constexpr int SC_L = 64, SC_C = SEQ / SC_L;
__device__ __forceinline__ void scan_a(const Args& a, const Frame& F) {
    const bf16_t* av = (const bf16_t*)(a.ws + WS_REC); const bf16_t* uv = (const bf16_t*)(a.ws + WS_U);
    f32x4* hl = (f32x4*)(a.ws + WS_HL); f32x4* pc = (f32x4*)(a.ws + WS_PC);
    if (F.tid >= 256) return;
    for (int item = blockIdx.x * 256 + F.tid; item < BATCH * SC_C * 256; item += F.G * 256) {
        const int cgp = item & 255, bc = item >> 8; const size_t row0 = (size_t)bc * SC_L;
        f32x4 h = {0.f, 0.f, 0.f, 0.f}, p = {1.f, 1.f, 1.f, 1.f};
#pragma unroll 8
        for (int t = 0; t < SC_L; ++t) { const u32x2 aw = *(const u32x2*)(av + (row0 + t) * D + 4 * cgp); const f32x4 aa = {__builtin_amdgcn_exp2f(bf_lo(aw.x)), __builtin_amdgcn_exp2f(bf_hi(aw.x)), __builtin_amdgcn_exp2f(bf_lo(aw.y)), __builtin_amdgcn_exp2f(bf_hi(aw.y))}; const u32x2 uw = *(const u32x2*)(uv + (row0 + t) * D + 4 * cgp);
            const f32x4 uu = {bf_lo(uw.x), bf_hi(uw.x), bf_lo(uw.y), bf_hi(uw.y)}; h = aa * h + uu; p = p * aa; }
        hl[item] = h; pc[item] = p;
    }
}
__device__ __forceinline__ void scan_a_local(const Args& a, const Frame& F) {
    asm volatile("s_waitcnt vmcnt(0)" ::: "memory"); __syncthreads();
    const bf16_t* av = (const bf16_t*)(a.ws + WS_REC); const bf16_t* uv = (const bf16_t*)(a.ws + WS_U);
    f32x4* hl = (f32x4*)(a.ws + WS_HL); f32x4* pc = (f32x4*)(a.ws + WS_PC);
    pg8::StaticOrder S; S.init(M, 2048, F.G, (int)blockIdx.x); pg8::Unit u0, mine;
    const int sel = F.tid >> 7, t = F.tid & 127, ck4 = t >> 5, cgl = t & 31;
    for (int i0 = 0; S.next(i0, u0); i0 += 4) {
        if (!S.next(i0 + sel, mine)) continue;
        const size_t row0 = (size_t)mine.pm * 256 + ck4 * SC_L; const int cgp = mine.pn * 32 + cgl;
        f32x4 h = {0.f, 0.f, 0.f, 0.f}, p = {1.f, 1.f, 1.f, 1.f};
#pragma unroll 8
        for (int tt = 0; tt < SC_L; ++tt) { const u32x2 aw = *(const u32x2*)(av + (row0 + tt) * D + 4 * cgp); const f32x4 aa = {__builtin_amdgcn_exp2f(bf_lo(aw.x)), __builtin_amdgcn_exp2f(bf_hi(aw.x)), __builtin_amdgcn_exp2f(bf_lo(aw.y)), __builtin_amdgcn_exp2f(bf_hi(aw.y))};
            const u32x2 uw = *(const u32x2*)(uv + (row0 + tt) * D + 4 * cgp);
            const f32x4 uu = {bf_lo(uw.x), bf_hi(uw.x), bf_lo(uw.y), bf_hi(uw.y)}; h = aa * h + uu; p = p * aa; }
        const int item = (int)(row0 / SC_L) * 256 + cgp;
        hl[item] = h; pc[item] = p;
    }
}
__device__ __forceinline__ void scan_b(const Args& a, const Frame& F) {
    const bf16_t* av = (const bf16_t*)(a.ws + WS_REC); const bf16_t* uv = (const bf16_t*)(a.ws + WS_U); const bf16_t* gb = (const bf16_t*)(a.ws + WS_GB); bf16_t* yb = (bf16_t*)(a.ws + WS_Y);
    const f32x4* hl = (const f32x4*)(a.ws + WS_HL); const f32x4* pc = (const f32x4*)(a.ws + WS_PC);
    if (F.tid >= 256) return;
    for (int item = blockIdx.x * 256 + F.tid; item < BATCH * SC_C * 256; item += F.G * 256) {
        const int cgp = item & 255, bc = item >> 8, ck = bc & (SC_C - 1), b0 = bc - ck; const size_t row0 = (size_t)bc * SC_L;
        f32x4 h = {0.f, 0.f, 0.f, 0.f};
        int j = 0;
        for (; j + 8 <= ck; j += 8) {
            f32x4 pp[8], hh[8];
#pragma unroll
            for (int e = 0; e < 8; ++e) { pp[e] = pc[(b0 + j + e) * 256 + cgp]; hh[e] = hl[(b0 + j + e) * 256 + cgp]; }
#pragma unroll
            for (int e = 0; e < 8; ++e) h = pp[e] * h + hh[e];
        }
        for (; j < ck; ++j) h = pc[(b0 + j) * 256 + cgp] * h + hl[(b0 + j) * 256 + cgp];
#pragma unroll 8
        for (int t = 0; t < SC_L; ++t) { const size_t off = (row0 + t) * D + 4 * cgp; const u32x2 aw = *(const u32x2*)(av + off); const f32x4 aa = {__builtin_amdgcn_exp2f(bf_lo(aw.x)), __builtin_amdgcn_exp2f(bf_hi(aw.x)), __builtin_amdgcn_exp2f(bf_lo(aw.y)), __builtin_amdgcn_exp2f(bf_hi(aw.y))}; const u32x2 uw = *(const u32x2*)(uv + off);
            const f32x4 uu = {bf_lo(uw.x), bf_hi(uw.x), bf_lo(uw.y), bf_hi(uw.y)}; h = aa * h + uu;
            const u32x2 gw = *(const u32x2*)(gb + off); u32x2 o; o.x = cvt_pk_bf16(h[0] * bf_lo(gw.x), h[1] * bf_hi(gw.x)); o.y = cvt_pk_bf16(h[2] * bf_lo(gw.y), h[3] * bf_hi(gw.y));
            *(u32x2*)(yb + off) = o; }
    }
}

constexpr float SB_TINY = 5.42e-20f;
struct SbFrag { bf16x8 kf[4]; bf16x8 vf[2][2]; };
constexpr int ATT_KSTR = 1088, ATT_VOFF = 4 * ATT_KSTR, ATT_SLOT = ATT_VOFF + 4096, WAVE_LDS = 2 * ATT_SLOT;
__device__ __forceinline__ void sb_dma(LAS unsigned char* slot, const bf16_t* kg, const bf16_t* vg, int k0) {
    const bf16_t* k = kg + (size_t)k0 * D; const bf16_t* v = vg + k0;
#define SB_GLDS(g, o) __builtin_amdgcn_global_load_lds((const unsigned*)(g), (LAS unsigned*)(slot + (o)), 16, 0, 0)
    SB_GLDS(k, 0); SB_GLDS(k + 8 * D, ATT_KSTR); SB_GLDS(k + 16 * D, 2 * ATT_KSTR); SB_GLDS(k + 24 * D, 3 * ATT_KSTR);
    SB_GLDS(v, ATT_VOFF); SB_GLDS(v + (size_t)16 * SEQ, ATT_VOFF + 1024); SB_GLDS(v + (size_t)32 * SEQ, ATT_VOFF + 2048); SB_GLDS(v + (size_t)48 * SEQ, ATT_VOFF + 3072);
#undef SB_GLDS
}
template <int N> __device__ __forceinline__ void sb_wait() { asm volatile("s_waitcnt vmcnt(%0)" :: "n"(N) : "memory"); }
struct SbAddr { int k[4]; int v[4]; };
__device__ __forceinline__ void sb_read(SbFrag& f, const LAS unsigned char* slot, const SbAddr& ad) {
#pragma unroll
    for (int d0 = 0; d0 < 4; ++d0) f.kf[d0] = *(const LAS bf16x8*)(slot + ad.k[d0]);
#pragma unroll
    for (int dh = 0; dh < 2; ++dh)
#pragma unroll
        for (int mm = 0; mm < 2; ++mm) f.vf[dh][mm] = *(const LAS bf16x8*)(slot + ad.v[dh * 2 + mm]);
}
template <bool DIAG> __device__ __forceinline__ void sb_tile(const SbFrag& f, const bf16x8 (&qf)[4], f32x16& o0, f32x16& o1, float& carry, int lim, int hi) {
    f32x16 s;
#pragma unroll
    for (int r = 0; r < 16; ++r) s[r] = 0.f;
#pragma unroll
    for (int d0 = 0; d0 < 4; ++d0) s = __builtin_amdgcn_mfma_f32_32x32x16_bf16(f.kf[d0], qf[d0], s, 0, 0, 0);
    float wv[16], t[16]; float run, zmax = -3.0e38f;
#pragma unroll
    for (int r = 0; r < 16; ++r) { zmax = fmaxf(zmax, s[r]); t[r] = __builtin_amdgcn_exp2f(s[r]); if (DIAG) t[r] = (r < lim) ? t[r] : 0.f; }
    if (!__any(zmax > 7.2f)) {
        float G = 1.f;
#pragma unroll
        for (int r = 0; r < 16; ++r) { wv[r] = t[r] * G; G *= 1.0f + t[r]; }
        run = __builtin_amdgcn_rcpf(G);
#pragma unroll
        for (int r = 0; r < 16; ++r) wv[r] *= run;
    } else {
        run = 1.f;
#pragma unroll
        for (int r = 15; r >= 0; --r) {
            float stay = __builtin_amdgcn_rcpf(1.0f + t[r]);
            float beta = 1.0f - stay;
            if (DIAG) { const bool ok = r < lim; stay = ok ? stay : 1.0f; beta = ok ? beta : 0.f; }
            wv[r] = beta * run; run *= stay;
        }
    }
    const float other = __shfl_xor(run, 32);
    const float base = carry * (hi == 0 ? other : 1.0f);
    carry *= run * other;
    u32x4 p0, p1;
    p0.x = cvt_pk_bf16(wv[0] * base, wv[1] * base); p0.y = cvt_pk_bf16(wv[2] * base, wv[3] * base); p0.z = cvt_pk_bf16(wv[4] * base, wv[5] * base); p0.w = cvt_pk_bf16(wv[6] * base, wv[7] * base);
    p1.x = cvt_pk_bf16(wv[8] * base, wv[9] * base); p1.y = cvt_pk_bf16(wv[10] * base, wv[11] * base); p1.z = cvt_pk_bf16(wv[12] * base, wv[13] * base); p1.w = cvt_pk_bf16(wv[14] * base, wv[15] * base);
    const bf16x8 pa0 = __builtin_bit_cast(bf16x8, p0), pa1 = __builtin_bit_cast(bf16x8, p1);
    o0 = __builtin_amdgcn_mfma_f32_32x32x16_bf16(pa0, f.vf[0][0], o0, 0, 0, 0); o0 = __builtin_amdgcn_mfma_f32_32x32x16_bf16(pa1, f.vf[0][1], o0, 0, 0, 0);
    o1 = __builtin_amdgcn_mfma_f32_32x32x16_bf16(pa0, f.vf[1][0], o1, 0, 0, 0); o1 = __builtin_amdgcn_mfma_f32_32x32x16_bf16(pa1, f.vf[1][1], o1, 0, 0, 0);
}
__device__ __forceinline__ void sb_unit(const bf16_t* Q, const bf16_t* K, const bf16_t* VT, bf16_t* O, int b, int h, int qb, int lane, LAS unsigned char* slotA, LAS unsigned char* slotB, const SbAddr& ad) {
    const int j = lane & 31, hi = lane >> 5, q0 = qb * 32; const size_t rowbase = (size_t)b * SEQ;
    const bf16_t* qp = Q + (rowbase + q0 + j) * D + h * HD + 8 * hi;
    bf16x8 qf[4];
#pragma unroll
    for (int d0 = 0; d0 < 4; ++d0) qf[d0] = *(const bf16x8*)(qp + 16 * d0);
    const int k8w = lane >> 3, cw = (lane & 7) ^ k8w, aw = lane >> 4, d16w = 4 * ((lane >> 2) & 3) + aw, pw = (lane & 3) ^ aw;
    const bf16_t* kg = K + (rowbase + k8w) * D + h * HD + 8 * cw;
    const bf16_t* vg = VT + ((size_t)(b * NH + h) * HD + d16w) * SEQ + 8 * pw;
    f32x16 o0, o1;
#pragma unroll
    for (int r = 0; r < 16; ++r) { o0[r] = 0.f; o1[r] = 0.f; }
    float carry = 1.f;
    SbFrag f;
    sb_dma(slotA, kg, vg, q0);
    sb_dma(slotB, kg, vg, qb > 0 ? q0 - 32 : 0);
    sb_wait<8>(); sb_read(f, slotA, ad);
    sb_tile<true>(f, qf, o0, o1, carry, j - 16 * hi, hi);
    for (int kt = qb - 1; kt >= 0; kt -= 2) {
        sb_dma(slotA, kg, vg, (kt > 0 ? kt - 1 : 0) * 32);
        sb_wait<8>(); sb_read(f, slotB, ad);
        sb_tile<false>(f, qf, o0, o1, carry, 64, hi);
        if (kt == 0 || __all(carry < SB_TINY)) break;
        sb_dma(slotB, kg, vg, (kt > 1 ? kt - 2 : 0) * 32);
        sb_wait<8>(); sb_read(f, slotA, ad);
        sb_tile<false>(f, qf, o0, o1, carry, 64, hi);
        if (__all(carry < SB_TINY)) break;
    }
    sb_wait<0>();
    bf16_t* op = O + (rowbase + q0) * D + h * HD + j;
#pragma unroll
    for (int r = 0; r < 16; ++r) { const int qr = (r & 3) + 8 * (r >> 2) + 4 * hi;
        op[(size_t)qr * D] = (bf16_t)(cvt_pk_bf16(o0[r], 0.f) & 0xffffu); op[(size_t)qr * D + 32] = (bf16_t)(cvt_pk_bf16(o1[r], 0.f) & 0xffffu); }
}
__device__ __forceinline__ void attn_phase(const Args& a, const Frame& F) {
    const bf16_t* Q = (const bf16_t*)(a.ws + WS_Q); const bf16_t* K = (const bf16_t*)(a.ws + WS_K); const bf16_t* VT = (const bf16_t*)(a.ws + WS_VT); bf16_t* O = (bf16_t*)(a.ws + WS_O);
    constexpr int NQB = SEQ / 32, NU = BATCH * NH * NQB;
    LAS unsigned char* slotA = F.lds + F.wave * WAVE_LDS;
    SbAddr ad;
    { const int j = F.lane & 31, hi = F.lane >> 5, key = 16 * ((j >> 2) & 1) + (j & 3) + 4 * (j >> 3), ki = key >> 3, k8 = key & 7;
#pragma unroll
      for (int d0 = 0; d0 < 4; ++d0) ad.k[d0] = ki * ATT_KSTR + (8 * k8 + ((2 * d0 + hi) ^ k8)) * 16;
#pragma unroll
      for (int dh = 0; dh < 2; ++dh)
#pragma unroll
          for (int mm = 0; mm < 2; ++mm) { const int dd = 32 * dh + j, vi = dd >> 4, d16 = dd & 15, a_ = d16 & 3, b_ = d16 >> 2, p = 2 * hi + mm; ad.v[dh * 2 + mm] = ATT_VOFF + vi * 1024 + (16 * a_ + 4 * b_ + (p ^ a_)) * 16; } }
    for (int u = F.gw; u < NU; u += F.NGW) { const int bh = u / NQB, qb = u % NQB; sb_unit(Q, K, VT, O, bh / NH, bh % NH, qb, F.lane, slotA, slotA + ATT_SLOT, ad); }
}

__global__ void __launch_bounds__(NTHR) fwd_kernel(Args args) {
    extern __shared__ __attribute__((aligned(16))) unsigned char lds_raw[];
    Frame F; F.lds = (LAS unsigned char*)lds_raw; F.tid = threadIdx.x; F.lane = F.tid & 63; F.wave = __builtin_amdgcn_readfirstlane(F.tid >> 6);
    F.G = gridDim.x; F.gw = blockIdx.x * NWAVES + F.wave; F.NGW = F.G * NWAVES;
    unsigned char* ws = args.ws;
    float* ss = (float*)(ws + WS_SS); LAS float* RED = (LAS float*)(F.lds + 131072);
    const int lo = args.ph_lo, hi = args.ph_hi;
#if MK_COOP
    cg::grid_group grid = cg::this_grid();
    volatile LAS unsigned* MISC = (volatile LAS unsigned*)(F.lds + MISC_OFF);
    if (F.tid < 16) MISC[F.tid] = 0u;
    __syncthreads();
    const XcdBarrier xbar = xcd_barrier_post((unsigned*)ws, MISC + 8);
    if (hi > N_PHASES) grid.sync();
#define SEAM(k) do { if (lo <= (k) && (k) + 1 < hi) xcd_barrier(xbar); } while (0)
#else
#define SEAM(k) do { } while (0)
#endif
#ifndef PH_MASK
#define PH_MASK 0x3ffff
#endif
#define IN(k) (((PH_MASK >> (k)) & 1) && lo <= (k) && (k) < hi)
    using namespace pg8;
    bf16_t* XB = (bf16_t*)(ws + WS_XB); bf16_t* ACT = (bf16_t*)(ws + WS_ACT);
    const int bx = blockIdx.x;
#define RUN_GEMM(EPI, ALIGN, Aptr, Bptr, N_, K_, lda_, adiv_, ...) do { Gemm g{(const bf16_t*)(Aptr), (const bf16_t*)(Bptr), M, (N_), (K_), (lda_), (adiv_)}; StaticOrder S; S.init(M, (N_), F.G, bx); \
        EPI E{__VA_ARGS__}; gemm_phase<EPI, ALIGN>(F.lds, g, S, E); } while (0)

#ifndef DUP_MASK
#define DUP_MASK 0
#endif
#if MK_COOP
#define REDO_BAR() xcd_barrier(xbar)
#else
#define REDO_BAR() do { } while (0)
#endif
#define PHASE(k, ...) do { if (IN(k)) { __VA_ARGS__; if ((DUP_MASK >> (k)) & 1) { REDO_BAR(); __VA_ARGS__; } } SEAM(k); } while (0)
    PHASE(0, cvt_range(args, F, 0, 1, 0, F.G); p0_rows(args, F));
    const int T22 = (64 * 22) % F.G, T30 = (64 * 30) % F.G;
    PHASE(1, RUN_GEMM(EpiSwiglu, true, XB, ws + WS_WA13, 2 * FF, D, D, 0, ss, ACT); cvt_range(args, F, 1, 4, T22, F.G - T22); cvt_range(args, F, 7, 10, T22, F.G - T22));
    PHASE(2, RUN_GEMM(EpiResidIn, true, ACT, ws + WS_WA2, D, FF, FF, 0, args.in[I_X], nullptr, XB, ss + M, 0.5f, RED));
    PHASE(3, RUN_GEMM(EpiWin, true, XB, ws + WS_WIN, 2048, D, D, 0, ss + M, (bf16_t*)(ws + WS_GB), (bf16_t*)(ws + WS_REC)));
    PHASE(4, conv_phase(args, F));
    PHASE(5, RUN_GEMM(EpiGate, true, ws + WS_Y, ws + WS_WRI, 2048, 256, D, 2, (const bf16_t*)(ws + WS_Y), args.in[I_ABR], args.in[I_ABI], (const float*)(ws + WS_SP8), (bf16_t*)(ws + WS_REC), (bf16_t*)(ws + WS_U)); scan_a_local(args, F));
    PHASE(7, scan_b(args, F));
    PHASE(8, RUN_GEMM(EpiResidMid, true, ws + WS_Y, ws + WS_WOUT, D, D, D, 0, nullptr, nullptr, XB, ss + 2 * M, 1.0f, RED));
    PHASE(9, RUN_GEMM(EpiSwiglu, true, XB, ws + WS_WB13, 2 * FF, D, D, 0, ss + 2 * M, ACT); cvt_range(args, F, 4, 7, T22, F.G - T22));
    PHASE(10, RUN_GEMM(EpiResidMid, true, ACT, ws + WS_WB2, D, FF, FF, 0, nullptr, nullptr, XB, ss + 3 * M, 0.5f, RED));
    PHASE(11, RUN_GEMM(EpiKvSwiglu, true, XB, ws + WS_WKV, 2048 + 2 * FF, D, D, 0, ss + 3 * M, args.in[I_KN], (bf16_t*)(ws + WS_K), (bf16_t*)(ws + WS_VT), ACT); cvt_range(args, F, 10, 14, T30, F.G - T30));
    PHASE(12, RUN_GEMM(EpiResidMid, true, ACT, ws + WS_WC2, D, FF, FF, 0, nullptr, nullptr, XB, ss + 4 * M, 0.5f, RED));
    PHASE(13, RUN_GEMM(EpiQ, true, XB, ws + WS_WQ, D, D, D, 0, ss + 4 * M, args.in[I_QN], (bf16_t*)(ws + WS_Q)));
    PHASE(14, attn_phase(args, F));
    PHASE(15, RUN_GEMM(EpiResidMid, true, ws + WS_O, ws + WS_WO, D, D, D, 0, nullptr, nullptr, XB, ss + 5 * M, 1.0f, RED));
    PHASE(16, RUN_GEMM(EpiSwiglu, true, XB, ws + WS_WA13, 2 * FF, D, D, 0, ss + 5 * M, ACT));
    PHASE(17, RUN_GEMM(EpiResidOut, true, ACT, ws + WS_WA2, D, FF, FF, 0, nullptr, args.out, XB, nullptr, 0.5f, RED));
}

extern "C" void kernel_launch(void* const* d_in, const int* in_sizes, int n_in, void* d_out, int out_size, void* d_ws, size_t ws_size, hipStream_t stream) {
    static int grid = 0;
    if (grid == 0) {
        if (n_in != 23 || out_size != M * D || ws_size < WS_END) { fprintf(stderr, "kernel_launch: unexpected problem (n_in %d out %d ws %zu)\n", n_in, out_size, ws_size); grid = -1; return; }
        int dev = 0, cus = 0, per_cu = 0;
        (void)hipGetDevice(&dev); (void)hipDeviceGetAttribute(&cus, hipDeviceAttributeMultiprocessorCount, dev);
        if (hipFuncSetAttribute((const void*)fwd_kernel, hipFuncAttributeMaxDynamicSharedMemorySize, LDS_BYTES) != hipSuccess) { fprintf(stderr, "kernel_launch: hipFuncSetAttribute failed\n"); grid = -1; return; }
        if (hipOccupancyMaxActiveBlocksPerMultiprocessor(&per_cu, (const void*)fwd_kernel, NTHR, LDS_BYTES) != hipSuccess || per_cu < 1) { fprintf(stderr, "kernel_launch: occupancy query says %d\n", per_cu); per_cu = 1; }
        (void)hipGetLastError();
        grid = cus * 1;
        if (grid <= 0) grid = 256;
    }
    if (grid < 0) return;
    Args a{};
    for (int i = 0; i < 23; ++i) a.in[i] = (const float*)d_in[i];
    a.out = (float*)d_out; a.ws = (unsigned char*)d_ws;
#if MK_COOP
    a.ph_lo = 0; a.ph_hi = N_PHASES;
    if (hipMemsetAsync(d_ws, 0, 16 * KiB, stream) != hipSuccess) { fprintf(stderr, "kernel_launch: memset of the barrier words failed\n"); return; }
    void* kargs[] = {&a};
    hipError_t e = hipLaunchCooperativeKernel((const void*)fwd_kernel, dim3(grid), dim3(NTHR), kargs, LDS_BYTES, stream);
    if (e != hipSuccess) fprintf(stderr, "kernel_launch: cooperative launch failed: %s (grid %d)\n", hipGetErrorString(e), grid);
#else
    for (int p = 0; p < N_PHASES; ++p) { a.ph_lo = p; a.ph_hi = p + 1; hipLaunchKernelGGL(fwd_kernel, dim3(grid), dim3(NTHR), LDS_BYTES, stream, a); }
#endif
}
```

```cpp
#include <hip/hip_runtime.h>
#include <hip/hip_cooperative_groups.h>
#include <cstdio>
#include <cstdint>
#include <cmath>
namespace cg = cooperative_groups;

#ifndef MK_COOP
#define MK_COOP 1
#endif

#define LAS __attribute__((address_space(3)))
typedef unsigned short bf16_t;
typedef short bf16x8 __attribute__((ext_vector_type(8)));
typedef float f32x4 __attribute__((ext_vector_type(4)));
typedef float f32x2 __attribute__((ext_vector_type(2)));
typedef float f32x16 __attribute__((ext_vector_type(16)));
typedef unsigned u32x4 __attribute__((ext_vector_type(4)));
typedef unsigned u32x2 __attribute__((ext_vector_type(2)));

constexpr int BATCH = 4, SEQ = 4096, D = 1024, FF = 2816, NH = 16, HD = 64;
constexpr int M = BATCH * SEQ;
constexpr float EPS = 1e-6f;
constexpr float LOG2E = 1.4426950408889634f, LN2 = 0.6931471805599453f;

constexpr size_t MiB = 1u << 20, KiB = 1u << 10;
constexpr size_t WS_SS = 64 * KiB;
constexpr size_t WS_SP8 = 32 * KiB;
constexpr size_t WS_HL = 1 * MiB, WS_PC = 2 * MiB;
constexpr size_t SZ_W13 = (size_t)2 * FF * D * 2, SZ_W2 = (size_t)D * FF * 2;
constexpr size_t WS_WA13 = 4 * MiB, WS_WA2 = WS_WA13 + SZ_W13;
constexpr size_t WS_WB13 = WS_WA2 + SZ_W2, WS_WB2 = WS_WB13 + SZ_W13;
constexpr size_t WS_WKV = WS_WB2 + SZ_W2, WS_WC13 = WS_WKV + 4 * MiB, WS_WC2 = WS_WC13 + SZ_W13;
constexpr size_t WS_WIN = WS_WC2 + SZ_W2, WS_WRI = WS_WIN + 4 * MiB, WS_WOUT = WS_WRI + 1 * MiB, WS_WQ = WS_WOUT + 2 * MiB, WS_WO = WS_WQ + 2 * MiB;
constexpr size_t WS_XB = 69 * MiB;
constexpr size_t WS_ACT = 101 * MiB;
constexpr size_t WS_K = 189 * MiB, WS_VT = 221 * MiB, WS_STASH = 253 * MiB, WS_END = 254 * MiB;
constexpr size_t WS_GB = WS_ACT, WS_U = WS_ACT + 32 * MiB, WS_REC = WS_ACT + 64 * MiB;
constexpr size_t WS_Y = WS_ACT + 96 * MiB;
constexpr size_t WS_Q = WS_ACT, WS_O = WS_ACT + 32 * MiB;
static_assert(WS_WO + 2 * MiB <= WS_XB && WS_REC + 64 * MiB <= WS_END, "ws map");

__device__ __forceinline__ unsigned cvt_pk_bf16(float lo, float hi) {
    typedef __bf16 bf16x2_t __attribute__((ext_vector_type(2)));
    f32x2 v = {lo, hi}; bf16x2_t b = __builtin_convertvector(v, bf16x2_t); return __builtin_bit_cast(unsigned, b);
}
__device__ __forceinline__ float bf_lo(unsigned w) { return __uint_as_float(w << 16); }
__device__ __forceinline__ float bf_hi(unsigned w) { return __uint_as_float(w & 0xffff0000u); }
__device__ __forceinline__ float sigm(float x) { return __builtin_amdgcn_rcpf(1.0f + __builtin_amdgcn_exp2f(-x * LOG2E)); }
__device__ __forceinline__ float gelu_tanh(float x) { return x * sigm(1.5957691216057308f * (x + 0.044715f * x * x * x)); }
__device__ __forceinline__ float wave_sum(float v) {
#pragma unroll
    for (int o = 1; o < 64; o <<= 1) v += __shfl_xor(v, o);
    return v;
}
#define LDS_WAIT() asm volatile("s_waitcnt lgkmcnt(0)" ::: "memory")

namespace pg8 {
constexpr int BM = 256, BK = 64, HALF = 128, HTB = HALF * BK * 2, STAGE_BYTES = 8 * HTB, NXCD = 8, WGM = 4;
__host__ __device__ __forceinline__ int lds_byte(int r, int c) { const int st = (r >> 4) * 2 + (c >> 5), rr = r & 15, cc = c & 31, ob = rr * 64 + cc * 2; return st * 1024 + (ob ^ (((ob >> 9) & 1) << 5)); }
__host__ __device__ __forceinline__ void stage_rc(int b, int& R, int& C) { const int st = b / 1024, sb = b % 1024, swz = sb ^ (((sb >> 9) & 1) << 5); R = (st >> 1) * 16 + swz / 64; C = (st & 1) * 32 + (swz % 64) / 2; }
__host__ __device__ __forceinline__ int perm32(int rho) { const int n = rho >> 4, i = rho & 15; return 8 * (i >> 2) + 4 * n + (i & 3); }

struct Unit { int pm, pn; };
struct Gemm { const bf16_t* A; const bf16_t* Bt; int M, N, K, lda, adiv; };

static_assert((16384 / BM) % WGM == 0, "row panels must fill whole groups");
struct StaticOrder {
    int rot = 0;
    int nM, nN, nwg, G, c;
    __device__ void init(int M_, int N_, int G_, int c_) { nM = M_ / BM; nN = N_ / BM; nwg = nM * nN; G = G_; c = c_; }
    __device__ bool next(int i, Unit& u) const {
        const long L = (long)i * G + c; if (L >= nwg) return false;
        int wgid = (int)L; { const int q = nwg / NXCD, r = nwg % NXCD, xcd = wgid % NXCD, off = wgid / NXCD; wgid = (xcd < r ? xcd * (q + 1) : r * (q + 1) + (xcd - r) * q) + off; }
        const int nig = WGM * nN, gid = wgid / nig, fm = gid * WGM; constexpr int gsz = WGM;
        u.pm = fm + ((wgid % nig) % gsz); u.pn = (wgid % nig) / gsz; if (rot) u.pn = (u.pn + rot * i) % nN; return true;
    }
};

template <class Epi, bool ALIGN_EPI>
__device__ __forceinline__ void gemm_phase(LAS unsigned char* lds, const Gemm g, const StaticOrder& S, const Epi& E) {
    const int tid = threadIdx.x, wid = __builtin_amdgcn_readfirstlane(tid >> 6), lane = tid & 63, wr = wid >> 2, wc = wid & 3, fr = lane & 15, fq = lane >> 4;
    const int K = g.K, nt = K / BK, lda = g.lda;
    unsigned voffA[2], voffB[2];
#pragma unroll
    for (int i = 0; i < 2; ++i) { int R, C; stage_rc(tid * 16 + i * 8192, R, C); const int Rb = (R & ~31) + perm32(R & 31);
        voffA[i] = (unsigned)(R * lda + C) * 2u; voffB[i] = (unsigned)(Rb * K + C) * 2u; }
    const size_t kstep = (size_t)(BK * 2);
    const size_t hA = (size_t)HALF * lda * 2, hB = (size_t)HALF * K * 2;
    const size_t tA = 2 * hA, tB = 2 * hB;
    const unsigned ldsw = (unsigned)wid * 1024u;
    const int aoff = lds_byte(wr * 64 + fr, fq * 8), boff = lds_byte(wc * 32 + fr, fq * 8);
#define PG8_SA(b, h) (((b) * 2 + (h)) * HTB)
#define PG8_SB(b, h) ((4 + (b) * 2 + (h)) * HTB)
#define PG8_STAGE(bufoff, gbase, voff) do { _Pragma("unroll") for (int _i = 0; _i < 2; ++_i) \
        __builtin_amdgcn_global_load_lds((const unsigned*)((const char*)(gbase) + (voff)[_i]), (LAS unsigned*)(lds + (bufoff) + ldsw + _i * 8192), 16, 0, 0); } while (0)
#define PG8_LDA(dst, b, h) do { _Pragma("unroll") for (int m = 0; m < 4; ++m) _Pragma("unroll") for (int k = 0; k < 2; ++k) dst[m][k] = *(const LAS bf16x8*)(lds + PG8_SA(b, h) + aoff + m * 2048 + k * 1024); } while (0)
#define PG8_LDB(dst, b, h) do { _Pragma("unroll") for (int n = 0; n < 2; ++n) _Pragma("unroll") for (int k = 0; k < 2; ++k) dst[n][k] = *(const LAS bf16x8*)(lds + PG8_SB(b, h) + boff + n * 2048 + k * 1024); } while (0)
#define PG8_MMA(ai, bj, At, Bt) do { __builtin_amdgcn_s_setprio(1); _Pragma("unroll") for (int m = 0; m < 4; ++m) _Pragma("unroll") for (int n = 0; n < 2; ++n) _Pragma("unroll") for (int k = 0; k < 2; ++k) \
        acc[ai][bj][m][n] = __builtin_amdgcn_mfma_f32_16x16x32_bf16(Bt[n][k], At[m][k], acc[ai][bj][m][n], 0, 0, 0); __builtin_amdgcn_s_setprio(0); } while (0)
#define PG8_WAIT_V(n) asm volatile("s_waitcnt vmcnt(" #n ")" ::: "memory")
#define PG8_WAIT_L(n) asm volatile("s_waitcnt lgkmcnt(" #n ")" ::: "memory")
#define PG8_BAR __builtin_amdgcn_s_barrier()
#define PG8_SCHED __builtin_amdgcn_sched_barrier(0)
#define PG8_ABASE(u) ((const char*)g.A + (size_t)(u).pm * tA + (g.adiv ? (size_t)((u).pn / g.adiv) * K * 2 : (size_t)0))
#define PG8_BBASE(u) ((const char*)g.Bt + (size_t)(u).pn * tB)
    Unit cur, nxt; int ui = 0;
    if (!S.next(0, cur)) return;
    f32x4 acc[2][2][4][2];
#pragma unroll
    for (int a = 0; a < 2; ++a)
#pragma unroll
        for (int b = 0; b < 2; ++b)
#pragma unroll
            for (int m = 0; m < 4; ++m)
#pragma unroll
                for (int n = 0; n < 2; ++n) acc[a][b][m][n] = (f32x4){0.f, 0.f, 0.f, 0.f};
    bf16x8 At[4][2], B0[2][2], B1[2][2];
    const char* cA = PG8_ABASE(cur); const char* cB = PG8_BBASE(cur);
    PG8_STAGE(PG8_SB(0, 0), cB, voffB); PG8_STAGE(PG8_SB(0, 1), cB + hB, voffB); PG8_STAGE(PG8_SA(0, 0), cA, voffA); PG8_STAGE(PG8_SA(0, 1), cA + hA, voffA);
    if (wr == 1) PG8_BAR;
    PG8_WAIT_V(2); PG8_BAR;
    PG8_STAGE(PG8_SB(1, 0), cB + kstep, voffB); PG8_STAGE(PG8_SA(1, 0), cA + kstep, voffA); PG8_STAGE(PG8_SB(1, 1), cB + hB + kstep, voffB);
    PG8_WAIT_V(6); PG8_BAR;
    for (;;) {
        const bool has_next = S.next(ui + 1, nxt);
        const char* nA = has_next ? PG8_ABASE(nxt) : cA; const char* nB = has_next ? PG8_BBASE(nxt) : cB;
#pragma unroll 1
        for (int t = 0; t < nt; t += 2) {
            const bool last = (t == nt - 2);
            const char* a1 = cA + (size_t)(t + 1) * kstep;
            const char* a2 = last ? nA : cA + (size_t)(t + 2) * kstep; const char* b2 = last ? nB : cB + (size_t)(t + 2) * kstep;
            const char* a3 = a2 + kstep; const char* b3 = b2 + kstep;
            PG8_LDB(B0, 0, 0); PG8_LDB(B1, 0, 1); PG8_SCHED; PG8_LDA(At, 0, 0); PG8_STAGE(PG8_SA(1, 1), a1 + hA, voffA);
            PG8_WAIT_V(8); PG8_WAIT_L(0); PG8_BAR; PG8_MMA(0, 0, At, B0); PG8_MMA(0, 1, At, B1); PG8_BAR; PG8_SCHED;
            PG8_LDA(At, 0, 1); PG8_STAGE(PG8_SB(0, 0), b2, voffB); PG8_STAGE(PG8_SB(0, 1), b2 + hB, voffB); PG8_STAGE(PG8_SA(0, 0), a2, voffA);
            PG8_WAIT_V(8); PG8_WAIT_L(0); PG8_BAR; PG8_MMA(1, 0, At, B0); PG8_MMA(1, 1, At, B1); PG8_BAR; PG8_SCHED;
            PG8_LDB(B0, 1, 0); PG8_LDB(B1, 1, 1); PG8_SCHED; PG8_LDA(At, 1, 0); PG8_STAGE(PG8_SA(0, 1), a2 + hA, voffA);
            PG8_WAIT_V(8); PG8_WAIT_L(0); PG8_BAR; PG8_MMA(0, 0, At, B0); PG8_MMA(0, 1, At, B1); PG8_BAR; PG8_SCHED;
            PG8_LDA(At, 1, 1); PG8_STAGE(PG8_SB(1, 0), b3, voffB); PG8_STAGE(PG8_SB(1, 1), b3 + hB, voffB); PG8_STAGE(PG8_SA(1, 0), a3, voffA);
            PG8_WAIT_V(8); PG8_WAIT_L(0); PG8_BAR; PG8_MMA(1, 0, At, B0); PG8_MMA(1, 1, At, B1); PG8_BAR; PG8_SCHED;
        }
        if constexpr (ALIGN_EPI) { if (wr == 0) PG8_BAR; }
        E(acc, cur, wr, wc, fr, fq);
        if (!has_next) break;
#pragma unroll
        for (int a = 0; a < 2; ++a)
#pragma unroll
            for (int b = 0; b < 2; ++b)
#pragma unroll
                for (int m = 0; m < 4; ++m)
#pragma unroll
                    for (int n = 0; n < 2; ++n) acc[a][b][m][n] = (f32x4){0.f, 0.f, 0.f, 0.f};
        cur = nxt; cA = nA; cB = nB; ++ui;
        if constexpr (ALIGN_EPI) { if (wr == 1) PG8_BAR; }
    }
    PG8_WAIT_V(0);
    if constexpr (!ALIGN_EPI) { if (wr == 0) PG8_BAR; }
    PG8_BAR;
#undef PG8_SA
#undef PG8_SB
#undef PG8_STAGE
#undef PG8_LDA
#undef PG8_LDB
#undef PG8_MMA
#undef PG8_WAIT_V
#undef PG8_WAIT_L
#undef PG8_BAR
#undef PG8_SCHED
#undef PG8_ABASE
#undef PG8_BBASE
}

typedef f32x4 Acc[2][2][4][2];
__device__ __forceinline__ float rstd_of(const float* ss, int row) { return 1.0f / sqrtf(ss[row] * (1.0f / D) + EPS); }

__device__ __forceinline__ void rstd8(const float* ss, int rbase, float (&rs)[2][4]) {
    float t[2][4];
#pragma unroll
    for (int ai = 0; ai < 2; ++ai)
#pragma unroll
        for (int m = 0; m < 4; ++m) t[ai][m] = ss[rbase + ai * HALF + m * 16];
#pragma unroll
    for (int ai = 0; ai < 2; ++ai)
#pragma unroll
        for (int m = 0; m < 4; ++m) rs[ai][m] = __builtin_amdgcn_rsqf(t[ai][m] * (1.0f / D) + EPS);
}
__device__ __forceinline__ void epi_swiglu(const Acc& acc, int pm, int pnf, int wr, int wc, int fr, int fq, const float* ss, bf16_t* act) {
    const int col = pnf * 128 + wc * 32 + 8 * fq;
    float rs8[2][4]; rstd8(ss, pm * BM + wr * 64 + fr, rs8);
#pragma unroll
    for (int ai = 0; ai < 2; ++ai)
#pragma unroll
        for (int m = 0; m < 4; ++m) {
            const int row = pm * BM + ai * HALF + wr * 64 + m * 16 + fr; const float rs = rs8[ai][m];
            float o[8];
#pragma unroll
            for (int n = 0; n < 2; ++n)
#pragma unroll
                for (int j = 0; j < 4; ++j) { const float gt = acc[ai][0][m][n][j] * rs, up = acc[ai][1][m][n][j] * rs; o[n * 4 + j] = gt * sigm(gt) * up; }
            u32x4 w; w.x = cvt_pk_bf16(o[0], o[1]); w.y = cvt_pk_bf16(o[2], o[3]); w.z = cvt_pk_bf16(o[4], o[5]); w.w = cvt_pk_bf16(o[6], o[7]);
            __builtin_nontemporal_store(w, (u32x4*)(act + (size_t)row * FF + col));
        }
}
struct EpiSwiglu { const float* ss; bf16_t* act;
    __device__ __forceinline__ void operator()(const Acc& acc, const Unit& u, int wr, int wc, int fr, int fq) const { epi_swiglu(acc, u.pm, u.pn, wr, wc, fr, fq, ss, act); } };

template <bool IN_F32, bool FINAL> struct EpiResid { const float* xin; float* xout; bf16_t* xb; float* ssn; float alpha; LAS float* red;
    __device__ __forceinline__ void operator()(const Acc& acc, const Unit& u, int wr, int wc, int fr, int fq) const {
        const size_t cbase = (size_t)u.pn * BM + wc * 32 + 8 * fq;
#pragma unroll
        for (int ai = 0; ai < 2; ++ai) {
            f32x4 xr[4][2][2];
#pragma unroll
            for (int m = 0; m < 4; ++m)
#pragma unroll
                for (int bj = 0; bj < 2; ++bj) {
                    const size_t off = (size_t)(u.pm * BM + ai * HALF + wr * 64 + m * 16 + fr) * D + cbase + bj * HALF;
                    if (IN_F32) { xr[m][bj][0] = *(const f32x4*)(xin + off); xr[m][bj][1] = *(const f32x4*)(xin + off + 4); }
                    else { const u32x4 xw = *(const u32x4*)(xb + off); xr[m][bj][0] = __builtin_bit_cast(f32x4, xw); }
                }
#pragma unroll
            for (int m = 0; m < 4; ++m) {
                const int row = u.pm * BM + ai * HALF + wr * 64 + m * 16 + fr; float sq = 0.f;
#pragma unroll
                for (int bj = 0; bj < 2; ++bj) {
                    const size_t off = (size_t)row * D + cbase + bj * HALF;
                    f32x4 x0, x1;
                    if (IN_F32) { x0 = xr[m][bj][0]; x1 = xr[m][bj][1]; }
                    else { const u32x4 xw = __builtin_bit_cast(u32x4, xr[m][bj][0]); x0 = (f32x4){bf_lo(xw.x), bf_hi(xw.x), bf_lo(xw.y), bf_hi(xw.y)}; x1 = (f32x4){bf_lo(xw.z), bf_hi(xw.z), bf_lo(xw.w), bf_hi(xw.w)}; }
                    const f32x4 y0 = x0 + acc[ai][bj][m][0] * alpha, y1 = x1 + acc[ai][bj][m][1] * alpha;
                    if (FINAL) { *(f32x4*)(xout + off) = y0; *(f32x4*)(xout + off + 4) = y1; }
                    else {
                        sq += (y0[0] * y0[0] + y0[1] * y0[1]) + (y0[2] * y0[2] + y0[3] * y0[3]) + (y1[0] * y1[0] + y1[1] * y1[1]) + (y1[2] * y1[2] + y1[3] * y1[3]);
                        u32x4 w; w.x = cvt_pk_bf16(y0[0], y0[1]); w.y = cvt_pk_bf16(y0[2], y0[3]); w.z = cvt_pk_bf16(y1[0], y1[1]); w.w = cvt_pk_bf16(y1[2], y1[3]);
                        *(u32x4*)(xb + off) = w;
                    }
                }
                if (!FINAL) { sq += __shfl_xor(sq, 16); sq += __shfl_xor(sq, 32); if (fq == 0) red[(ai * HALF + wr * 64 + m * 16 + fr) * 4 + wc] = sq; }
            }
        }
        if (!FINAL) {
            asm volatile("s_waitcnt lgkmcnt(0)" ::: "memory"); __builtin_amdgcn_s_barrier(); asm volatile("" ::: "memory");
            const int t = threadIdx.x;
            if (t < BM) { const f32x4 v = ((const LAS f32x4*)red)[t]; atomicAdd(ssn + u.pm * BM + t, (v[0] + v[1]) + (v[2] + v[3])); }
        }
    } };
typedef EpiResid<true, false> EpiResidIn; typedef EpiResid<false, false> EpiResidMid; typedef EpiResid<false, true> EpiResidOut;

struct EpiWin { const float* ss; bf16_t* gb; bf16_t* rec;
    __device__ __forceinline__ void operator()(const Acc& acc, const Unit& u, int wr, int wc, int fr, int fq) const {
        const bool isg = u.pn < 4; const int ct = (u.pn & 3) * BM;
        float rs8[2][4]; rstd8(ss, u.pm * BM + wr * 64 + fr, rs8);
#pragma unroll
        for (int ai = 0; ai < 2; ++ai)
#pragma unroll
            for (int m = 0; m < 4; ++m) {
                const int row = u.pm * BM + ai * HALF + wr * 64 + m * 16 + fr; const float rs = rs8[ai][m];
#pragma unroll
                for (int bj = 0; bj < 2; ++bj) {
                    const size_t off = (size_t)row * D + ct + bj * HALF + wc * 32 + 8 * fq;
                    const f32x4 v0 = acc[ai][bj][m][0] * rs, v1 = acc[ai][bj][m][1] * rs;
                    if (isg) { u32x4 w; w.x = cvt_pk_bf16(gelu_tanh(v0[0]), gelu_tanh(v0[1])); w.y = cvt_pk_bf16(gelu_tanh(v0[2]), gelu_tanh(v0[3]));
                        w.z = cvt_pk_bf16(gelu_tanh(v1[0]), gelu_tanh(v1[1])); w.w = cvt_pk_bf16(gelu_tanh(v1[2]), gelu_tanh(v1[3])); *(u32x4*)(gb + off) = w; }
                    else { u32x4 w; w.x = cvt_pk_bf16(v0[0], v0[1]); w.y = cvt_pk_bf16(v0[2], v0[3]); w.z = cvt_pk_bf16(v1[0], v1[1]); w.w = cvt_pk_bf16(v1[2], v1[3]); *(u32x4*)(rec + off) = w; }
                }
            }
    } };

struct EpiGate { const bf16_t* xc; const float* b_r; const float* b_i; const float* sp8; bf16_t* aout; bf16_t* uout;
    __device__ __forceinline__ void operator()(const Acc& acc, const Unit& u, int wr, int wc, int fr, int fq) const {
        const int ch = u.pn * 128 + wc * 32 + 8 * fq;
        float br[8], bi[8], sp[8];
#pragma unroll
        for (int n = 0; n < 2; ++n) { const f32x4 a_ = *(const f32x4*)(b_r + ch + 4 * n), b_ = *(const f32x4*)(b_i + ch + 4 * n), c_ = *(const f32x4*)(sp8 + ch + 4 * n);
#pragma unroll
            for (int j = 0; j < 4; ++j) { br[4 * n + j] = a_[j]; bi[4 * n + j] = b_[j]; sp[4 * n + j] = c_[j]; } }
        u32x4 xcw[2][4];
#pragma unroll
        for (int ai = 0; ai < 2; ++ai)
#pragma unroll
            for (int m = 0; m < 4; ++m) xcw[ai][m] = *(const u32x4*)(xc + (size_t)(u.pm * BM + ai * HALF + wr * 64 + m * 16 + fr) * D + ch);
#pragma unroll
        for (int ai = 0; ai < 2; ++ai)
#pragma unroll
            for (int m = 0; m < 4; ++m) {
                const int row = u.pm * BM + ai * HALF + wr * 64 + m * 16 + fr; const size_t off = (size_t)row * D + ch;
                const u32x4 xw = xcw[ai][m];
                const float xv[8] = {bf_lo(xw.x), bf_hi(xw.x), bf_lo(xw.y), bf_hi(xw.y), bf_lo(xw.z), bf_hi(xw.z), bf_lo(xw.w), bf_hi(xw.w)};
                float av[8], uv[8];
#pragma unroll
                for (int j = 0; j < 8; ++j) {
                    const float r = sigm(acc[ai][0][m][j >> 2][j & 3] + br[j]), ig = sigm(acc[ai][1][m][j >> 2][j & 3] + bi[j]);
                    const float la2 = r * sp[j];
                    const float a = __builtin_amdgcn_exp2f(la2);
                    av[j] = la2; uv[j] = __builtin_amdgcn_sqrtf(fmaxf(1.0f - a * a, 0.f)) * ig * xv[j];
                }
                u32x4 wa; wa.x = cvt_pk_bf16(av[0], av[1]); wa.y = cvt_pk_bf16(av[2], av[3]); wa.z = cvt_pk_bf16(av[4], av[5]); wa.w = cvt_pk_bf16(av[6], av[7]);
                *(u32x4*)(aout + off) = wa;
                u32x4 w; w.x = cvt_pk_bf16(uv[0], uv[1]); w.y = cvt_pk_bf16(uv[2], uv[3]); w.z = cvt_pk_bf16(uv[4], uv[5]); w.w = cvt_pk_bf16(uv[6], uv[7]);
                *(u32x4*)(uout + off) = w;
            }
    } };

__device__ __forceinline__ void epi_headnorm(const Acc& acc, int pm, int pnh, int wr, int wc, int fr, int fq, const float* ss, const float* gain, float oscale, bf16_t* out) {
    const int head = 4 * pnh + wc;
    float sc[2][4]; rstd8(ss, pm * BM + wr * 64 + fr, sc);
#pragma unroll
    for (int ai = 0; ai < 2; ++ai)
#pragma unroll
        for (int m = 0; m < 4; ++m) {
            const float rs = sc[ai][m];
            float sq = 0.f;
#pragma unroll
            for (int bj = 0; bj < 2; ++bj)
#pragma unroll
                for (int n = 0; n < 2; ++n) { const f32x4 v = acc[ai][bj][m][n]; sq += (v[0] * v[0] + v[1] * v[1]) + (v[2] * v[2] + v[3] * v[3]); }
            sq += __shfl_xor(sq, 16); sq += __shfl_xor(sq, 32);
            sc[ai][m] = rs * oscale * __builtin_amdgcn_rsqf(sq * rs * rs * (1.0f / HD) + EPS);
        }
#pragma unroll
    for (int bj = 0; bj < 2; ++bj) {
        const f32x4 g0 = *(const f32x4*)(gain + 32 * bj + 8 * fq), g1 = *(const f32x4*)(gain + 32 * bj + 8 * fq + 4);
#pragma unroll
        for (int ai = 0; ai < 2; ++ai)
#pragma unroll
            for (int m = 0; m < 4; ++m) {
                const int row = pm * BM + ai * HALF + wr * 64 + m * 16 + fr;
                const f32x4 v0 = acc[ai][bj][m][0] * g0 * sc[ai][m], v1 = acc[ai][bj][m][1] * g1 * sc[ai][m];
                u32x4 w; w.x = cvt_pk_bf16(v0[0], v0[1]); w.y = cvt_pk_bf16(v0[2], v0[3]); w.z = cvt_pk_bf16(v1[0], v1[1]); w.w = cvt_pk_bf16(v1[2], v1[3]);
                *(u32x4*)(out + (size_t)row * D + head * HD + 32 * bj + 8 * fq) = w;
                asm volatile("" ::: "memory");
            }
    }
}
struct EpiQ { const float* ss; const float* gain; bf16_t* q;
    __device__ __forceinline__ void operator()(const Acc& acc, const Unit& u, int wr, int wc, int fr, int fq) const { epi_headnorm(acc, u.pm, u.pn, wr, wc, fr, fq, ss, gain, 0.125f * LOG2E, q); } };
struct EpiKvSwiglu { const float* ss; const float* kgain; bf16_t* kout; bf16_t* vt; bf16_t* act;
    __device__ __forceinline__ void operator()(const Acc& acc, const Unit& u, int wr, int wc, int fr, int fq) const {
        if (u.pn >= 8) { epi_swiglu(acc, u.pm, u.pn - 8, wr, wc, fr, fq, ss, act); return; }
        if (u.pn < 4) { epi_headnorm(acc, u.pm, u.pn, wr, wc, fr, fq, ss, kgain, 1.0f, kout); return; }
        const int head = 4 * (u.pn - 4) + wc;
        float rs8[2][4]; rstd8(ss, u.pm * BM + wr * 64 + fr, rs8);
        const int row0 = u.pm * BM + wr * 64 + fr, b = row0 / SEQ, s0 = row0 % SEQ;
        bf16_t* base = vt + ((size_t)(b * NH + head) * HD + 8 * fq) * SEQ + s0;
#pragma unroll
        for (int bj = 0; bj < 2; ++bj)
#pragma unroll
            for (int j = 0; j < 8; ++j) {
                bf16_t* p = base + (size_t)(32 * bj + j) * SEQ;
#pragma unroll
                for (int ai = 0; ai < 2; ++ai)
#pragma unroll
                    for (int m = 0; m < 4; ++m) p[ai * HALF + m * 16] = (bf16_t)(cvt_pk_bf16(acc[ai][bj][m][j >> 2][j & 3] * rs8[ai][m], 0.f) & 0xffffu);
                asm volatile("" ::: "memory");
            }
    } };
}


#define XB_TMO      128
#define XB_XCNT(j)  (256  + 64 * (j))
#define XB_XSUB(j)  (1280 + 64 * (j))
#define XB_XGEN(j)  (2304 + 64 * (j))
#define XB_TOP      3328
#define XB_TOPGEN   3392
#define XCD_BAR_WORDS 3456
#define XB_SPIN_CAP (1u << 18)
__device__ __forceinline__ unsigned xb_ld(unsigned* p)              { return __hip_atomic_load(p, __ATOMIC_RELAXED, __HIP_MEMORY_SCOPE_AGENT); }
__device__ __forceinline__ unsigned xb_add(unsigned* p, unsigned v) { return __hip_atomic_fetch_add(p, v, __ATOMIC_RELAXED, __HIP_MEMORY_SCOPE_AGENT); }
__device__ __forceinline__ unsigned xb_xcc_id() { return (unsigned)__builtin_amdgcn_s_getreg((3 << 11) | 20) & 0xFu; }
#define XB_SPIN(cond, bar) do { unsigned _sp = 0; while (cond) { __builtin_amdgcn_s_sleep(1); \
    if ((++_sp & 255u) == 0u) { if (xb_ld(&(bar)[XB_TMO])) break; if (_sp > XB_SPIN_CAP) { atomicAdd(&(bar)[XB_TMO], 1u); break; } } } } while (0)
struct XcdBarrier { unsigned* bar; unsigned x; volatile LAS unsigned* st; };
__device__ __forceinline__ XcdBarrier xcd_barrier_post(unsigned* bar, volatile LAS unsigned* st) {
    XcdBarrier b; b.bar = bar; b.x = xb_xcc_id(); b.st = st;
    if (threadIdx.x == 0) (void)xb_add(&bar[XB_XCNT(b.x)], 1u);
    return b;
}
__device__ __forceinline__ void xcd_barrier_complete(unsigned* bar, unsigned x, unsigned& nloc, unsigned& nx) {
    const unsigned G = gridDim.x * gridDim.y * gridDim.z;
    unsigned sum, cnt, mine, sp = 0u;
    for (;;) {
        sum = 0u; cnt = 0u; mine = 0u;
#pragma unroll
        for (unsigned j = 0; j < 16; ++j) { const unsigned c = xb_ld(&bar[XB_XCNT(j)]); sum += c; cnt += (c > 0u) ? 1u : 0u; mine = (j == x) ? c : mine; }
        if (sum == G) break;
        __builtin_amdgcn_s_sleep(1);
        if ((++sp & 255u) == 0u) { if (xb_ld(&bar[XB_TMO])) break; if (sp > XB_SPIN_CAP) { atomicAdd(&bar[XB_TMO], 1u); break; } }
    }
    nloc = mine > 0u ? mine : 1u; nx = cnt > 0u ? cnt : 1u;
}
__device__ __forceinline__ void xcd_barrier(const XcdBarrier& b) {
    asm volatile("s_waitcnt vmcnt(0)" ::: "memory");
    __syncthreads();
    if (threadIdx.x == 0) {
        unsigned* bar = b.bar;
        __builtin_amdgcn_s_waitcnt(0);
        unsigned nloc = b.st[0], nx = b.st[1];
        if (nloc == 0u) { xcd_barrier_complete(bar, b.x, nloc, nx); b.st[0] = nloc; b.st[1] = nx; }
        const unsigned old = xb_add(&bar[XB_XSUB(b.x)], 1u);
        const unsigned gen = old / nloc;
        if (old + 1u == (gen + 1u) * nloc) {
            __builtin_amdgcn_fence(__ATOMIC_RELEASE, "agent");
            asm volatile("s_waitcnt vmcnt(0)" ::: "memory");
            const unsigned og = xb_add(&bar[XB_TOP], 1u);
            const unsigned tg = og / nx;
            if (og + 1u == (tg + 1u) * nx) xb_add(&bar[XB_TOPGEN], 1u);
            else XB_SPIN(xb_ld(&bar[XB_TOPGEN]) == tg, bar);
            __builtin_amdgcn_fence(__ATOMIC_ACQUIRE, "agent");
            xb_add(&bar[XB_XGEN(b.x)], 1u);
            asm volatile("s_waitcnt vmcnt(0)" ::: "memory");
        } else {
            XB_SPIN(xb_ld(&bar[XB_XGEN(b.x)]) == gen, bar);
            __builtin_amdgcn_fence(__ATOMIC_ACQUIRE, "agent");
            asm volatile("s_waitcnt vmcnt(0)" ::: "memory");
        }
    }
    __syncthreads();
}

constexpr int N_PHASES = 18;
constexpr int NWAVES = 8, NTHR = NWAVES * 64;
constexpr int MISC_OFF = 8 * 16896, LDS_BYTES = MISC_OFF + 256;

struct Args { const float* in[23]; float* out; unsigned char* ws; int ph_lo, ph_hi; };

struct Frame { LAS unsigned char* lds; int tid, lane, wave, G, gw, NGW; };

struct CvtDesc { const float* W; const float* W2; bf16_t* dst; const float* gain; int ldw, K, nb, mode; };
constexpr int SCR_STRIDE = 64 * 65 * 4;
__device__ __forceinline__ void cvt_item(const CvtDesc& d, int local, LAS float* scr, int lane) {
    const int kb = local / d.nb, gI = local % d.nb, k0 = 64 * kb, n0 = 64 * gI;
    const int l16 = lane & 15, l4 = lane >> 4, n = n0 + 4 * l16;
    const float* W = d.W; int c0;
    if (d.mode == 0) c0 = n;
    else if (d.mode == 1) { const int tile = n >> 8, bj = (n >> 7) & 1, j0 = n & 127; c0 = bj * FF + tile * 128 + j0; }
    else if (d.mode == 2) { const int pn = n >> 8, bj = (n >> 7) & 1, wc = (n >> 5) & 3, j0 = n & 31; c0 = 256 * pn + 64 * wc + 32 * bj + j0; }
    else { const int t = n >> 8, blk = t >> 1, half = t & 1, which = (n >> 7) & 1, j0 = n & 127; W = (which ? d.W2 : d.W) + (size_t)blk * 65536; c0 = half * 128 + j0; }
    const float* wp = W + (size_t)(k0 + l4) * d.ldw + c0;
    f32x4 v[16];
#pragma unroll
    for (int i = 0; i < 16; ++i) v[i] = *(const f32x4*)(wp + (size_t)(4 * i) * d.ldw);
    if (d.gain) {
#pragma unroll
        for (int i = 0; i < 16; ++i) v[i] *= d.gain[k0 + 4 * i + l4];
    }
#pragma unroll
    for (int i = 0; i < 16; ++i) { LAS float* s = scr + (4 * i + l4) * 65 + 4 * l16; s[0] = v[i][0]; s[1] = v[i][1]; s[2] = v[i][2]; s[3] = v[i][3]; }
    LDS_WAIT(); asm volatile("" ::: "memory");
    const int c = lane & 7;
#pragma unroll
    for (int j = 0; j < 8; ++j) { const int nn = (lane >> 3) + 8 * j; const LAS float* s = scr + (8 * c) * 65 + nn;
        u32x4 o; o.x = cvt_pk_bf16(s[0 * 65], s[1 * 65]); o.y = cvt_pk_bf16(s[2 * 65], s[3 * 65]); o.z = cvt_pk_bf16(s[4 * 65], s[5 * 65]); o.w = cvt_pk_bf16(s[6 * 65], s[7 * 65]);
        *(u32x4*)(d.dst + (size_t)(n0 + nn) * d.K + k0 + 8 * c) = o; }
    LDS_WAIT(); asm volatile("" ::: "memory");
}
enum { I_X = 0, I_F1N, I_F1W13, I_F1W2, I_MIXN, I_AWIN, I_ACW, I_ACB, I_AWR, I_ABR, I_AWI, I_ABI, I_ALAM, I_AWOUT, I_KVN, I_WKV, I_KN, I_BWQ, I_QN, I_BWO, I_F2N, I_F2W13, I_F2W2 };
constexpr int IT_W13 = (D / 64) * (2 * FF / 64), IT_W2 = (FF / 64) * (D / 64), IT_2048 = (D / 64) * (2048 / 64), IT_1024 = (D / 64) * (D / 64), IT_RI = (256 / 64) * (2048 / 64);
__device__ __forceinline__ CvtDesc cvt_desc(const Args& a, int id) {
    unsigned char* ws = a.ws; CvtDesc d; d.W2 = nullptr; d.gain = nullptr;
    switch (id) {
    case 0: d = {a.in[I_F1W13], nullptr, (bf16_t*)(ws + WS_WA13), a.in[I_F1N], 2 * FF, D, 2 * FF / 64, 1}; break;
    case 1: d = {a.in[I_F1W2], nullptr, (bf16_t*)(ws + WS_WA2), nullptr, D, FF, D / 64, 0}; break;
    case 2: d = {a.in[I_F2W13], nullptr, (bf16_t*)(ws + WS_WB13), a.in[I_F2N], 2 * FF, D, 2 * FF / 64, 1}; break;
    case 3: d = {a.in[I_F2W2], nullptr, (bf16_t*)(ws + WS_WB2), nullptr, D, FF, D / 64, 0}; break;
    case 4: d = {a.in[I_WKV], nullptr, (bf16_t*)(ws + WS_WKV), a.in[I_KVN], 2048, D, 2048 / 64, 2}; break;
    case 5: d = {a.in[I_F1W13] + (size_t)D * 2 * FF, nullptr, (bf16_t*)(ws + WS_WC13), a.in[I_F1N] + D, 2 * FF, D, 2 * FF / 64, 1}; break;
    case 6: d = {a.in[I_F1W2] + (size_t)FF * D, nullptr, (bf16_t*)(ws + WS_WC2), nullptr, D, FF, D / 64, 0}; break;
    case 7: d = {a.in[I_AWIN], nullptr, (bf16_t*)(ws + WS_WIN), a.in[I_MIXN], 2048, D, 2048 / 64, 0}; break;
    case 8: d = {a.in[I_AWR], a.in[I_AWI], (bf16_t*)(ws + WS_WRI), nullptr, 256, 256, 2048 / 64, 3}; break;
    case 9: d = {a.in[I_AWOUT], nullptr, (bf16_t*)(ws + WS_WOUT), nullptr, D, D, D / 64, 0}; break;
    case 10: d = {a.in[I_BWQ], nullptr, (bf16_t*)(ws + WS_WQ), a.in[I_MIXN] + D, D, D, D / 64, 2}; break;
    case 11: d = {a.in[I_BWO], nullptr, (bf16_t*)(ws + WS_WO), nullptr, D, D, D / 64, 0}; break;
    case 12: d = {a.in[I_F2W13] + (size_t)D * 2 * FF, nullptr, (bf16_t*)(ws + WS_WA13), a.in[I_F2N] + D, 2 * FF, D, 2 * FF / 64, 1}; break;
    default: d = {a.in[I_F2W2] + (size_t)FF * D, nullptr, (bf16_t*)(ws + WS_WA2), nullptr, D, FF, D / 64, 0}; break;
    }
    return d;
}
__device__ __forceinline__ int cvt_items(int id) {
    switch (id) { case 0: case 2: case 5: case 12: return IT_W13; case 1: case 3: case 6: case 13: return IT_W2; case 4: case 7: return IT_2048; case 8: return IT_RI; default: return IT_1024; }
}
__device__ __forceinline__ void cvt_range(const Args& a, const Frame& F, int id_lo, int id_hi, int wg_lo, int wg_n) {
    LAS float* scr = (LAS float*)(F.lds + F.wave * 16896);
    int total = 0; for (int id = id_lo; id < id_hi; ++id) total += cvt_items(id);
    const int rank = (int)blockIdx.x - wg_lo; if (rank < 0 || rank >= wg_n) return;
    for (int it = rank * NWAVES + F.wave; it < total; it += wg_n * NWAVES) {
        int r = it, id = id_lo; while (r >= cvt_items(id)) { r -= cvt_items(id); ++id; }
        const CvtDesc d = cvt_desc(a, id); cvt_item(d, r, scr, F.lane);
    }
}

__device__ __forceinline__ void p0_rows(const Args& a, const Frame& F) {
    const float* x = a.in[I_X]; bf16_t* xb = (bf16_t*)(a.ws + WS_XB); float* ss = (float*)(a.ws + WS_SS);
    for (int m = F.gw; m < M; m += 2 * F.NGW) {
        const int m2 = m + F.NGW;
        const bool has2 = m2 < M;
        const f32x4* xr = (const f32x4*)(x + (size_t)m * D) + F.lane; const f32x4* xr2 = (const f32x4*)(x + (size_t)(has2 ? m2 : m) * D) + F.lane;
        f32x4 v[4], v2[4]; float s = 0.f, s2 = 0.f;
#pragma unroll
        for (int j = 0; j < 4; ++j) { v[j] = xr[64 * j]; v2[j] = xr2[64 * j]; }
#pragma unroll
        for (int j = 0; j < 4; ++j) { s += (v[j][0] * v[j][0] + v[j][1] * v[j][1]) + (v[j][2] * v[j][2] + v[j][3] * v[j][3]); s2 += (v2[j][0] * v2[j][0] + v2[j][1] * v2[j][1]) + (v2[j][2] * v2[j][2] + v2[j][3] * v2[j][3]); }
        s = wave_sum(s); s2 = wave_sum(s2);
        u32x2* o = (u32x2*)(xb + (size_t)m * D) + F.lane; u32x2* o2 = (u32x2*)(xb + (size_t)m2 * D) + F.lane;
#pragma unroll
        for (int j = 0; j < 4; ++j) { u32x2 w; w.x = cvt_pk_bf16(v[j][0], v[j][1]); w.y = cvt_pk_bf16(v[j][2], v[j][3]); o[64 * j] = w;
            if (has2) { u32x2 w2; w2.x = cvt_pk_bf16(v2[j][0], v2[j][1]); w2.y = cvt_pk_bf16(v2[j][2], v2[j][3]); o2[64 * j] = w2; } }
        if (F.lane == 0) { ss[m] = s; if (has2) ss[m2] = s2; }
    }
    for (int i = blockIdx.x * NTHR + F.tid; i < 5 * M; i += F.G * NTHR) ss[M + i] = 0.f;
    if (blockIdx.x == 0) for (int c = F.tid; c < D; c += NTHR) { const float l = a.in[I_ALAM][c]; ((float*)(a.ws + WS_SP8))[c] = -8.0f * LOG2E * (fmaxf(-l, 0.f) + log1pf(expf(-fabsf(l)))); }
}

__device__ __forceinline__ void conv_phase(const Args& a, const Frame& F) {
    const bf16_t* rec = (const bf16_t*)(a.ws + WS_REC); bf16_t* xc = (bf16_t*)(a.ws + WS_Y);
    constexpr int CR = 16, NITEM = (M / CR) * 4;
    for (int it = F.gw; it < NITEM; it += F.NGW) {
        const int cq = it & 3, m0 = (it >> 2) * CR, t0 = m0 & (SEQ - 1), ch = cq * 256 + 4 * F.lane;
        f32x4 w[4];
#pragma unroll
        for (int k = 0; k < 4; ++k) w[k] = *(const f32x4*)(a.in[I_ACW] + k * D + ch);
        const f32x4 bv = *(const f32x4*)(a.in[I_ACB] + ch);
        u32x2 rw[CR + 3];
#pragma unroll
        for (int i = 0; i < CR + 3; ++i) { const int r = m0 - 3 + i; rw[i] = (i >= 3 || t0 > 0) ? *(const u32x2*)(rec + (size_t)r * D + ch) : (u32x2){0u, 0u}; }
#pragma unroll
        for (int i = 0; i < CR; ++i) {
            f32x4 y = bv;
#pragma unroll
            for (int k = 0; k < 4; ++k) { const u32x2 q = rw[i + k]; y += w[k] * (f32x4){bf_lo(q.x), bf_hi(q.x), bf_lo(q.y), bf_hi(q.y)}; }
            u32x2 o; o.x = cvt_pk_bf16(y[0], y[1]); o.y = cvt_pk_bf16(y[2], y[3]); *(u32x2*)(xc + (size_t)(m0 + i) * D + ch) = o;
        }
    }
}

__device__ __forceinline__ f32x4 bf4(u32x2 q) { return (f32x4){bf_lo(q.x), bf_hi(q.x), bf_lo(q.y), bf_hi(q.y)}; }
__device__ __forceinline__ void conv_local(const Args& a, const Frame& F) {
    asm volatile("s_waitcnt vmcnt(0)" ::: "memory"); __syncthreads();
    const bf16_t* rec = (const bf16_t*)(a.ws + WS_REC); bf16_t* xc = (bf16_t*)(a.ws + WS_Y); bf16_t* stash = (bf16_t*)(a.ws + WS_STASH);
    pg8::StaticOrder S; S.init(M, 2048, F.G, (int)blockIdx.x); S.rot = 4; pg8::Unit u;
    for (int i = 0; S.next(i, u); ++i) {
        if (u.pn < 4) continue;
        const int ch = (u.pn - 4) * 256 + 4 * F.lane, R0 = u.pm * 256;
        f32x4 w[4];
#pragma unroll
        for (int k = 0; k < 4; ++k) w[k] = *(const f32x4*)(a.in[I_ACW] + k * D + ch);
        const f32x4 bv = *(const f32x4*)(a.in[I_ACB] + ch);
        if (F.wave < 6) { const int sr = F.wave < 3 ? F.wave : 250 + F.wave;
            *(u32x2*)(stash + ((size_t)u.pm * 6 + F.wave) * D + ch) = *(const u32x2*)(rec + (size_t)(R0 + sr) * D + ch); }
#pragma unroll 1
        for (int hblk = 0; hblk < 2; ++hblk) {
            const int r0 = 3 + 32 * F.wave + 16 * hblk;
            u32x2 rw[19];
#pragma unroll
            for (int q = 0; q < 19; ++q) { const int r = r0 - 3 + q; rw[q] = (r < 256) ? *(const u32x2*)(rec + (size_t)(R0 + r) * D + ch) : (u32x2){0u, 0u}; }
#pragma unroll
            for (int q = 0; q < 16; ++q) {
                f32x4 y = bv;
#pragma unroll
                for (int k = 0; k < 4; ++k) y += w[k] * bf4(rw[q + k]);
                u32x2 o; o.x = cvt_pk_bf16(y[0], y[1]); o.y = cvt_pk_bf16(y[2], y[3]);
                if (r0 + q < 256) *(u32x2*)(xc + (size_t)(R0 + r0 + q) * D + ch) = o;
            }
        }
    }
}
__device__ __forceinline__ void conv_edge(const Args& a, const Frame& F) {
    const bf16_t* stash = (const bf16_t*)(a.ws + WS_STASH); bf16_t* xc = (bf16_t*)(a.ws + WS_Y);
    pg8::StaticOrder S; S.init(M, 2048, F.G, (int)blockIdx.x); pg8::Unit u;
    for (int i = 0; S.next(i, u); ++i) {
        if (F.wave < 3) {
            const int ch = (u.pn >> 1) * 256 + 4 * F.lane, R0 = u.pm * 256; const bool first = (R0 % SEQ) == 0;
            f32x4 y = *(const f32x4*)(a.in[I_ACB] + ch);
#pragma unroll
            for (int k = 0; k < 4; ++k) { const int s = F.wave - 3 + k;
                const f32x4 wk = *(const f32x4*)(a.in[I_ACW] + k * D + ch);
                if (s >= 0) y += wk * bf4(*(const u32x2*)(stash + ((size_t)u.pm * 6 + s) * D + ch));
                else if (!first) y += wk * bf4(*(const u32x2*)(stash + ((size_t)(u.pm - 1) * 6 + 6 + s) * D + ch)); }
            u32x2 o; o.x = cvt_pk_bf16(y[0], y[1]); o.y = cvt_pk_bf16(y[2], y[3]);
            *(u32x2*)(xc + (size_t)(R0 + F.wave) * D + ch) = o;
        }
    }
    asm volatile("s_waitcnt vmcnt(0)" ::: "memory"); __syncthreads();
}

constexpr int SC_L = 64, SC_C = SEQ / SC_L;
__device__ __forceinline__ void scan_a(const Args& a, const Frame& F) {
    const bf16_t* av = (const bf16_t*)(a.ws + WS_REC); const bf16_t* uv = (const bf16_t*)(a.ws + WS_U);
    f32x4* hl = (f32x4*)(a.ws + WS_HL); f32x4* pc = (f32x4*)(a.ws + WS_PC);
    if (F.tid >= 256) return;
    for (int item = blockIdx.x * 256 + F.tid; item < BATCH * SC_C * 256; item += F.G * 256) {
        const int cgp = item & 255, bc = item >> 8; const size_t row0 = (size_t)bc * SC_L;
        f32x4 h = {0.f, 0.f, 0.f, 0.f}, p = {1.f, 1.f, 1.f, 1.f};
#pragma unroll 8
        for (int t = 0; t < SC_L; ++t) { const u32x2 aw = *(const u32x2*)(av + (row0 + t) * D + 4 * cgp); const f32x4 aa = {__builtin_amdgcn_exp2f(bf_lo(aw.x)), __builtin_amdgcn_exp2f(bf_hi(aw.x)), __builtin_amdgcn_exp2f(bf_lo(aw.y)), __builtin_amdgcn_exp2f(bf_hi(aw.y))}; const u32x2 uw = *(const u32x2*)(uv + (row0 + t) * D + 4 * cgp);
            const f32x4 uu = {bf_lo(uw.x), bf_hi(uw.x), bf_lo(uw.y), bf_hi(uw.y)}; h = aa * h + uu; p = p * aa; }
        hl[item] = h; pc[item] = p;
    }
}
__device__ __forceinline__ void scan_a_local(const Args& a, const Frame& F) {
    asm volatile("s_waitcnt vmcnt(0)" ::: "memory"); __syncthreads();
    const bf16_t* av = (const bf16_t*)(a.ws + WS_REC); const bf16_t* uv = (const bf16_t*)(a.ws + WS_U);
    f32x4* hl = (f32x4*)(a.ws + WS_HL); f32x4* pc = (f32x4*)(a.ws + WS_PC);
    pg8::StaticOrder S; S.init(M, 2048, F.G, (int)blockIdx.x); pg8::Unit u0, mine;
    const int sel = F.tid >> 7, t = F.tid & 127, ck4 = t >> 5, cgl = t & 31;
    for (int i0 = 0; S.next(i0, u0); i0 += 4) {
        if (!S.next(i0 + sel, mine)) continue;
        const size_t row0 = (size_t)mine.pm * 256 + ck4 * SC_L; const int cgp = mine.pn * 32 + cgl;
        f32x4 h = {0.f, 0.f, 0.f, 0.f}, p = {1.f, 1.f, 1.f, 1.f};
#pragma unroll 8
        for (int tt = 0; tt < SC_L; ++tt) { const u32x2 aw = *(const u32x2*)(av + (row0 + tt) * D + 4 * cgp); const f32x4 aa = {__builtin_amdgcn_exp2f(bf_lo(aw.x)), __builtin_amdgcn_exp2f(bf_hi(aw.x)), __builtin_amdgcn_exp2f(bf_lo(aw.y)), __builtin_amdgcn_exp2f(bf_hi(aw.y))};
            const u32x2 uw = *(const u32x2*)(uv + (row0 + tt) * D + 4 * cgp);
            const f32x4 uu = {bf_lo(uw.x), bf_hi(uw.x), bf_lo(uw.y), bf_hi(uw.y)}; h = aa * h + uu; p = p * aa; }
        const int item = (int)(row0 / SC_L) * 256 + cgp;
        hl[item] = h; pc[item] = p;
    }
}
__device__ __forceinline__ void scan_b(const Args& a, const Frame& F) {
    const bf16_t* av = (const bf16_t*)(a.ws + WS_REC); const bf16_t* uv = (const bf16_t*)(a.ws + WS_U); const bf16_t* gb = (const bf16_t*)(a.ws + WS_GB); bf16_t* yb = (bf16_t*)(a.ws + WS_Y);
    const f32x4* hl = (const f32x4*)(a.ws + WS_HL); const f32x4* pc = (const f32x4*)(a.ws + WS_PC);
    if (F.tid >= 256) return;
    for (int item = blockIdx.x * 256 + F.tid; item < BATCH * SC_C * 256; item += F.G * 256) {
        const int cgp = item & 255, bc = item >> 8, ck = bc & (SC_C - 1), b0 = bc - ck; const size_t row0 = (size_t)bc * SC_L;
        f32x4 h = {0.f, 0.f, 0.f, 0.f};
        int j = 0;
        for (; j + 8 <= ck; j += 8) {
            f32x4 pp[8], hh[8];
#pragma unroll
            for (int e = 0; e < 8; ++e) { pp[e] = pc[(b0 + j + e) * 256 + cgp]; hh[e] = hl[(b0 + j + e) * 256 + cgp]; }
#pragma unroll
            for (int e = 0; e < 8; ++e) h = pp[e] * h + hh[e];
        }
        for (; j < ck; ++j) h = pc[(b0 + j) * 256 + cgp] * h + hl[(b0 + j) * 256 + cgp];
#pragma unroll 8
        for (int t = 0; t < SC_L; ++t) { const size_t off = (row0 + t) * D + 4 * cgp; const u32x2 aw = *(const u32x2*)(av + off); const f32x4 aa = {__builtin_amdgcn_exp2f(bf_lo(aw.x)), __builtin_amdgcn_exp2f(bf_hi(aw.x)), __builtin_amdgcn_exp2f(bf_lo(aw.y)), __builtin_amdgcn_exp2f(bf_hi(aw.y))}; const u32x2 uw = *(const u32x2*)(uv + off);
            const f32x4 uu = {bf_lo(uw.x), bf_hi(uw.x), bf_lo(uw.y), bf_hi(uw.y)}; h = aa * h + uu;
            const u32x2 gw = *(const u32x2*)(gb + off); u32x2 o; o.x = cvt_pk_bf16(h[0] * bf_lo(gw.x), h[1] * bf_hi(gw.x)); o.y = cvt_pk_bf16(h[2] * bf_lo(gw.y), h[3] * bf_hi(gw.y));
            *(u32x2*)(yb + off) = o; }
    }
}

constexpr float SB_TINY = 5.42e-20f;
struct SbFrag { bf16x8 kf[4]; bf16x8 vf[2][2]; };
constexpr int ATT_KSTR = 1088, ATT_VOFF = 4 * ATT_KSTR, ATT_SLOT = ATT_VOFF + 4096, WAVE_LDS = 2 * ATT_SLOT;
__device__ __forceinline__ void sb_dma(LAS unsigned char* slot, const bf16_t* kg, const bf16_t* vg, int k0) {
    const bf16_t* k = kg + (size_t)k0 * D; const bf16_t* v = vg + k0;
#define SB_GLDS(g, o) __builtin_amdgcn_global_load_lds((const unsigned*)(g), (LAS unsigned*)(slot + (o)), 16, 0, 0)
    SB_GLDS(k, 0); SB_GLDS(k + 8 * D, ATT_KSTR); SB_GLDS(k + 16 * D, 2 * ATT_KSTR); SB_GLDS(k + 24 * D, 3 * ATT_KSTR);
    SB_GLDS(v, ATT_VOFF); SB_GLDS(v + (size_t)16 * SEQ, ATT_VOFF + 1024); SB_GLDS(v + (size_t)32 * SEQ, ATT_VOFF + 2048); SB_GLDS(v + (size_t)48 * SEQ, ATT_VOFF + 3072);
#undef SB_GLDS
}
template <int N> __device__ __forceinline__ void sb_wait() { asm volatile("s_waitcnt vmcnt(%0)" :: "n"(N) : "memory"); }
struct SbAddr { int k[4]; int v[4]; };
__device__ __forceinline__ void sb_read(SbFrag& f, const LAS unsigned char* slot, const SbAddr& ad) {
#pragma unroll
    for (int d0 = 0; d0 < 4; ++d0) f.kf[d0] = *(const LAS bf16x8*)(slot + ad.k[d0]);
#pragma unroll
    for (int dh = 0; dh < 2; ++dh)
#pragma unroll
        for (int mm = 0; mm < 2; ++mm) f.vf[dh][mm] = *(const LAS bf16x8*)(slot + ad.v[dh * 2 + mm]);
}
template <bool DIAG> __device__ __forceinline__ void sb_tile(const SbFrag& f, const bf16x8 (&qf)[4], f32x16& o0, f32x16& o1, float& carry, int lim, int hi) {
    f32x16 s;
#pragma unroll
    for (int r = 0; r < 16; ++r) s[r] = 0.f;
#pragma unroll
    for (int d0 = 0; d0 < 4; ++d0) s = __builtin_amdgcn_mfma_f32_32x32x16_bf16(f.kf[d0], qf[d0], s, 0, 0, 0);
    float wv[16], t[16]; float run, zmax = -3.0e38f;
#pragma unroll
    for (int r = 0; r < 16; ++r) { zmax = fmaxf(zmax, s[r]); t[r] = __builtin_amdgcn_exp2f(s[r]); if (DIAG) t[r] = (r < lim) ? t[r] : 0.f; }
    if (!__any(zmax > 7.2f)) {
        float G = 1.f;
#pragma unroll
        for (int r = 0; r < 16; ++r) { wv[r] = t[r] * G; G *= 1.0f + t[r]; }
        run = __builtin_amdgcn_rcpf(G);
#pragma unroll
        for (int r = 0; r < 16; ++r) wv[r] *= run;
    } else {
        run = 1.f;
#pragma unroll
        for (int r = 15; r >= 0; --r) {
            float stay = __builtin_amdgcn_rcpf(1.0f + t[r]);
            float beta = 1.0f - stay;
            if (DIAG) { const bool ok = r < lim; stay = ok ? stay : 1.0f; beta = ok ? beta : 0.f; }
            wv[r] = beta * run; run *= stay;
        }
    }
    const float other = __shfl_xor(run, 32);
    const float base = carry * (hi == 0 ? other : 1.0f);
    carry *= run * other;
    u32x4 p0, p1;
    p0.x = cvt_pk_bf16(wv[0] * base, wv[1] * base); p0.y = cvt_pk_bf16(wv[2] * base, wv[3] * base); p0.z = cvt_pk_bf16(wv[4] * base, wv[5] * base); p0.w = cvt_pk_bf16(wv[6] * base, wv[7] * base);
    p1.x = cvt_pk_bf16(wv[8] * base, wv[9] * base); p1.y = cvt_pk_bf16(wv[10] * base, wv[11] * base); p1.z = cvt_pk_bf16(wv[12] * base, wv[13] * base); p1.w = cvt_pk_bf16(wv[14] * base, wv[15] * base);
    const bf16x8 pa0 = __builtin_bit_cast(bf16x8, p0), pa1 = __builtin_bit_cast(bf16x8, p1);
    o0 = __builtin_amdgcn_mfma_f32_32x32x16_bf16(pa0, f.vf[0][0], o0, 0, 0, 0); o0 = __builtin_amdgcn_mfma_f32_32x32x16_bf16(pa1, f.vf[0][1], o0, 0, 0, 0);
    o1 = __builtin_amdgcn_mfma_f32_32x32x16_bf16(pa0, f.vf[1][0], o1, 0, 0, 0); o1 = __builtin_amdgcn_mfma_f32_32x32x16_bf16(pa1, f.vf[1][1], o1, 0, 0, 0);
}
__device__ __forceinline__ void sb_unit(const bf16_t* Q, const bf16_t* K, const bf16_t* VT, bf16_t* O, int b, int h, int qb, int lane, LAS unsigned char* slotA, LAS unsigned char* slotB, const SbAddr& ad) {
    const int j = lane & 31, hi = lane >> 5, q0 = qb * 32; const size_t rowbase = (size_t)b * SEQ;
    const bf16_t* qp = Q + (rowbase + q0 + j) * D + h * HD + 8 * hi;
    bf16x8 qf[4];
#pragma unroll
    for (int d0 = 0; d0 < 4; ++d0) qf[d0] = *(const bf16x8*)(qp + 16 * d0);
    const int k8w = lane >> 3, cw = (lane & 7) ^ k8w, aw = lane >> 4, d16w = 4 * ((lane >> 2) & 3) + aw, pw = (lane & 3) ^ aw;
    const bf16_t* kg = K + (rowbase + k8w) * D + h * HD + 8 * cw;
    const bf16_t* vg = VT + ((size_t)(b * NH + h) * HD + d16w) * SEQ + 8 * pw;
    f32x16 o0, o1;
#pragma unroll
    for (int r = 0; r < 16; ++r) { o0[r] = 0.f; o1[r] = 0.f; }
    float carry = 1.f;
    SbFrag f;
    sb_dma(slotA, kg, vg, q0);
    sb_dma(slotB, kg, vg, qb > 0 ? q0 - 32 : 0);
    sb_wait<8>(); sb_read(f, slotA, ad);
    sb_tile<true>(f, qf, o0, o1, carry, j - 16 * hi, hi);
    for (int kt = qb - 1; kt >= 0; kt -= 2) {
        sb_dma(slotA, kg, vg, (kt > 0 ? kt - 1 : 0) * 32);
        sb_wait<8>(); sb_read(f, slotB, ad);
        sb_tile<false>(f, qf, o0, o1, carry, 64, hi);
        if (kt == 0 || __all(carry < SB_TINY)) break;
        sb_dma(slotB, kg, vg, (kt > 1 ? kt - 2 : 0) * 32);
        sb_wait<8>(); sb_read(f, slotA, ad);
        sb_tile<false>(f, qf, o0, o1, carry, 64, hi);
        if (__all(carry < SB_TINY)) break;
    }
    sb_wait<0>();
    bf16_t* op = O + (rowbase + q0) * D + h * HD + j;
#pragma unroll
    for (int r = 0; r < 16; ++r) { const int qr = (r & 3) + 8 * (r >> 2) + 4 * hi;
        op[(size_t)qr * D] = (bf16_t)(cvt_pk_bf16(o0[r], 0.f) & 0xffffu); op[(size_t)qr * D + 32] = (bf16_t)(cvt_pk_bf16(o1[r], 0.f) & 0xffffu); }
}
__device__ __forceinline__ void attn_phase(const Args& a, const Frame& F) {
    const bf16_t* Q = (const bf16_t*)(a.ws + WS_Q); const bf16_t* K = (const bf16_t*)(a.ws + WS_K); const bf16_t* VT = (const bf16_t*)(a.ws + WS_VT); bf16_t* O = (bf16_t*)(a.ws + WS_O);
    constexpr int NQB = SEQ / 32, NU = BATCH * NH * NQB;
    LAS unsigned char* slotA = F.lds + F.wave * WAVE_LDS;
    SbAddr ad;
    { const int j = F.lane & 31, hi = F.lane >> 5, key = 16 * ((j >> 2) & 1) + (j & 3) + 4 * (j >> 3), ki = key >> 3, k8 = key & 7;
#pragma unroll
      for (int d0 = 0; d0 < 4; ++d0) ad.k[d0] = ki * ATT_KSTR + (8 * k8 + ((2 * d0 + hi) ^ k8)) * 16;
#pragma unroll
      for (int dh = 0; dh < 2; ++dh)
#pragma unroll
          for (int mm = 0; mm < 2; ++mm) { const int dd = 32 * dh + j, vi = dd >> 4, d16 = dd & 15, a_ = d16 & 3, b_ = d16 >> 2, p = 2 * hi + mm; ad.v[dh * 2 + mm] = ATT_VOFF + vi * 1024 + (16 * a_ + 4 * b_ + (p ^ a_)) * 16; } }
    for (int u = F.gw; u < NU; u += F.NGW) { const int bh = u / NQB, qb = u % NQB; sb_unit(Q, K, VT, O, bh / NH, bh % NH, qb, F.lane, slotA, slotA + ATT_SLOT, ad); }
}

__global__ void __launch_bounds__(NTHR) fwd_kernel(Args args) {
    extern __shared__ __attribute__((aligned(16))) unsigned char lds_raw[];
    Frame F; F.lds = (LAS unsigned char*)lds_raw; F.tid = threadIdx.x; F.lane = F.tid & 63; F.wave = __builtin_amdgcn_readfirstlane(F.tid >> 6);
    F.G = gridDim.x; F.gw = blockIdx.x * NWAVES + F.wave; F.NGW = F.G * NWAVES;
    unsigned char* ws = args.ws;
    float* ss = (float*)(ws + WS_SS); LAS float* RED = (LAS float*)(F.lds + 131072);
    const int lo = args.ph_lo, hi = args.ph_hi;
#if MK_COOP
    cg::grid_group grid = cg::this_grid();
    volatile LAS unsigned* MISC = (volatile LAS unsigned*)(F.lds + MISC_OFF);
    if (F.tid < 16) MISC[F.tid] = 0u;
    __syncthreads();
    const XcdBarrier xbar = xcd_barrier_post((unsigned*)ws, MISC + 8);
    if (hi > N_PHASES) grid.sync();
#define SEAM(k) do { if (lo <= (k) && (k) + 1 < hi) xcd_barrier(xbar); } while (0)
#else
#define SEAM(k) do { } while (0)
#endif
#ifndef PH_MASK
#define PH_MASK 0x3ffff
#endif
#define IN(k) (((PH_MASK >> (k)) & 1) && lo <= (k) && (k) < hi)
    using namespace pg8;
    bf16_t* XB = (bf16_t*)(ws + WS_XB); bf16_t* ACT = (bf16_t*)(ws + WS_ACT);
    const int bx = blockIdx.x;
#define RUN_GEMM(EPI, ALIGN, Aptr, Bptr, N_, K_, lda_, adiv_, ...) do { Gemm g{(const bf16_t*)(Aptr), (const bf16_t*)(Bptr), M, (N_), (K_), (lda_), (adiv_)}; StaticOrder S; S.init(M, (N_), F.G, bx); \
        EPI E{__VA_ARGS__}; gemm_phase<EPI, ALIGN>(F.lds, g, S, E); } while (0)

#ifndef DUP_MASK
#define DUP_MASK 0
#endif
#if MK_COOP
#define REDO_BAR() xcd_barrier(xbar)
#else
#define REDO_BAR() do { } while (0)
#endif
#define PHASE(k, ...) do { if (IN(k)) { __VA_ARGS__; if ((DUP_MASK >> (k)) & 1) { REDO_BAR(); __VA_ARGS__; } } SEAM(k); } while (0)
    PHASE(0, cvt_range(args, F, 0, 1, 0, F.G); p0_rows(args, F));
    const int T22 = (64 * 22) % F.G, T30 = (64 * 30) % F.G;
    PHASE(1, RUN_GEMM(EpiSwiglu, true, XB, ws + WS_WA13, 2 * FF, D, D, 0, ss, ACT); cvt_range(args, F, 1, 4, T22, F.G - T22); cvt_range(args, F, 7, 10, T22, F.G - T22));
    PHASE(2, RUN_GEMM(EpiResidIn, true, ACT, ws + WS_WA2, D, FF, FF, 0, args.in[I_X], nullptr, XB, ss + M, 0.5f, RED));
    PHASE(3, { Gemm g{(const bf16_t*)XB, (const bf16_t*)(ws + WS_WIN), M, 2048, D, D, 0}; StaticOrder S; S.init(M, 2048, F.G, bx); S.rot = 4;
        EpiWin E{ss + M, (bf16_t*)(ws + WS_GB), (bf16_t*)(ws + WS_REC)}; gemm_phase<EpiWin, true>(F.lds, g, S, E); } conv_local(args, F));
    PHASE(5, conv_edge(args, F); RUN_GEMM(EpiGate, true, ws + WS_Y, ws + WS_WRI, 2048, 256, D, 2, (const bf16_t*)(ws + WS_Y), args.in[I_ABR], args.in[I_ABI], (const float*)(ws + WS_SP8), (bf16_t*)(ws + WS_REC), (bf16_t*)(ws + WS_U)); scan_a_local(args, F));
    PHASE(7, scan_b(args, F));
    PHASE(8, RUN_GEMM(EpiResidMid, true, ws + WS_Y, ws + WS_WOUT, D, D, D, 0, nullptr, nullptr, XB, ss + 2 * M, 1.0f, RED));
    PHASE(9, RUN_GEMM(EpiSwiglu, true, XB, ws + WS_WB13, 2 * FF, D, D, 0, ss + 2 * M, ACT); cvt_range(args, F, 4, 7, T22, F.G - T22));
    PHASE(10, RUN_GEMM(EpiResidMid, true, ACT, ws + WS_WB2, D, FF, FF, 0, nullptr, nullptr, XB, ss + 3 * M, 0.5f, RED));
    PHASE(11, RUN_GEMM(EpiKvSwiglu, true, XB, ws + WS_WKV, 2048 + 2 * FF, D, D, 0, ss + 3 * M, args.in[I_KN], (bf16_t*)(ws + WS_K), (bf16_t*)(ws + WS_VT), ACT); cvt_range(args, F, 10, 14, T30, F.G - T30));
    PHASE(12, RUN_GEMM(EpiResidMid, true, ACT, ws + WS_WC2, D, FF, FF, 0, nullptr, nullptr, XB, ss + 4 * M, 0.5f, RED));
    PHASE(13, RUN_GEMM(EpiQ, true, XB, ws + WS_WQ, D, D, D, 0, ss + 4 * M, args.in[I_QN], (bf16_t*)(ws + WS_Q)));
    PHASE(14, attn_phase(args, F));
    PHASE(15, RUN_GEMM(EpiResidMid, true, ws + WS_O, ws + WS_WO, D, D, D, 0, nullptr, nullptr, XB, ss + 5 * M, 1.0f, RED));
    PHASE(16, RUN_GEMM(EpiSwiglu, true, XB, ws + WS_WA13, 2 * FF, D, D, 0, ss + 5 * M, ACT));
    PHASE(17, RUN_GEMM(EpiResidOut, true, ACT, ws + WS_WA2, D, FF, FF, 0, nullptr, args.out, XB, nullptr, 0.5f, RED));
}

extern "C" void kernel_launch(void* const* d_in, const int* in_sizes, int n_in, void* d_out, int out_size, void* d_ws, size_t ws_size, hipStream_t stream) {
    static int grid = 0;
    if (grid == 0) {
        if (n_in != 23 || out_size != M * D || ws_size < WS_END) { fprintf(stderr, "kernel_launch: unexpected problem (n_in %d out %d ws %zu)\n", n_in, out_size, ws_size); grid = -1; return; }
        int dev = 0, cus = 0, per_cu = 0;
        (void)hipGetDevice(&dev); (void)hipDeviceGetAttribute(&cus, hipDeviceAttributeMultiprocessorCount, dev);
        if (hipFuncSetAttribute((const void*)fwd_kernel, hipFuncAttributeMaxDynamicSharedMemorySize, LDS_BYTES) != hipSuccess) { fprintf(stderr, "kernel_launch: hipFuncSetAttribute failed\n"); grid = -1; return; }
        if (hipOccupancyMaxActiveBlocksPerMultiprocessor(&per_cu, (const void*)fwd_kernel, NTHR, LDS_BYTES) != hipSuccess || per_cu < 1) { fprintf(stderr, "kernel_launch: occupancy query says %d\n", per_cu); per_cu = 1; }
        (void)hipGetLastError();
        grid = cus * 1;
        if (grid <= 0) grid = 256;
    }
    if (grid < 0) return;
    Args a{};
    for (int i = 0; i < 23; ++i) a.in[i] = (const float*)d_in[i];
    a.out = (float*)d_out; a.ws = (unsigned char*)d_ws;
#if MK_COOP
    a.ph_lo = 0; a.ph_hi = N_PHASES;
    if (hipMemsetAsync(d_ws, 0, 16 * KiB, stream) != hipSuccess) { fprintf(stderr, "kernel_launch: memset of the barrier words failed\n"); return; }
    void* kargs[] = {&a};
    hipError_t e = hipLaunchCooperativeKernel((const void*)fwd_kernel, dim3(grid), dim3(NTHR), kargs, LDS_BYTES, stream);
    if (e != hipSuccess) fprintf(stderr, "kernel_launch: cooperative launch failed: %s (grid %d)\n", hipGetErrorString(e), grid);
#else
    for (int p = 0; p < N_PHASES; ++p) { a.ph_lo = p; a.ph_hi = p + 1; hipLaunchKernelGGL(fwd_kernel, dim3(grid), dim3(NTHR), LDS_BYTES, stream, a); }
#endif
}
```
